# Optimizing an MI355X kernel written in HIP

```python
import jax, jax.numpy as jnp
from jax import lax
import numpy as np

D_MODEL = 2048
BATCH = 1
SEQ = 8192
DEPTH = 1

CHUNK = 64
MEM_LEN = 256
MIX_WIDTH = D_MODEL
POOL_WIDTH = MIX_WIDTH // 2
CONV_WIDTH = MIX_WIDTH - POOL_WIDTH
POOL_WINDOWS = (2, 4, 8, 16)
N_POOL_GROUPS = len(POOL_WINDOWS)
POOL_GROUP_DIM = POOL_WIDTH // N_POOL_GROUPS
CONV_KERNEL = 31
XATTN_HEADS = 4
XATTN_HEAD_DIM = D_MODEL // XATTN_HEADS
N_GROUPS = 4
EXPERTS_PER_GROUP = 8
N_EXPERTS = N_GROUPS * EXPERTS_PER_GROUP
TOP_K = 2
D_EXPERT = D_MODEL // 4
MOE_BLOCK = 128
EPS = 1e-6

kernel_name = "hymba_pool_conformer_xmem_hmoe"


def rmsnorm(x, g):
    xf = x.astype(jnp.float32)
    y = xf * lax.rsqrt(jnp.mean(xf * xf, axis=-1, keepdims=True) + EPS)
    return (y * g.astype(jnp.float32)).astype(x.dtype)


def layernorm(x, g, b):
    xf = x.astype(jnp.float32)
    mu = jnp.mean(xf, axis=-1, keepdims=True)
    var = jnp.mean(jnp.square(xf - mu), axis=-1, keepdims=True)
    y = (xf - mu) * lax.rsqrt(var + EPS)
    return (y * g.astype(jnp.float32) + b.astype(jnp.float32)).astype(x.dtype)


def pool_mixer(u, w_pool, pool_scale):
    B, S, _ = u.shape
    ug = u.reshape(B, S, N_POOL_GROUPS, POOL_GROUP_DIM)
    cs = jnp.cumsum(ug.astype(jnp.float32), axis=1)
    cs0 = jnp.concatenate([jnp.zeros_like(cs[:, :1]), cs], axis=1)
    pos = jnp.arange(S)
    outs = []
    for g, w in enumerate(POOL_WINDOWS):
        c = cs0[:, :, g]
        lo = jnp.pad(c, ((0, 0), (w - 1, 0), (0, 0)))[:, :S]
        wsum = c[:, 1:] - lo
        cnt = jnp.minimum(pos + 1, w).astype(jnp.float32)[None, :, None]
        outs.append(wsum / cnt - ug[:, :, g].astype(jnp.float32))
    d = jnp.stack(outs, axis=2).astype(u.dtype)
    z = jnp.einsum('bsgc,gcd->bsgd', d, w_pool)
    return z.reshape(B, S, POOL_WIDTH) * pool_scale


def conv_module(v, w_dw, b_dw, ln_g, ln_b, w_pw):
    a, gate = jnp.split(v, 2, axis=-1)
    y = a * jax.nn.sigmoid(gate)
    y = lax.conv_general_dilated(y, w_dw, window_strides=(1,), padding=[(CONV_KERNEL - 1, 0)],
                                 dimension_numbers=('NWC', 'WIO', 'NWC'),
                                 feature_group_count=CONV_WIDTH)
    y = layernorm(y + b_dw, ln_g, ln_b)
    y = jax.nn.silu(y)
    return y @ w_pw


def cross_attention(h, m, w_q, w_kv, w_o):
    B, S, D = h.shape
    M = m.shape[1]
    q = (h @ w_q).reshape(B, S, XATTN_HEADS, XATTN_HEAD_DIM)
    k, v = jnp.split(m @ w_kv, 2, axis=-1)
    k = k.reshape(B, M, XATTN_HEADS, XATTN_HEAD_DIM)
    v = v.reshape(B, M, XATTN_HEADS, XATTN_HEAD_DIM)
    s = jnp.einsum('bshd,bmhd->bhsm', q, k).astype(jnp.float32) * (XATTN_HEAD_DIM ** -0.5)
    p = jax.nn.softmax(s, axis=-1).astype(v.dtype)
    o = jnp.einsum('bhsm,bmhd->bshd', p, v).reshape(B, S, D)
    return o @ w_o


def hierarchical_moe(h, w_rg, b_rg, w_re, b_re, w_gate, w_up, w_down):
    B, S, D = h.shape
    N = B * S
    hf = h.reshape(N, D)
    lg = (hf @ w_rg).astype(jnp.float32) + b_rg.astype(jnp.float32)
    pg = jax.nn.softmax(lg, axis=-1)
    pg_top, g_idx = lax.top_k(pg, 1)
    le = ((hf @ w_re).astype(jnp.float32) + b_re.astype(jnp.float32)).reshape(N, N_GROUPS, EXPERTS_PER_GROUP)
    le_sel = jnp.take_along_axis(le, g_idx[:, :, None], axis=1)[:, 0]
    pe = jax.nn.softmax(le_sel, axis=-1)
    pe_top, e_loc = lax.top_k(pe, TOP_K)
    w_tok = pg_top * pe_top / jnp.sum(pe_top, axis=-1, keepdims=True)
    e_glob = g_idx * EXPERTS_PER_GROUP + e_loc
    A = N * TOP_K
    flat_e = e_glob.reshape(A)
    flat_tok = jnp.repeat(jnp.arange(N, dtype=jnp.int32), TOP_K)
    flat_w = w_tok.reshape(A)
    order = jnp.argsort(flat_e)
    se, st, sw = flat_e[order], flat_tok[order], flat_w[order]
    counts = jnp.bincount(flat_e, length=N_EXPERTS)
    starts = jnp.cumsum(counts) - counts
    padded = (counts + MOE_BLOCK - 1) // MOE_BLOCK * MOE_BLOCK
    pends = jnp.cumsum(padded)
    pstarts = pends - padded
    dest = pstarts[se] + (jnp.arange(A) - starts[se])
    nb = (A + MOE_BLOCK - 1) // MOE_BLOCK + N_EXPERTS
    P = nb * MOE_BLOCK
    slot_tok = jnp.zeros((P,), jnp.int32).at[dest].set(st)
    slot_w = jnp.zeros((P,), jnp.float32).at[dest].set(sw)
    block_e = jnp.clip(jnp.searchsorted(pends, jnp.arange(nb) * MOE_BLOCK, side='right'), 0, N_EXPERTS - 1)
    xs = hf[slot_tok].reshape(nb, MOE_BLOCK, D)

    def expert_block(args):
        xb, e = args
        hid = jax.nn.silu(xb @ w_gate[e]) * (xb @ w_up[e])
        return hid @ w_down[e]

    ys = lax.map(expert_block, (xs, block_e)).reshape(P, D)
    ys = ys * slot_w[:, None].astype(ys.dtype)
    out = jnp.zeros((N, D), h.dtype).at[slot_tok].add(ys)
    return out.reshape(B, S, D)


def setup_inputs(seed: int = 0) -> dict:
    key = jax.random.key(seed)
    ks = jax.random.split(key, 32)
    f32 = jnp.float32
    L = DEPTH

    def w(k, shape, fan_in):
        return jax.random.normal(k, shape, f32) * (fan_in ** -0.5)

    def gain(k, shape):
        return 1.0 + 0.02 * jax.random.normal(k, shape, f32)

    return {
        "x": jax.random.normal(ks[0], (BATCH, SEQ, D_MODEL), f32),
        "mem": jax.random.normal(ks[1], (BATCH, MEM_LEN, D_MODEL), f32),
        "norm_mix_g": gain(ks[2], (L, D_MODEL)),
        "w_in": w(ks[3], (L, D_MODEL, POOL_WIDTH + 2 * CONV_WIDTH), D_MODEL),
        "w_pool": w(ks[4], (L, N_POOL_GROUPS, POOL_GROUP_DIM, POOL_GROUP_DIM), POOL_GROUP_DIM),
        "pool_scale": gain(ks[5], (L, POOL_WIDTH)),
        "w_dw": w(ks[6], (L, CONV_KERNEL, 1, CONV_WIDTH), CONV_KERNEL),
        "b_dw": 0.02 * jax.random.normal(ks[7], (L, CONV_WIDTH), f32),
        "conv_ln_g": gain(ks[8], (L, CONV_WIDTH)),
        "conv_ln_b": 0.02 * jax.random.normal(ks[9], (L, CONV_WIDTH), f32),
        "w_conv_pw": w(ks[10], (L, CONV_WIDTH, CONV_WIDTH), CONV_WIDTH),
        "out_norm_a_g": gain(ks[11], (L, POOL_WIDTH)),
        "out_norm_b_g": gain(ks[12], (L, CONV_WIDTH)),
        "w_out": w(ks[13], (L, MIX_WIDTH, D_MODEL), MIX_WIDTH),
        "norm_xattn_g": gain(ks[14], (L, D_MODEL)),
        "norm_mem_g": gain(ks[15], (L, D_MODEL)),
        "w_q_mem": w(ks[16], (L, D_MODEL, D_MODEL), D_MODEL),
        "w_kv_mem": w(ks[17], (L, D_MODEL, 2 * D_MODEL), D_MODEL),
        "w_o_mem": w(ks[18], (L, D_MODEL, D_MODEL), D_MODEL),
        "norm_ffn_g": gain(ks[19], (L, D_MODEL)),
        "w_router_group": w(ks[20], (L, D_MODEL, N_GROUPS), D_MODEL),
        "b_router_group": 0.01 * jax.random.normal(ks[21], (L, N_GROUPS), f32),
        "w_router_expert": w(ks[22], (L, D_MODEL, N_EXPERTS), D_MODEL),
        "b_router_expert": 0.01 * jax.random.normal(ks[23], (L, N_EXPERTS), f32),
        "w_exp_gate": w(ks[24], (L, N_EXPERTS, D_MODEL, D_EXPERT), D_MODEL),
        "w_exp_up": w(ks[25], (L, N_EXPERTS, D_MODEL, D_EXPERT), D_MODEL),
        "w_exp_down": w(ks[26], (L, N_EXPERTS, D_EXPERT, D_MODEL), D_EXPERT),
        "final_norm_g": gain(ks[27], (D_MODEL,)),
    }


def reference(x, mem, norm_mix_g, w_in, w_pool, pool_scale, w_dw, b_dw, conv_ln_g, conv_ln_b,
              w_conv_pw, out_norm_a_g, out_norm_b_g, w_out, norm_xattn_g, norm_mem_g, w_q_mem,
              w_kv_mem, w_o_mem, norm_ffn_g, w_router_group, b_router_group, w_router_expert,
              b_router_expert, w_exp_gate, w_exp_up, w_exp_down, final_norm_g):
    for l in range(DEPTH):
        h = rmsnorm(x, norm_mix_g[l])
        proj = h @ w_in[l]
        ya = pool_mixer(proj[..., :POOL_WIDTH], w_pool[l], pool_scale[l])
        yb = conv_module(proj[..., POOL_WIDTH:], w_dw[l], b_dw[l], conv_ln_g[l], conv_ln_b[l], w_conv_pw[l])
        y = jnp.concatenate([rmsnorm(ya, out_norm_a_g[l]), rmsnorm(yb, out_norm_b_g[l])], axis=-1)
        x = x + y @ w_out[l]
        h = rmsnorm(x, norm_xattn_g[l])
        m = rmsnorm(mem, norm_mem_g[l])
        x = x + cross_attention(h, m, w_q_mem[l], w_kv_mem[l], w_o_mem[l])
        h = rmsnorm(x, norm_ffn_g[l])
        x = x + hierarchical_moe(h, w_router_group[l], b_router_group[l], w_router_expert[l],
                                 b_router_expert[l], w_exp_gate[l], w_exp_up[l], w_exp_down[l])
    return rmsnorm(x, final_norm_g)
```

```cpp
#include <hip/hip_runtime.h>
#include <cstdio>
#include <cstdint>

#ifndef MK_N_LAUNCHES
#define MK_N_LAUNCHES 1
#endif
#ifndef FAST_GEMM
#define FAST_GEMM 0
#endif

#define LAS __attribute__((address_space(3)))
#define GAS __attribute__((address_space(1)))
typedef _Float16 f16;
typedef _Float16 f16x8 __attribute__((ext_vector_type(8)));
typedef _Float16 f16x2 __attribute__((ext_vector_type(2)));
typedef float f32x4 __attribute__((ext_vector_type(4)));
typedef float f32x2 __attribute__((ext_vector_type(2)));
typedef unsigned u32x4 __attribute__((ext_vector_type(4)));
typedef unsigned u32x2 __attribute__((ext_vector_type(2)));

constexpr int SEQ = 8192, D = 2048, NPROJ = 3072, MEMLEN = 256, NHEAD = 4, HD = 512, NE = 32, DE = 512, CK = 31;
constexpr float EPS = 1e-6f;
constexpr int NPHASE = 16;

constexpr size_t MiB = 1u << 20;
constexpr size_t WS_CTL = 0, CTL_ZERO_BYTES = 65536;
constexpr size_t WS_HIST = 65536;
constexpr size_t WS_TOT = 98304;
constexpr size_t WS_TOKE = 131072;
constexpr size_t WS_TOKW = 196608;
constexpr size_t WS_TOKSLOT = 262144;
constexpr size_t WS_SLOTW = 327680;
constexpr size_t WS_M16 = 1 * MiB, WS_K16 = 2 * MiB, WS_VT16 = 3 * MiB;
constexpr size_t WS_WIN = 8 * MiB, WS_WPOOL = 20 * MiB, WS_WPW = 22 * MiB, WS_WOUT = 24 * MiB, WS_WQ = 32 * MiB, WS_WKV = 40 * MiB, WS_WO = 56 * MiB,
                 WS_WGU = 64 * MiB, WS_WDN = 192 * MiB;
constexpr size_t WS_PROJ = 256 * MiB, WS_DC = 304 * MiB, WS_XS = 256 * MiB;
constexpr size_t WS_H = 352 * MiB, WS_Y = 384 * MiB, WS_YN = 416 * MiB, WS_YS = 352 * MiB;
constexpr size_t WS_Q = 448 * MiB, WS_P = 480 * MiB, WS_O = 496 * MiB, WS_HID = 448 * MiB;
constexpr size_t WS_END = 528 * MiB;
constexpr int CW_BAR = 4096;

constexpr int RING_BYTES = 131072;
constexpr int MISC_OFF = RING_BYTES;
constexpr int TAB_OFF = RING_BYTES + 256;
constexpr int LDS_BYTES = 147456;

#define LDS_WAIT() asm volatile("s_waitcnt lgkmcnt(0)" ::: "memory")
#define VM_WAIT() asm volatile("s_waitcnt vmcnt(0)" ::: "memory")

__device__ __forceinline__ unsigned pk2h(float lo, float hi) { f32x2 v = {lo, hi}; f16x2 h = __builtin_convertvector(v, f16x2); return __builtin_bit_cast(unsigned, h); }
__device__ __forceinline__ f32x2 unpk2h(unsigned u) { f16x2 h = __builtin_bit_cast(f16x2, u); return __builtin_convertvector(h, f32x2); }
__device__ __forceinline__ float wave_sum(float v) {
#pragma unroll
    for (int o = 1; o < 64; o <<= 1) v += __shfl_xor(v, o);
    return v;
}
__device__ __forceinline__ float fast_sigmoid(float x) { return __builtin_amdgcn_rcpf(1.0f + __expf(-x)); }

#define XB_TMO      128
#define XB_XCNT(j)  (256  + 64 * (j))
#define XB_XSUB(j)  (1280 + 64 * (j))
#define XB_XGEN(j)  (2304 + 64 * (j))
#define XB_TOP      3328
#define XB_TOPGEN   3392
#define XCD_BAR_WORDS 3456
#define XB_SPIN_CAP (1u << 18)
__device__ __forceinline__ unsigned xb_ld(unsigned* p)              { return __hip_atomic_load(p, __ATOMIC_RELAXED, __HIP_MEMORY_SCOPE_AGENT); }
__device__ __forceinline__ unsigned xb_add(unsigned* p, unsigned v) { return __hip_atomic_fetch_add(p, v, __ATOMIC_RELAXED, __HIP_MEMORY_SCOPE_AGENT); }
__device__ __forceinline__ unsigned xb_xcc_id() { return (unsigned)__builtin_amdgcn_s_getreg((3 << 11) | 20) & 0xFu; }
#define XB_SPIN(cond, bar) do { unsigned _sp = 0; while (cond) { __builtin_amdgcn_s_sleep(1); \
    if ((++_sp & 255u) == 0u) { if (xb_ld(&(bar)[XB_TMO])) break; if (_sp > XB_SPIN_CAP) { atomicAdd(&(bar)[XB_TMO], 1u); break; } } } } while (0)
struct XcdBarrier { unsigned* bar; unsigned x; volatile LAS unsigned* st; };
__device__ __forceinline__ XcdBarrier xcd_barrier_post(unsigned* bar, volatile LAS unsigned* st) {
    XcdBarrier b; b.bar = bar; b.x = xb_xcc_id(); b.st = st;
    if (threadIdx.x == 0) (void)xb_add(&bar[XB_XCNT(b.x)], 1u);
    return b;
}
__device__ __forceinline__ void xcd_barrier_complete(unsigned* bar, unsigned x, unsigned& nloc, unsigned& nx) {
    const unsigned G = gridDim.x * gridDim.y * gridDim.z;
    unsigned sum, cnt, mine, sp = 0u;
    for (;;) {
        sum = 0u; cnt = 0u; mine = 0u;
#pragma unroll
        for (unsigned j = 0; j < 16; ++j) { const unsigned c = xb_ld(&bar[XB_XCNT(j)]); sum += c; cnt += (c > 0u) ? 1u : 0u; mine = (j == x) ? c : mine; }
        if (sum == G) break;
        __builtin_amdgcn_s_sleep(1);
        if ((++sp & 255u) == 0u) { if (xb_ld(&bar[XB_TMO])) break; if (sp > XB_SPIN_CAP) { atomicAdd(&bar[XB_TMO], 1u); break; } }
    }
    nloc = mine > 0u ? mine : 1u; nx = cnt > 0u ? cnt : 1u;
}
__device__ __forceinline__ void xcd_barrier(const XcdBarrier& b) {
    asm volatile("s_waitcnt vmcnt(0)" ::: "memory");
    __syncthreads();
    if (threadIdx.x == 0) {
        unsigned* bar = b.bar;
        __builtin_amdgcn_s_waitcnt(0);
        unsigned nloc = b.st[0], nx = b.st[1];
        if (nloc == 0u) { xcd_barrier_complete(bar, b.x, nloc, nx); b.st[0] = nloc; b.st[1] = nx; }
        const unsigned old = xb_add(&bar[XB_XSUB(b.x)], 1u);
        const unsigned gen = old / nloc;
        if (old + 1u == (gen + 1u) * nloc) {
            __builtin_amdgcn_fence(__ATOMIC_RELEASE, "agent");
            asm volatile("s_waitcnt vmcnt(0)" ::: "memory");
            const unsigned og = xb_add(&bar[XB_TOP], 1u);
            const unsigned tg = og / nx;
            if (og + 1u == (tg + 1u) * nx) xb_add(&bar[XB_TOPGEN], 1u);
            else XB_SPIN(xb_ld(&bar[XB_TOPGEN]) == tg, bar);
            __builtin_amdgcn_fence(__ATOMIC_ACQUIRE, "agent");
            xb_add(&bar[XB_XGEN(b.x)], 1u);
            asm volatile("s_waitcnt vmcnt(0)" ::: "memory");
        } else {
            XB_SPIN(xb_ld(&bar[XB_XGEN(b.x)]) == gen, bar);
            __builtin_amdgcn_fence(__ATOMIC_ACQUIRE, "agent");
            asm volatile("s_waitcnt vmcnt(0)" ::: "memory");
        }
    }
    __syncthreads();
}

namespace pg8 {
constexpr int BM = 256, BK = 64, HALF = 128, HTB = HALF * BK * 2, STAGE_BYTES = 8 * HTB, NXCD = 8, WGM = 8;
__host__ __device__ __forceinline__ int lds_byte(int r, int c) { const int st = (r >> 4) * 2 + (c >> 5), rr = r & 15, cc = c & 31, ob = rr * 64 + cc * 2; return st * 1024 + (ob ^ (((ob >> 9) & 1) << 5)); }
__host__ __device__ __forceinline__ void stage_rc(int b, int& R, int& C) { const int st = b / 1024, sb = b % 1024, swz = sb ^ (((sb >> 9) & 1) << 5); R = (st >> 1) * 16 + swz / 64; C = (st & 1) * 32 + (swz % 64) / 2; }
__host__ __device__ __forceinline__ int perm32(int rho) { const int n = rho >> 4, i = rho & 15; return 8 * (i >> 2) + 4 * n + (i & 3); }

struct Unit { const char* a; const char* b; char* o; int ldc; int nt; int r0, c0, kind, aux; };

__device__ __forceinline__ void tile_of(int L, int nM, int nN, int& pm, int& pn) {
    const int nwg = nM * nN; int wgid = L;
    { const int q = nwg / NXCD, r = nwg % NXCD, xcd = wgid % NXCD, off = wgid / NXCD; wgid = (xcd < r ? xcd * (q + 1) : r * (q + 1) + (xcd - r) * q) + off; }
    const int nig = WGM * nN, gid = wgid / nig, fm = gid * WGM, gsz = (nM - fm) < WGM ? (nM - fm) : WGM;
    pm = fm + ((wgid % nig) % gsz); pn = (wgid % nig) / gsz;
}
__device__ __forceinline__ int xcd_chunk(int L, int nwg) {
    const int q = nwg / NXCD, r = nwg % NXCD, xcd = L % NXCD, off = L / NXCD; return (xcd < r ? xcd * (q + 1) : r * (q + 1) + (xcd - r) * q) + off;
}

typedef f32x4 Acc[2][2][4][2];

template <class Epi, class Sched>
__device__ __forceinline__ void gemm_phase_simple(LAS unsigned char* lds, int lda, int ldb, const Sched& S, const Epi& E) {
    const int tid = threadIdx.x, wid = __builtin_amdgcn_readfirstlane(tid >> 6), lane = tid & 63, wr = wid >> 2, wc = wid & 3, fr = lane & 15, fq = lane >> 4;
    Unit u;
    for (int ui = 0; S.next(ui, u); ++ui) {
        Acc acc;
#pragma unroll
        for (int a = 0; a < 2; ++a)
#pragma unroll
            for (int b = 0; b < 2; ++b)
#pragma unroll
                for (int m = 0; m < 4; ++m)
#pragma unroll
                    for (int n = 0; n < 2; ++n) acc[a][b][m][n] = (f32x4){0.f, 0.f, 0.f, 0.f};
        for (int ks = 0; ks < u.nt * 2; ++ks) {
            f16x8 Af[2][4], Bf[2][2];
            const size_t kb = (size_t)(ks * 32 + fq * 8) * 2;
#pragma unroll
            for (int ai = 0; ai < 2; ++ai)
#pragma unroll
                for (int m = 0; m < 4; ++m) Af[ai][m] = *(const f16x8*)(u.a + (size_t)(ai * 128 + wr * 64 + m * 16 + fr) * lda * 2 + kb);
#pragma unroll
            for (int bj = 0; bj < 2; ++bj)
#pragma unroll
                for (int n = 0; n < 2; ++n) { const int rr = Epi::PERM ? (8 * (fr >> 2) + 4 * n + (fr & 3)) : (n * 16 + fr);
                    Bf[bj][n] = *(const f16x8*)(u.b + (size_t)(bj * 128 + wc * 32 + rr) * ldb * 2 + kb); }
#pragma unroll
            for (int ai = 0; ai < 2; ++ai)
#pragma unroll
                for (int bj = 0; bj < 2; ++bj)
#pragma unroll
                    for (int m = 0; m < 4; ++m)
#pragma unroll
                        for (int n = 0; n < 2; ++n) acc[ai][bj][m][n] = __builtin_amdgcn_mfma_f32_16x16x32_f16(Bf[bj][n], Af[ai][m], acc[ai][bj][m][n], 0, 0, 0);
        }
        if constexpr (Epi::AFTER_DRAIN) { __syncthreads(); E.fused(acc, u, wr, wc, fr, fq, lds, wid, lane); __syncthreads(); }
        else E(acc, u, wr, wc, fr, fq);
    }
}
}
using pg8::Unit; using pg8::Acc;

struct EpiF16 {
    static constexpr bool PERM = true, AFTER_DRAIN = false;
    const float* cs0; float scale;
    __device__ __forceinline__ void operator()(const Acc& acc, const Unit& u, int wr, int wc, int fr, int fq) const {
        f16* base = (f16*)u.o; const int ldc = u.ldc;
        const int row0 = u.r0 + wr * 64 + fr, col0 = u.c0 + wc * 32 + 8 * fq;
        f32x4 sv[2][2];
        const bool has_cs = (u.kind == 0) && (cs0 != nullptr);
#pragma unroll
        for (int bj = 0; bj < 2; ++bj)
#pragma unroll
            for (int n = 0; n < 2; ++n) { sv[bj][n] = (f32x4){scale, scale, scale, scale}; if (has_cs) sv[bj][n] = sv[bj][n] * *(const f32x4*)(cs0 + col0 + bj * 128 + 4 * n); }
#pragma unroll
        for (int ai = 0; ai < 2; ++ai)
#pragma unroll
            for (int m = 0; m < 4; ++m) { f16* rowp = base + (size_t)(row0 + ai * 128 + m * 16) * ldc + col0;
#pragma unroll
                for (int bj = 0; bj < 2; ++bj) { const f32x4 v0 = acc[ai][bj][m][0] * sv[bj][0], v1 = acc[ai][bj][m][1] * sv[bj][1];
                    u32x4 w; w.x = pk2h(v0[0], v0[1]); w.y = pk2h(v0[2], v0[3]); w.z = pk2h(v1[0], v1[1]); w.w = pk2h(v1[2], v1[3]);
                    *(u32x4*)(rowp + bj * 128) = w; } }
    }
};
struct EpiResF32 {
    static constexpr bool PERM = false, AFTER_DRAIN = false;
    const float* base; float* out; int ldc;
    __device__ __forceinline__ void operator()(const Acc& acc, const Unit& u, int wr, int wc, int fr, int fq) const {
        const int row0 = u.r0 + wr * 64 + fr, col0 = u.c0 + wc * 32 + 4 * fq;
#pragma unroll
        for (int ai = 0; ai < 2; ++ai)
#pragma unroll
            for (int m = 0; m < 4; ++m) { const size_t off = (size_t)(row0 + ai * 128 + m * 16) * ldc + col0;
#pragma unroll
                for (int bj = 0; bj < 2; ++bj)
#pragma unroll
                    for (int n = 0; n < 2; ++n) { const f32x4 bs = *(const f32x4*)(base + off + bj * 128 + n * 16); *(f32x4*)(out + off + bj * 128 + n * 16) = bs + acc[ai][bj][m][n]; } }
    }
};
struct EpiSwiGLU {
    static constexpr bool PERM = true, AFTER_DRAIN = false;
    f16* hid;
    __device__ __forceinline__ void operator()(const Acc& acc, const Unit& u, int wr, int wc, int fr, int fq) const {
        const int row0 = u.r0 + wr * 64 + fr, col0 = u.c0 + wc * 32 + 8 * fq;
#pragma unroll
        for (int ai = 0; ai < 2; ++ai)
#pragma unroll
            for (int m = 0; m < 4; ++m) { f16* rowp = hid + (size_t)(row0 + ai * 128 + m * 16) * DE + col0;
                float h[8];
#pragma unroll
                for (int n = 0; n < 2; ++n)
#pragma unroll
                    for (int j = 0; j < 4; ++j) { const float g = acc[ai][0][m][n][j], up = acc[ai][1][m][n][j]; h[n * 4 + j] = g * fast_sigmoid(g) * up; }
                u32x4 w; w.x = pk2h(h[0], h[1]); w.y = pk2h(h[2], h[3]); w.z = pk2h(h[4], h[5]); w.w = pk2h(h[6], h[7]);
                *(u32x4*)rowp = w; }
    }
};
struct EpiDown {
    static constexpr bool PERM = true, AFTER_DRAIN = false;
    f16* ys; const float* slot_w;
    __device__ __forceinline__ void operator()(const Acc& acc, const Unit& u, int wr, int wc, int fr, int fq) const {
        const int row0 = u.r0 + wr * 64 + fr, col0 = u.c0 + wc * 32 + 8 * fq;
#pragma unroll
        for (int ai = 0; ai < 2; ++ai)
#pragma unroll
            for (int m = 0; m < 4; ++m) { const int row = row0 + ai * 128 + m * 16; const float sw = slot_w[row]; f16* rowp = ys + (size_t)row * D + col0;
#pragma unroll
                for (int bj = 0; bj < 2; ++bj) { const f32x4 v0 = acc[ai][bj][m][0] * sw, v1 = acc[ai][bj][m][1] * sw;
                    u32x4 w; w.x = pk2h(v0[0], v0[1]); w.y = pk2h(v0[2], v0[3]); w.z = pk2h(v1[0], v1[1]); w.w = pk2h(v1[2], v1[3]);
                    *(u32x4*)(rowp + bj * 128) = w; } }
    }
};
struct EpiSoftmax {
    static constexpr bool PERM = true, AFTER_DRAIN = true;
    f16* P;
    __device__ __forceinline__ void operator()(const Acc&, const Unit&, int, int, int, int) const {}
    __device__ __forceinline__ void fused(Acc& acc, const Unit& u, int wr, int wc, int fr, int fq, LAS unsigned char* lds, int wid, int lane) const {
        LAS f32x2* T = (LAS f32x2*)lds;
        float mloc[2][4], lloc[2][4];
#pragma unroll
        for (int ai = 0; ai < 2; ++ai)
#pragma unroll
            for (int m = 0; m < 4; ++m) {
                float mx = -3.0e38f;
#pragma unroll
                for (int bj = 0; bj < 2; ++bj)
#pragma unroll
                    for (int n = 0; n < 2; ++n)
#pragma unroll
                        for (int j = 0; j < 4; ++j) mx = fmaxf(mx, acc[ai][bj][m][n][j]);
                mx = fmaxf(mx, __shfl_xor(mx, 16)); mx = fmaxf(mx, __shfl_xor(mx, 32));
                float s = 0.f;
#pragma unroll
                for (int bj = 0; bj < 2; ++bj)
#pragma unroll
                    for (int n = 0; n < 2; ++n)
#pragma unroll
                        for (int j = 0; j < 4; ++j) { const float e = __expf(acc[ai][bj][m][n][j] - mx); acc[ai][bj][m][n][j] = e; s += e; }
                s += __shfl_xor(s, 16); s += __shfl_xor(s, 32);
                mloc[ai][m] = mx; lloc[ai][m] = s;
                if (fq == 0) T[(ai * 128 + wr * 64 + m * 16 + fr) * 4 + wc] = (f32x2){mx, s};
            }
        LDS_WAIT(); __builtin_amdgcn_s_barrier(); asm volatile("" ::: "memory");
        const int row0 = u.r0 + wr * 64 + fr, col0 = u.c0 + wc * 32 + 8 * fq;
#pragma unroll
        for (int ai = 0; ai < 2; ++ai)
#pragma unroll
            for (int m = 0; m < 4; ++m) { const int r = ai * 128 + wr * 64 + m * 16 + fr;
                const f32x2 t0 = T[r * 4 + 0], t1 = T[r * 4 + 1], t2 = T[r * 4 + 2], t3 = T[r * 4 + 3];
                const float M = fmaxf(fmaxf(t0.x, t1.x), fmaxf(t2.x, t3.x));
                const float L = t0.y * __expf(t0.x - M) + t1.y * __expf(t1.x - M) + t2.y * __expf(t2.x - M) + t3.y * __expf(t3.x - M);
                const float f = __expf(mloc[ai][m] - M) / L;
                f16* rowp = P + (size_t)(row0 + ai * 128 + m * 16) * 256 + col0;
#pragma unroll
                for (int bj = 0; bj < 2; ++bj) { const f32x4 v0 = acc[ai][bj][m][0] * f, v1 = acc[ai][bj][m][1] * f;
                    u32x4 w; w.x = pk2h(v0[0], v0[1]); w.y = pk2h(v0[2], v0[3]); w.z = pk2h(v1[0], v1[1]); w.w = pk2h(v1[2], v1[3]);
                    *(u32x4*)(rowp + bj * 128) = w; } }
        (void)lloc;
    }
};

struct Frame {
    LAS unsigned char* lds;
    unsigned char* ws;
    int tid, lane, wave, G, c;
};
struct Args { const float* in[28]; float* out; unsigned char* ws; int ph_lo, ph_hi, li, pad; };

struct SchedP1 {
    int G, c; const char* h16; const char* win; const char* m16; const char* wkv; char* proj; char* k16; char* vt16;
    __device__ __forceinline__ bool next(int i, Unit& u) const {
        const int L = i * G + c; if (L >= 400) return false;
        u.nt = 32; u.aux = 0;
        if (L < 384) { int pm, pn; pg8::tile_of(L, 32, 12, pm, pn); u.a = h16 + (size_t)pm * 256 * D * 2; u.b = win + (size_t)pn * 256 * D * 2; u.r0 = pm * 256; u.c0 = pn * 256; u.kind = 0; u.o = proj; u.ldc = NPROJ; }
        else if (L < 392) { const int pn = L - 384; u.a = m16; u.b = wkv + (size_t)pn * 256 * D * 2; u.r0 = 0; u.c0 = pn * 256; u.kind = 1; u.o = k16; u.ldc = D; }
        else { const int pm = L - 392; u.a = wkv + (size_t)(2048 + pm * 256) * D * 2; u.b = m16; u.r0 = pm * 256; u.c0 = 0; u.kind = 2; u.o = vt16; u.ldc = 256; }
        return true;
    }
};
struct SchedG2 {
    int G, c; const char* dc; const char* wpw; const char* wpool; char* y;
    __device__ __forceinline__ bool next(int i, Unit& u) const {
        const int L = i * G + c; if (L >= 256) return false;
        u.aux = 0; u.o = y; u.ldc = D;
        if (L < 128) { int pm, pn; pg8::tile_of(L, 32, 4, pm, pn); u.a = dc + ((size_t)pm * 256 * D + 1024) * 2; u.b = wpw + (size_t)pn * 256 * 1024 * 2; u.nt = 16; u.r0 = pm * 256; u.c0 = 1024 + pn * 256; u.kind = 1; }
        else { int pm, g; pg8::tile_of(L - 128, 32, 4, pm, g); u.a = dc + ((size_t)pm * 256 * D + g * 256) * 2; u.b = wpool + (size_t)g * 256 * 1024 * 2; u.nt = 4; u.r0 = pm * 256; u.c0 = g * 256; u.kind = 0; }
        return true;
    }
};
struct SchedDense {
    int G, c; const char* A; const char* B; char* o;
    __device__ __forceinline__ bool next(int i, Unit& u) const {
        const int L = i * G + c; if (L >= 256) return false;
        int pm, pn; pg8::tile_of(L, 32, 8, pm, pn);
        u.a = A + (size_t)pm * 256 * D * 2; u.b = B + (size_t)pn * 256 * D * 2; u.nt = 32; u.r0 = pm * 256; u.c0 = pn * 256; u.kind = 1; u.aux = 0; u.o = o; u.ldc = D; return true;
    }
};
struct SchedS {
    int G, c; const char* q; const char* k16;
    __device__ __forceinline__ bool next(int i, Unit& u) const {
        const int L = i * G + c; if (L >= 128 || i > 0) return false;
        const int h = L >> 5, pm = L & 31;
        u.a = q + ((size_t)pm * 256 * D + h * HD) * 2; u.b = k16 + (size_t)h * HD * 2; u.nt = 8; u.r0 = h * SEQ + pm * 256; u.c0 = 0; u.kind = 1; u.aux = 0; u.o = nullptr; u.ldc = 256; return true;
    }
};
struct SchedPV {
    int G, c; const char* p; const char* vt; char* o;
    __device__ __forceinline__ bool next(int i, Unit& u) const {
        const int L = i * G + c; if (L >= 256) return false;
        const int w = pg8::xcd_chunk(L, 256); const int h = w >> 6, pm = (w >> 1) & 31, pn = w & 1;
        u.a = p + (size_t)(h * SEQ + pm * 256) * 256 * 2; u.b = vt + (size_t)(h * HD + pn * 256) * 256 * 2; u.nt = 4; u.r0 = pm * 256; u.c0 = h * HD + pn * 256; u.kind = 1; u.aux = 0; u.o = o; u.ldc = D; return true;
    }
};
struct SchedGU {
    int G, c; const char* xs; const char* wgu; const LAS int* tab;
    __device__ __forceinline__ bool next(int i, Unit& u) const {
        const int T = __builtin_amdgcn_readfirstlane(tab[0]); const int L = i * G + c; if (L >= T * 4) return false;
        const int w = pg8::xcd_chunk(L, T * 4); const int j = w >> 2, pn = w & 3; const int e = __builtin_amdgcn_readfirstlane(tab[1 + j]);
        u.a = xs + (size_t)j * 256 * D * 2; u.b = wgu + (size_t)(e * 1024 + pn * 256) * D * 2; u.nt = 32; u.r0 = j * 256; u.c0 = pn * 128; u.kind = 1; u.aux = e; u.o = nullptr; u.ldc = DE; return true;
    }
};
struct SchedDN {
    int G, c; const char* hid; const char* wdn; const LAS int* tab;
    __device__ __forceinline__ bool next(int i, Unit& u) const {
        const int T = __builtin_amdgcn_readfirstlane(tab[0]); const int L = i * G + c; if (L >= T * 8) return false;
        const int w = pg8::xcd_chunk(L, T * 8); const int j = w >> 3, pn = w & 7; const int e = __builtin_amdgcn_readfirstlane(tab[1 + j]);
        u.a = hid + (size_t)j * 256 * DE * 2; u.b = wdn + (size_t)(e * 2048 + pn * 256) * DE * 2; u.nt = 8; u.r0 = j * 256; u.c0 = pn * 256; u.kind = 1; u.aux = e; u.o = nullptr; u.ldc = D; return true;
    }
};

__device__ __forceinline__ void tr_item(const float* W, int N, int k0, int n0, f16* dst, int pitch, LAS float* scr, int lane) {
    const float* src = W + (size_t)(k0 + (lane >> 3)) * N + n0 + 4 * (lane & 7);
    f32x4 v[8];
#pragma unroll
    for (int i = 0; i < 8; ++i) v[i] = *(const f32x4*)(src + (size_t)(8 * i) * N);
#pragma unroll
    for (int i = 0; i < 8; ++i) { LAS float* p = scr + ((lane >> 3) + 8 * i) * 33 + 4 * (lane & 7); p[0] = v[i][0]; p[1] = v[i][1]; p[2] = v[i][2]; p[3] = v[i][3]; }
    LDS_WAIT();
    const int c = lane >> 3, nl = lane & 7;
#pragma unroll
    for (int jj = 0; jj < 4; ++jj) { const int n = nl + 8 * jj; const LAS float* s = scr + (8 * c) * 33 + n;
        u32x4 o; o.x = pk2h(s[0 * 33], s[1 * 33]); o.y = pk2h(s[2 * 33], s[3 * 33]); o.z = pk2h(s[4 * 33], s[5 * 33]); o.w = pk2h(s[6 * 33], s[7 * 33]);
        *(u32x4*)(dst + (size_t)n * pitch + 8 * c) = o; }
    LDS_WAIT();
}
__device__ __forceinline__ void rms_row_f32(const float* xrow, const float* g, f16* orow, int lane) {
    f32x4 v[8]; float s = 0.f;
#pragma unroll
    for (int j = 0; j < 4; ++j) { const f32x4* p = (const f32x4*)(xrow + 8 * (lane + 64 * j)); v[2 * j] = p[0]; v[2 * j + 1] = p[1];
        s += v[2 * j][0] * v[2 * j][0] + v[2 * j][1] * v[2 * j][1] + v[2 * j][2] * v[2 * j][2] + v[2 * j][3] * v[2 * j][3];
        s += v[2 * j + 1][0] * v[2 * j + 1][0] + v[2 * j + 1][1] * v[2 * j + 1][1] + v[2 * j + 1][2] * v[2 * j + 1][2] + v[2 * j + 1][3] * v[2 * j + 1][3]; }
    const float rs = rsqrtf(wave_sum(s) * (1.0f / D) + EPS);
#pragma unroll
    for (int j = 0; j < 4; ++j) { const f32x4* gp = (const f32x4*)(g + 8 * (lane + 64 * j)); const f32x4 a = v[2 * j] * rs * gp[0], b = v[2 * j + 1] * rs * gp[1];
        u32x4 o; o.x = pk2h(a[0], a[1]); o.y = pk2h(a[2], a[3]); o.z = pk2h(b[0], b[1]); o.w = pk2h(b[2], b[3]);
        *(u32x4*)(orow + 8 * (lane + 64 * j)) = o; }
}

__device__ __forceinline__ void phase_prep(const Frame& F, const Args& A) {
    LAS float* scr = (LAS float*)(F.lds + F.wave * 16384);
    const int gw = F.c * 8 + F.wave, NGW = F.G * 8;
    unsigned char* ws = F.ws;
    constexpr int I_IN = 32 * 96, I_POOL = 4 * 4 * 8, I_PW = 16 * 32, I_SQ = 32 * 64, I_KV = 32 * 128, I_G = 32 * 32 * 16, I_D = 32 * 8 * 64;
    constexpr int NITEMS = I_IN + I_POOL + I_PW + 3 * I_SQ + I_KV + 2 * I_G + I_D;
    for (int it = gw; it < NITEMS; it += NGW) {
        int r = it;
        if (r < I_IN) { const int kb = r / 96, nb = r % 96; tr_item(A.in[3], NPROJ, kb * 64, nb * 32, (f16*)(ws + WS_WIN) + (size_t)(nb * 32) * D + kb * 64, D, scr, F.lane); continue; } r -= I_IN;
        if (r < I_POOL) { const int g = r / 32, q = r % 32, kb = q / 8, nb = q % 8; tr_item(A.in[4] + (size_t)g * 65536, 256, kb * 64, nb * 32, (f16*)(ws + WS_WPOOL) + (size_t)(g * 256 + nb * 32) * 1024 + kb * 64, 1024, scr, F.lane); continue; } r -= I_POOL;
        if (r < I_PW) { const int kb = r / 32, nb = r % 32; tr_item(A.in[10], 1024, kb * 64, nb * 32, (f16*)(ws + WS_WPW) + (size_t)(nb * 32) * 1024 + kb * 64, 1024, scr, F.lane); continue; } r -= I_PW;
        if (r < I_SQ) { const int kb = r / 64, nb = r % 64; tr_item(A.in[13], D, kb * 64, nb * 32, (f16*)(ws + WS_WOUT) + (size_t)(nb * 32) * D + kb * 64, D, scr, F.lane); continue; } r -= I_SQ;
        if (r < I_SQ) { const int kb = r / 64, nb = r % 64; tr_item(A.in[16], D, kb * 64, nb * 32, (f16*)(ws + WS_WQ) + (size_t)(nb * 32) * D + kb * 64, D, scr, F.lane); continue; } r -= I_SQ;
        if (r < I_SQ) { const int kb = r / 64, nb = r % 64; tr_item(A.in[18], D, kb * 64, nb * 32, (f16*)(ws + WS_WO) + (size_t)(nb * 32) * D + kb * 64, D, scr, F.lane); continue; } r -= I_SQ;
        if (r < I_KV) { const int kb = r / 128, nb = r % 128; tr_item(A.in[17], 4096, kb * 64, nb * 32, (f16*)(ws + WS_WKV) + (size_t)(nb * 32) * D + kb * 64, D, scr, F.lane); continue; } r -= I_KV;
        if (r < 2 * I_G) { const int up = r >= I_G; if (up) r -= I_G; const int e = r / 512, q = r % 512, kb = q / 16, nb = q % 16; const int n0 = nb * 32;
            const int drow = e * 1024 + (n0 >> 7) * 256 + up * 128 + (n0 & 127);
            tr_item(A.in[up ? 25 : 24] + (size_t)e * D * DE, DE, kb * 64, n0, (f16*)(ws + WS_WGU) + (size_t)drow * D + kb * 64, D, scr, F.lane); continue; } r -= 2 * I_G;
        { const int e = r / 512, q = r % 512, kb = q / 64, nb = q % 64;
          tr_item(A.in[26] + (size_t)e * DE * D, D, kb * 64, nb * 32, (f16*)(ws + WS_WDN) + (size_t)(e * 2048 + nb * 32) * DE + kb * 64, DE, scr, F.lane); }
    }
    for (int m = gw; m < SEQ; m += NGW) rms_row_f32(A.in[0] + (size_t)m * D, A.in[2], (f16*)(ws + WS_H) + (size_t)m * D, F.lane);
    for (int m = gw; m < MEMLEN; m += NGW) rms_row_f32(A.in[1] + (size_t)m * D, A.in[15], (f16*)(ws + WS_M16) + (size_t)m * D, F.lane);
}

__device__ __forceinline__ void phase_mixpre(const Frame& F, const Args& A) {
    const f16* proj = (const f16*)(F.ws + WS_PROJ);
    f16* dc = (f16*)(F.ws + WS_DC);
    LAS unsigned* ylds = (LAS unsigned*)F.lds;
    LAS float* red = (LAS float*)F.lds;
    LAS float* stat = (LAS float*)(F.lds + TAB_OFF);
    const int tid = F.tid, lane = F.lane;
    const float* wdw = A.in[6];
    f32x2 w[CK];
#pragma unroll
    for (int j = 0; j < CK; ++j) w[j] = *(const f32x2*)(wdw + j * 1024 + 2 * tid);
    const f32x2 bdw = *(const f32x2*)(A.in[7] + 2 * tid), lng = *(const f32x2*)(A.in[8] + 2 * tid), lnb = *(const f32x2*)(A.in[9] + 2 * tid);
    for (int blk = F.c; blk < SEQ / 32; blk += F.G) {
        const int t0 = blk * 32;
#pragma unroll 1
        for (int p = 0; p < 16; ++p) { const int r = p * 4 + (tid >> 7), c8 = (tid & 127) * 8; const int t = t0 - 30 + r;
            if (r < 62) { u32x4 o = (u32x4){0u, 0u, 0u, 0u};
                if (t >= 0) { const u32x4 av = *(const u32x4*)(proj + (size_t)t * NPROJ + 1024 + c8), gv = *(const u32x4*)(proj + (size_t)t * NPROJ + 2048 + c8);
#pragma unroll
                    for (int q = 0; q < 4; ++q) { const f32x2 a2 = unpk2h(av[q]), g2 = unpk2h(gv[q]); o[q] = pk2h(a2[0] * fast_sigmoid(g2[0]), a2[1] * fast_sigmoid(g2[1])); } }
                *(LAS u32x4*)(ylds + r * 512 + (tid & 127) * 4) = o; } }
        __syncthreads();
        unsigned o[32];
#pragma unroll
        for (int r = 0; r < 32; ++r) { f32x2 a = bdw;
#pragma unroll
            for (int j = 0; j < CK; ++j) { const f32x2 y = unpk2h(ylds[(r + j) * 512 + tid]); a = a + w[j] * y; }
            o[r] = pk2h(a[0], a[1]); __builtin_amdgcn_sched_barrier(0); }
        __syncthreads();
#pragma unroll
        for (int r = 0; r < 32; ++r) { const f32x2 v = unpk2h(o[r]); red[(2 * r) * 512 + tid] = v[0] + v[1]; red[(2 * r + 1) * 512 + tid] = v[0] * v[0] + v[1] * v[1]; }
        __syncthreads();
        { const int s = tid >> 3, sl = tid & 7; float a = 0.f;
#pragma unroll 8
          for (int i = 0; i < 64; ++i) a += red[s * 512 + sl * 64 + ((i + lane) & 63)];
          a += __shfl_xor(a, 1); a += __shfl_xor(a, 2); a += __shfl_xor(a, 4);
          if (sl == 0) stat[s] = a; }
        __syncthreads();
#pragma unroll
        for (int r = 0; r < 32; ++r) { const float mean = stat[2 * r] * (1.0f / 1024.f); const float var = stat[2 * r + 1] * (1.0f / 1024.f) - mean * mean; const float rstd = rsqrtf(var + EPS);
            const f32x2 v = unpk2h(o[r]);
            const float y0 = (v[0] - mean) * rstd * lng[0] + lnb[0], y1 = (v[1] - mean) * rstd * lng[1] + lnb[1];
            *(unsigned*)(dc + (size_t)(t0 + r) * D + 1024 + 2 * tid) = pk2h(y0 * fast_sigmoid(y0), y1 * fast_sigmoid(y1)); }
        { const int g = tid >> 7, wnd = 2 << g; const f16* up = proj + 2 * tid; f32x2 S = (f32x2){0.f, 0.f};
#pragma unroll 1
          for (int i = 1; i < wnd; ++i) { const int t = t0 - i; if (t >= 0) S = S + unpk2h(*(const unsigned*)(up + (size_t)t * NPROJ)); }
#pragma unroll 2
          for (int r = 0; r < 32; ++r) { const int t = t0 + r; const f32x2 cur = unpk2h(*(const unsigned*)(up + (size_t)t * NPROJ)); S = S + cur;
              const int cnt = (t + 1 < wnd) ? (t + 1) : wnd; const float ic = 1.0f / (float)cnt;
              *(unsigned*)(dc + (size_t)t * D + 2 * tid) = pk2h(S[0] * ic - cur[0], S[1] * ic - cur[1]);
              const int tl = t - wnd + 1; if (tl >= 0) S = S - unpk2h(*(const unsigned*)(up + (size_t)tl * NPROJ)); } }
        __syncthreads();
    }
}

__device__ __forceinline__ void phase_rownorm(const Frame& F, const Args& A) {
    const f16* y = (const f16*)(F.ws + WS_Y); f16* yn = (f16*)(F.ws + WS_YN);
    const int gw = F.c * 8 + F.wave, NGW = F.G * 8, lane = F.lane;
    for (int m = gw; m < SEQ; m += NGW) {
        u32x4 v[4]; float sa = 0.f, sb = 0.f;
#pragma unroll
        for (int j = 0; j < 4; ++j) { v[j] = *(const u32x4*)(y + (size_t)m * D + 8 * (lane + 64 * j)); float s = 0.f;
#pragma unroll
            for (int q = 0; q < 4; ++q) { const f32x2 a = unpk2h(v[j][q]); s += a[0] * a[0] + a[1] * a[1]; }
            if (j < 2) sa += s; else sb += s; }
        const float ra = rsqrtf(wave_sum(sa) * (1.0f / 1024.f) + EPS), rb = rsqrtf(wave_sum(sb) * (1.0f / 1024.f) + EPS);
#pragma unroll
        for (int j = 0; j < 4; ++j) { const int col = 8 * (lane + 64 * j); const float* g = (j < 2) ? (A.in[11] + col) : (A.in[12] + col - 1024); const float rs = (j < 2) ? ra : rb;
            const f32x4 g0 = *(const f32x4*)g, g1 = *(const f32x4*)(g + 4); u32x4 o;
            { const f32x2 a = unpk2h(v[j][0]); o.x = pk2h(a[0] * rs * g0[0], a[1] * rs * g0[1]); }
            { const f32x2 a = unpk2h(v[j][1]); o.y = pk2h(a[0] * rs * g0[2], a[1] * rs * g0[3]); }
            { const f32x2 a = unpk2h(v[j][2]); o.z = pk2h(a[0] * rs * g1[0], a[1] * rs * g1[1]); }
            { const f32x2 a = unpk2h(v[j][3]); o.w = pk2h(a[0] * rs * g1[2], a[1] * rs * g1[3]); }
            *(u32x4*)(yn + (size_t)m * D + col) = o; }
    }
}
__device__ __forceinline__ void phase_norm_x(const Frame& F, const float* x, const float* g) {
    const int gw = F.c * 8 + F.wave, NGW = F.G * 8;
    for (int m = gw; m < SEQ; m += NGW) rms_row_f32(x + (size_t)m * D, g, (f16*)(F.ws + WS_H) + (size_t)m * D, F.lane);
}

__device__ __forceinline__ void phase_router(const Frame& F, const Args& A, const float* x2) {
    const float* gf = A.in[19]; const float* wrg = A.in[20]; const float* brg = A.in[21]; const float* wre = A.in[22]; const float* bre = A.in[23];
    LAS float* lg = (LAS float*)(F.lds) + F.wave * 256;
    LAS int* hist = (LAS int*)(F.lds + 16384);
    int* histg = (int*)(F.ws + WS_HIST); int* toke = (int*)(F.ws + WS_TOKE); float* tokw = (float*)(F.ws + WS_TOKW);
    f16* h3 = (f16*)(F.ws + WS_H);
    const int lane = F.lane, nh = lane >> 5, kl = lane & 31;
    for (int ch = F.c; ch < SEQ / 32; ch += F.G) {
        if (F.tid < 32) hist[F.tid] = 0;
        __syncthreads();
        const int t0 = ch * 32 + F.wave * 4;
        float acc[4][18]; float ssq[4];
#pragma unroll
        for (int t = 0; t < 4; ++t) { ssq[t] = 0.f;
#pragma unroll
            for (int n = 0; n < 18; ++n) acc[t][n] = 0.f; }
        for (int j = 0; j < 8; ++j) { const int k8 = 8 * (kl + 32 * j);
            const f32x4 ga = *(const f32x4*)(gf + k8), gb = *(const f32x4*)(gf + k8 + 4);
            float xg[4][8];
#pragma unroll
            for (int t = 0; t < 4; ++t) { const f32x4 xa = *(const f32x4*)(x2 + (size_t)(t0 + t) * D + k8), xb = *(const f32x4*)(x2 + (size_t)(t0 + t) * D + k8 + 4);
                ssq[t] += xa[0] * xa[0] + xa[1] * xa[1] + xa[2] * xa[2] + xa[3] * xa[3] + xb[0] * xb[0] + xb[1] * xb[1] + xb[2] * xb[2] + xb[3] * xb[3];
#pragma unroll
                for (int i = 0; i < 4; ++i) { xg[t][i] = xa[i] * ga[i]; xg[t][4 + i] = xb[i] * gb[i]; } }
#pragma unroll
            for (int i = 0; i < 8; ++i) { const int k = k8 + i;
                const f32x4 w0 = *(const f32x4*)(wre + (size_t)k * 32 + 16 * nh), w1 = *(const f32x4*)(wre + (size_t)k * 32 + 16 * nh + 4),
                            w2 = *(const f32x4*)(wre + (size_t)k * 32 + 16 * nh + 8), w3 = *(const f32x4*)(wre + (size_t)k * 32 + 16 * nh + 12);
                const f32x2 wg = *(const f32x2*)(wrg + (size_t)k * 4 + 2 * nh);
#pragma unroll
                for (int t = 0; t < 4; ++t) { const float hv = xg[t][i];
#pragma unroll
                    for (int n = 0; n < 4; ++n) { acc[t][n] += hv * w0[n]; acc[t][4 + n] += hv * w1[n]; acc[t][8 + n] += hv * w2[n]; acc[t][12 + n] += hv * w3[n]; }
                    acc[t][16] += hv * wg[0]; acc[t][17] += hv * wg[1]; } } }
#pragma unroll
        for (int t = 0; t < 4; ++t) {
#pragma unroll
            for (int o = 1; o < 32; o <<= 1) ssq[t] += __shfl_xor(ssq[t], o);
#pragma unroll
            for (int n = 0; n < 18; ++n) {
#pragma unroll
                for (int o = 1; o < 32; o <<= 1) acc[t][n] += __shfl_xor(acc[t][n], o); } }
        float rs[4];
#pragma unroll
        for (int t = 0; t < 4; ++t) rs[t] = rsqrtf(ssq[t] * (1.0f / D) + EPS);
        if (kl == 0) {
#pragma unroll
            for (int t = 0; t < 4; ++t) {
#pragma unroll
                for (int n = 0; n < 16; ++n) lg[t * 40 + 4 + 16 * nh + n] = acc[t][n] * rs[t];
                lg[t * 40 + 2 * nh] = acc[t][16] * rs[t]; lg[t * 40 + 2 * nh + 1] = acc[t][17] * rs[t]; } }
        LDS_WAIT(); asm volatile("" ::: "memory");
        if (lane < 4) { const int t = lane; const LAS float* L = lg + t * 40;
            float g0 = L[0] + brg[0], g1 = L[1] + brg[1], g2 = L[2] + brg[2], g3 = L[3] + brg[3];
            int gi = 0; float gm = g0; if (g1 > gm) { gm = g1; gi = 1; } if (g2 > gm) { gm = g2; gi = 2; } if (g3 > gm) { gm = g3; gi = 3; }
            const float pg = 1.0f / (__expf(g0 - gm) + __expf(g1 - gm) + __expf(g2 - gm) + __expf(g3 - gm));
            float le[8];
#pragma unroll
            for (int i = 0; i < 8; ++i) le[i] = L[4 + gi * 8 + i] + bre[gi * 8 + i];
            int i1 = 0; float m1 = le[0];
#pragma unroll
            for (int i = 1; i < 8; ++i) if (le[i] > m1) { m1 = le[i]; i1 = i; }
            int i2 = -1; float m2 = -3.0e38f;
#pragma unroll
            for (int i = 0; i < 8; ++i) if (i != i1 && le[i] > m2) { m2 = le[i]; i2 = i; }
            const float ex = __expf(m2 - m1); const float w1 = pg / (1.0f + ex), w2 = pg * ex / (1.0f + ex);
            const int tok = t0 + t; const int e1 = gi * 8 + i1, e2 = gi * 8 + i2;
            toke[tok * 2] = e1; toke[tok * 2 + 1] = e2; tokw[tok * 2] = w1; tokw[tok * 2 + 1] = w2;
            atomicAdd((int*)(hist + e1), 1); atomicAdd((int*)(hist + e2), 1); }
#pragma unroll
        for (int t = 0; t < 4; ++t) { const float* xr = x2 + (size_t)(t0 + t) * D; f16* orow = h3 + (size_t)(t0 + t) * D;
            const float r = __shfl(rs[t], 0);
#pragma unroll
            for (int j = 0; j < 4; ++j) { const int col = 8 * (lane + 64 * j); const f32x4 a = *(const f32x4*)(xr + col) * r * *(const f32x4*)(gf + col), b = *(const f32x4*)(xr + col + 4) * r * *(const f32x4*)(gf + col + 4);
                u32x4 o; o.x = pk2h(a[0], a[1]); o.y = pk2h(a[2], a[3]); o.z = pk2h(b[0], b[1]); o.w = pk2h(b[2], b[3]);
                *(u32x4*)(orow + col) = o; } }
        __syncthreads();
        if (F.tid < 32) histg[ch * 32 + F.tid] = hist[F.tid];
        __syncthreads();
    }
}

__device__ __forceinline__ void phase_scatter(const Frame& F) {
    const int* histg = (const int*)(F.ws + WS_HIST); const int* toke = (const int*)(F.ws + WS_TOKE); const float* tokw = (const float*)(F.ws + WS_TOKW);
    int* totg = (int*)(F.ws + WS_TOT); int* tokslot = (int*)(F.ws + WS_TOKSLOT); float* slotw = (float*)(F.ws + WS_SLOTW);
    const f16* h3 = (const f16*)(F.ws + WS_H); f16* xs = (f16*)(F.ws + WS_XS);
    LAS int* ps = (LAS int*)F.lds;
    LAS int* tot = ps + 1024;
    LAS int* bas = ps + 1056;
    LAS int* sl = ps + 1088;
    const int tid = F.tid, lane = F.lane;
    for (int ch = F.c; ch < SEQ / 32; ch += F.G) {
        { const int e = tid & 31, part = tid >> 5; int s = 0, b = 0;
#pragma unroll
          for (int q = 0; q < 16; ++q) { const int cq = part * 16 + q; const int h = histg[cq * 32 + e]; s += h; b += (cq < ch) ? h : 0; }
          ps[part * 32 + e] = s; ps[512 + part * 32 + e] = b; }
        __syncthreads();
        if (tid < 32) { int s = 0, b = 0;
#pragma unroll
            for (int p = 0; p < 16; ++p) { s += ps[p * 32 + tid]; b += ps[512 + p * 32 + tid]; }
            tot[tid] = s; bas[tid] = b; }
        __syncthreads();
        if (tid < 32) { int pst = 0; for (int e = 0; e < tid; ++e) pst += (tot[e] + 255) >> 8; pst <<= 8;
            bas[tid] = pst + bas[tid];
            if (ch == 0) totg[tid] = tot[tid]; }
        __syncthreads();
        if (ch < 32) { int pst = 0; for (int e = 0; e < ch; ++e) pst += (tot[e] + 255) >> 8; pst <<= 8; const int n = tot[ch]; const int end = pst + (((n + 255) >> 8) << 8);
            for (int s = pst + n + tid; s < end; s += 512) slotw[s] = 0.f; }
        if (F.wave == 0) { const int a = lane; const int tok = ch * 32 + (a >> 1); const int e = toke[tok * 2 + (a & 1)]; const float wv = tokw[tok * 2 + (a & 1)];
            int rank = 0;
            for (int ee = 0; ee < 32; ++ee) { const unsigned long long mk = __ballot(e == ee); if (e == ee) rank = __popcll(mk & ((1ull << lane) - 1ull)); }
            const int slot = bas[e] + rank; sl[a] = slot; slotw[slot] = wv; tokslot[tok * 2 + (a & 1)] = slot; }
        __syncthreads();
#pragma unroll
        for (int r = 0; r < 8; ++r) { const int a = F.wave * 8 + r; const int tok = ch * 32 + (a >> 1); const int slot = sl[a];
            const u32x4* src = (const u32x4*)(h3 + (size_t)tok * D); u32x4* dst = (u32x4*)(xs + (size_t)slot * D);
#pragma unroll
            for (int j = 0; j < 4; ++j) dst[lane + 64 * j] = src[lane + 64 * j]; }
        __syncthreads();
    }
}
__device__ __forceinline__ void moe_table(const Frame& F) {
    const int* totg = (const int*)(F.ws + WS_TOT); LAS int* tab = (LAS int*)(F.lds + TAB_OFF);
    if (F.tid == 0) { int T = 0; for (int e = 0; e < NE; ++e) { const int n = totg[e]; const int te = (n + 255) >> 8; for (int q = 0; q < te; ++q) tab[1 + T + q] = e; T += te; } tab[0] = T; }
    __syncthreads();
}

__device__ __forceinline__ void phase_final(const Frame& F, const Args& A, float* out) {
    const int* tokslot = (const int*)(F.ws + WS_TOKSLOT); const f16* ys = (const f16*)(F.ws + WS_YS); const float* g = A.in[27];
    const int gw = F.c * 8 + F.wave, NGW = F.G * 8, lane = F.lane;
    for (int m = gw; m < SEQ; m += NGW) {
        const int s0 = tokslot[m * 2], s1 = tokslot[m * 2 + 1];
        f32x4 v[8]; float s = 0.f;
#pragma unroll
        for (int j = 0; j < 4; ++j) { const int col = 8 * (lane + 64 * j); const f32x4* p = (const f32x4*)(out + (size_t)m * D + col);
            const u32x4 y0 = *(const u32x4*)(ys + (size_t)s0 * D + col), y1 = *(const u32x4*)(ys + (size_t)s1 * D + col);
            f32x4 a = p[0], b = p[1];
            { const f32x2 q0 = unpk2h(y0.x), q1 = unpk2h(y1.x); a[0] += q0[0] + q1[0]; a[1] += q0[1] + q1[1]; }
            { const f32x2 q0 = unpk2h(y0.y), q1 = unpk2h(y1.y); a[2] += q0[0] + q1[0]; a[3] += q0[1] + q1[1]; }
            { const f32x2 q0 = unpk2h(y0.z), q1 = unpk2h(y1.z); b[0] += q0[0] + q1[0]; b[1] += q0[1] + q1[1]; }
            { const f32x2 q0 = unpk2h(y0.w), q1 = unpk2h(y1.w); b[2] += q0[0] + q1[0]; b[3] += q0[1] + q1[1]; }
            v[2 * j] = a; v[2 * j + 1] = b;
            s += a[0] * a[0] + a[1] * a[1] + a[2] * a[2] + a[3] * a[3] + b[0] * b[0] + b[1] * b[1] + b[2] * b[2] + b[3] * b[3]; }
        const float rs = rsqrtf(wave_sum(s) * (1.0f / D) + EPS);
#pragma unroll
        for (int j = 0; j < 4; ++j) { const int col = 8 * (lane + 64 * j); f32x4* p = (f32x4*)(out + (size_t)m * D + col);
            p[0] = v[2 * j] * rs * *(const f32x4*)(g + col); p[1] = v[2 * j + 1] * rs * *(const f32x4*)(g + col + 4); }
    }
}

#define GEMM_PHASE pg8::gemm_phase_simple

__global__ void __launch_bounds__(512, 2) fwd(Args args) {
    extern __shared__ __attribute__((aligned(16))) unsigned char lds_raw[];
    Frame F;
    F.lds = (LAS unsigned char*)lds_raw; F.ws = args.ws;
    F.tid = threadIdx.x; F.lane = F.tid & 63; F.wave = __builtin_amdgcn_readfirstlane(F.tid >> 6);
    F.G = gridDim.x; F.c = blockIdx.x;
    volatile LAS unsigned* MISC = (volatile LAS unsigned*)(F.lds + MISC_OFF);
    if (F.tid < 64) MISC[F.tid] = 0u;
    __syncthreads();
    XcdBarrier bar; bar.bar = (unsigned*)(args.ws + WS_CTL) + CW_BAR; bar.x = 0; bar.st = nullptr;
    if (MK_N_LAUNCHES == 1) bar = xcd_barrier_post((unsigned*)(args.ws + WS_CTL) + CW_BAR, MISC + 8);
    const int lo = args.ph_lo, hi = args.ph_hi;
#ifndef ONLY_PHASE
#define ONLY_PHASE -1
#endif
#define IN(k) ((ONLY_PHASE < 0 || (k) == ONLY_PHASE) && lo <= (k) && (k) < hi)
#define SEAM(k) do { if (IN(k) && IN((k) + 1)) xcd_barrier(bar); } while (0)
    unsigned char* ws = args.ws; float* out = args.out;
    const char* wsc = (const char*)ws;

    if (IN(0)) { phase_prep(F, args); } SEAM(0);
    if (IN(1)) { SchedP1 S{F.G, F.c, wsc + WS_H, wsc + WS_WIN, wsc + WS_M16, wsc + WS_WKV, (char*)(ws + WS_PROJ), (char*)(ws + WS_K16), (char*)(ws + WS_VT16)};
        EpiF16 E{nullptr, 1.0f};
        GEMM_PHASE<EpiF16, SchedP1>(F.lds, D, D, S, E); } SEAM(1);
    if (IN(2)) { phase_mixpre(F, args); } SEAM(2);
    if (IN(3)) { SchedG2 S{F.G, F.c, wsc + WS_DC, wsc + WS_WPW, wsc + WS_WPOOL, (char*)(ws + WS_Y)};
        EpiF16 E{args.in[5], 1.0f};
        GEMM_PHASE<EpiF16, SchedG2>(F.lds, D, 1024, S, E); } SEAM(3);
    if (IN(4)) { phase_rownorm(F, args); } SEAM(4);
    if (IN(5)) { SchedDense S{F.G, F.c, wsc + WS_YN, wsc + WS_WOUT, nullptr}; EpiResF32 E{args.in[0], out, D};
        GEMM_PHASE<EpiResF32, SchedDense>(F.lds, D, D, S, E); } SEAM(5);
    if (IN(6)) { phase_norm_x(F, out, args.in[14]); } SEAM(6);
    if (IN(7)) { SchedDense S{F.G, F.c, wsc + WS_H, wsc + WS_WQ, (char*)(ws + WS_Q)};
        EpiF16 E{nullptr, 0.044194173824159216f};
        GEMM_PHASE<EpiF16, SchedDense>(F.lds, D, D, S, E); } SEAM(7);
    if (IN(8)) { SchedS S{F.G, F.c, wsc + WS_Q, wsc + WS_K16}; EpiSoftmax E{(f16*)(ws + WS_P)};
        GEMM_PHASE<EpiSoftmax, SchedS>(F.lds, D, D, S, E); } SEAM(8);
    if (IN(9)) { SchedPV S{F.G, F.c, wsc + WS_P, wsc + WS_VT16, (char*)(ws + WS_O)};
        EpiF16 E{nullptr, 1.0f};
        GEMM_PHASE<EpiF16, SchedPV>(F.lds, 256, 256, S, E); } SEAM(9);
    if (IN(10)) { SchedDense S{F.G, F.c, wsc + WS_O, wsc + WS_WO, nullptr}; EpiResF32 E{out, out, D};
        GEMM_PHASE<EpiResF32, SchedDense>(F.lds, D, D, S, E); } SEAM(10);
    if (IN(11)) { phase_router(F, args, out); } SEAM(11);
    if (IN(12)) { phase_scatter(F); } SEAM(12);
    if (IN(13)) { moe_table(F); SchedGU S{F.G, F.c, wsc + WS_XS, wsc + WS_WGU, (const LAS int*)(F.lds + TAB_OFF)}; EpiSwiGLU E{(f16*)(ws + WS_HID)};
        GEMM_PHASE<EpiSwiGLU, SchedGU>(F.lds, D, D, S, E); } SEAM(13);
    if (IN(14)) { moe_table(F); SchedDN S{F.G, F.c, wsc + WS_HID, wsc + WS_WDN, (const LAS int*)(F.lds + TAB_OFF)}; EpiDown E{(f16*)(ws + WS_YS), (const float*)(ws + WS_SLOTW)};
        GEMM_PHASE<EpiDown, SchedDN>(F.lds, DE, DE, S, E); } SEAM(14);
    if (IN(15)) { phase_final(F, args, out); }
#undef IN
#undef SEAM
}

extern "C" void kernel_launch(void* const* d_in, const int* in_sizes, int n_in, void* d_out, int out_size, void* d_ws, size_t ws_size, hipStream_t stream) {
    static int grid = 0;
    if (grid == 0) {
        if (n_in != 28 || out_size != SEQ * D || ws_size < WS_END) { fprintf(stderr, "kernel_launch: unexpected sizes n_in %d out %d ws %zu\n", n_in, out_size, ws_size); grid = -1; return; }
        int dev = 0, cus = 0;
        if (hipGetDevice(&dev) != hipSuccess || hipDeviceGetAttribute(&cus, hipDeviceAttributeMultiprocessorCount, dev) != hipSuccess) { grid = -1; return; }
        if (hipFuncSetAttribute((const void*)fwd, hipFuncAttributeMaxDynamicSharedMemorySize, LDS_BYTES) != hipSuccess) { grid = -1; return; }
        int per_cu = 0;
        (void)hipOccupancyMaxActiveBlocksPerMultiprocessor(&per_cu, (const void*)fwd, 512, LDS_BYTES);
        (void)hipGetLastError();
        grid = cus;
    }
    if (grid < 0) return;
    (void)hipMemsetAsync((char*)d_ws + WS_CTL, 0, CTL_ZERO_BYTES, stream);
    Args a{};
    for (int i = 0; i < 28; ++i) a.in[i] = (const float*)d_in[i];
    a.out = (float*)d_out; a.ws = (unsigned char*)d_ws;
    if (MK_N_LAUNCHES == 1) { a.ph_lo = 0; a.ph_hi = NPHASE; a.li = 0; hipLaunchKernelGGL(fwd, dim3(grid), dim3(512), LDS_BYTES, stream, a); }
    else { for (int p = 0; p < NPHASE; ++p) { a.ph_lo = p; a.ph_hi = p + 1; a.li = p; hipLaunchKernelGGL(fwd, dim3(grid), dim3(512), LDS_BYTES, stream, a); } }
}
```

```cpp
#include <hip/hip_runtime.h>
#include <cstdio>
#include <cstdint>

#ifndef MK_N_LAUNCHES
#define MK_N_LAUNCHES 1
#endif
#ifndef EXTRA_PHASE
#define EXTRA_PHASE -1
#endif
#ifndef EXTRA_REQUEUE
#define EXTRA_REQUEUE 0
#endif
#ifndef EXTRA_N
#define EXTRA_N 2
#endif
#ifndef FAST_GEMM
#define FAST_GEMM 1
#endif

#define LAS __attribute__((address_space(3)))
#define GAS __attribute__((address_space(1)))
typedef _Float16 f16;
typedef _Float16 f16x8 __attribute__((ext_vector_type(8)));
typedef _Float16 f16x2 __attribute__((ext_vector_type(2)));
typedef float f32x4 __attribute__((ext_vector_type(4)));
typedef float f32x2 __attribute__((ext_vector_type(2)));
typedef unsigned u32x4 __attribute__((ext_vector_type(4)));
typedef unsigned u32x2 __attribute__((ext_vector_type(2)));

constexpr int SEQ = 8192, D = 2048, NPROJ = 3072, MEMLEN = 256, NHEAD = 4, HD = 512, NE = 32, DE = 512, CK = 31;
constexpr float EPS = 1e-6f;
constexpr int NPHASE = 16;

constexpr size_t MiB = 1u << 20;
constexpr size_t WS_CTL = 0, CTL_ZERO_BYTES = 65536;
constexpr size_t WS_HIST = 65536;
constexpr size_t WS_TOT = 98304;
constexpr size_t WS_TOKE = 131072;
constexpr size_t WS_TOKW = 196608;
constexpr size_t WS_TOKSLOT = 262144;
constexpr size_t WS_SLOTW = 327680;
constexpr size_t WS_TOKRS = 458752;
constexpr size_t WS_M16 = 1 * MiB, WS_K16 = 2 * MiB, WS_VT16 = 3 * MiB;
constexpr size_t WS_WIN = 8 * MiB, WS_WPOOL = 20 * MiB, WS_WPW = 22 * MiB, WS_WOUT = 24 * MiB, WS_WQ = 32 * MiB, WS_WKV = 40 * MiB, WS_WO = 56 * MiB,
                 WS_WGU = 64 * MiB, WS_WDN = 192 * MiB;
constexpr size_t WS_PROJ = 256 * MiB, WS_DC = 304 * MiB, WS_XS = 256 * MiB;
constexpr size_t WS_H = 352 * MiB, WS_Y = 384 * MiB, WS_YN = 416 * MiB, WS_YS = 352 * MiB;
constexpr size_t WS_Q = 448 * MiB, WS_P = 480 * MiB, WS_O = 496 * MiB, WS_HID = 448 * MiB;
constexpr size_t WS_END = 528 * MiB;
constexpr int CW_BAR = 4096;

constexpr int RING_BYTES = 131072;
constexpr int MISC_OFF = RING_BYTES;
constexpr int TAB_OFF = RING_BYTES + 256;
constexpr int LDS_BYTES = 147456;

#define LDS_WAIT() asm volatile("s_waitcnt lgkmcnt(0)" ::: "memory")
#define VM_WAIT() asm volatile("s_waitcnt vmcnt(0)" ::: "memory")

__device__ __forceinline__ unsigned pk2h(float lo, float hi) { f32x2 v = {lo, hi}; f16x2 h = __builtin_convertvector(v, f16x2); return __builtin_bit_cast(unsigned, h); }
__device__ __forceinline__ f32x2 unpk2h(unsigned u) { f16x2 h = __builtin_bit_cast(f16x2, u); return __builtin_convertvector(h, f32x2); }
__device__ __forceinline__ float wave_sum(float v) {
#pragma unroll
    for (int o = 1; o < 64; o <<= 1) v += __shfl_xor(v, o);
    return v;
}
__device__ __forceinline__ float fast_sigmoid(float x) { return __builtin_amdgcn_rcpf(1.0f + __expf(-x)); }

#define XB_TMO      128
#define XB_XCNT(j)  (256  + 64 * (j))
#define XB_XSUB(j)  (1280 + 64 * (j))
#define XB_XGEN(j)  (2304 + 64 * (j))
#define XB_TOP      3328
#define XB_TOPGEN   3392
#define XCD_BAR_WORDS 3456
#define XB_SPIN_CAP (1u << 18)
__device__ __forceinline__ unsigned xb_ld(unsigned* p)              { return __hip_atomic_load(p, __ATOMIC_RELAXED, __HIP_MEMORY_SCOPE_AGENT); }
__device__ __forceinline__ unsigned xb_add(unsigned* p, unsigned v) { return __hip_atomic_fetch_add(p, v, __ATOMIC_RELAXED, __HIP_MEMORY_SCOPE_AGENT); }
__device__ __forceinline__ unsigned xb_xcc_id() { return (unsigned)__builtin_amdgcn_s_getreg((3 << 11) | 20) & 0xFu; }
#define XB_SPIN(cond, bar) do { unsigned _sp = 0; while (cond) { __builtin_amdgcn_s_sleep(1); \
    if ((++_sp & 255u) == 0u) { if (xb_ld(&(bar)[XB_TMO])) break; if (_sp > XB_SPIN_CAP) { atomicAdd(&(bar)[XB_TMO], 1u); break; } } } } while (0)
struct XcdBarrier { unsigned* bar; unsigned x; volatile LAS unsigned* st; };
__device__ __forceinline__ XcdBarrier xcd_barrier_post(unsigned* bar, volatile LAS unsigned* st) {
    XcdBarrier b; b.bar = bar; b.x = xb_xcc_id(); b.st = st;
    if (threadIdx.x == 0) (void)xb_add(&bar[XB_XCNT(b.x)], 1u);
    return b;
}
__device__ __forceinline__ void xcd_barrier_complete(unsigned* bar, unsigned x, unsigned& nloc, unsigned& nx) {
    const unsigned G = gridDim.x * gridDim.y * gridDim.z;
    unsigned sum, cnt, mine, sp = 0u;
    for (;;) {
        sum = 0u; cnt = 0u; mine = 0u;
#pragma unroll
        for (unsigned j = 0; j < 16; ++j) { const unsigned c = xb_ld(&bar[XB_XCNT(j)]); sum += c; cnt += (c > 0u) ? 1u : 0u; mine = (j == x) ? c : mine; }
        if (sum == G) break;
        __builtin_amdgcn_s_sleep(1);
        if ((++sp & 255u) == 0u) { if (xb_ld(&bar[XB_TMO])) break; if (sp > XB_SPIN_CAP) { atomicAdd(&bar[XB_TMO], 1u); break; } }
    }
    nloc = mine > 0u ? mine : 1u; nx = cnt > 0u ? cnt : 1u;
}
__device__ __forceinline__ void xcd_barrier(const XcdBarrier& b) {
    asm volatile("s_waitcnt vmcnt(0)" ::: "memory");
    __syncthreads();
    if (threadIdx.x == 0) {
        unsigned* bar = b.bar;
        __builtin_amdgcn_s_waitcnt(0);
        unsigned nloc = b.st[0], nx = b.st[1];
        if (nloc == 0u) { xcd_barrier_complete(bar, b.x, nloc, nx); b.st[0] = nloc; b.st[1] = nx; }
        const unsigned old = xb_add(&bar[XB_XSUB(b.x)], 1u);
        const unsigned gen = old / nloc;
        if (old + 1u == (gen + 1u) * nloc) {
            __builtin_amdgcn_fence(__ATOMIC_RELEASE, "agent");
            asm volatile("s_waitcnt vmcnt(0)" ::: "memory");
            const unsigned og = xb_add(&bar[XB_TOP], 1u);
            const unsigned tg = og / nx;
            if (og + 1u == (tg + 1u) * nx) xb_add(&bar[XB_TOPGEN], 1u);
            else XB_SPIN(xb_ld(&bar[XB_TOPGEN]) == tg, bar);
            __builtin_amdgcn_fence(__ATOMIC_ACQUIRE, "agent");
            xb_add(&bar[XB_XGEN(b.x)], 1u);
            asm volatile("s_waitcnt vmcnt(0)" ::: "memory");
        } else {
            XB_SPIN(xb_ld(&bar[XB_XGEN(b.x)]) == gen, bar);
            __builtin_amdgcn_fence(__ATOMIC_ACQUIRE, "agent");
            asm volatile("s_waitcnt vmcnt(0)" ::: "memory");
        }
    }
    __syncthreads();
}

namespace pg8 {
constexpr int BM = 256, BK = 64, HALF = 128, HTB = HALF * BK * 2, STAGE_BYTES = 8 * HTB, NXCD = 8, WGM = 8;
__host__ __device__ __forceinline__ int lds_byte(int r, int c) { const int st = (r >> 4) * 2 + (c >> 5), rr = r & 15, cc = c & 31, ob = rr * 64 + cc * 2; return st * 1024 + (ob ^ (((ob >> 9) & 1) << 5)); }
__host__ __device__ __forceinline__ void stage_rc(int b, int& R, int& C) { const int st = b / 1024, sb = b % 1024, swz = sb ^ (((sb >> 9) & 1) << 5); R = (st >> 1) * 16 + swz / 64; C = (st & 1) * 32 + (swz % 64) / 2; }
__host__ __device__ __forceinline__ int perm32(int rho) { const int n = rho >> 4, i = rho & 15; return 8 * (i >> 2) + 4 * n + (i & 3); }

struct Unit { const char* a; const char* b; char* o; int ldc; int nt; int r0, c0, kind, aux; };

__device__ __forceinline__ void tile_of(int L, int nM, int nN, int& pm, int& pn) {
    const int nwg = nM * nN; int wgid = L;
    { const int q = nwg / NXCD, r = nwg % NXCD, xcd = wgid % NXCD, off = wgid / NXCD; wgid = (xcd < r ? xcd * (q + 1) : r * (q + 1) + (xcd - r) * q) + off; }
    const int nig = WGM * nN, gid = wgid / nig, fm = gid * WGM, gsz = (nM - fm) < WGM ? (nM - fm) : WGM;
    pm = fm + ((wgid % nig) % gsz); pn = (wgid % nig) / gsz;
}
__device__ __forceinline__ void tile_of_w(int wgid, int nM, int nN, int& pm, int& pn) {
    const int nig = WGM * nN, gid = wgid / nig, fm = gid * WGM, gsz = (nM - fm) < WGM ? (nM - fm) : WGM;
    pm = fm + ((wgid % nig) % gsz); pn = (wgid % nig) / gsz;
}
__device__ __forceinline__ int xcd_chunk(int L, int nwg) {
    const int q = nwg / NXCD, r = nwg % NXCD, xcd = L % NXCD, off = L / NXCD; return (xcd < r ? xcd * (q + 1) : r * (q + 1) + (xcd - r) * q) + off;
}

typedef f32x4 Acc[2][2][4][2];

template <class Epi, class Sched>
__device__ __forceinline__ void gemm_phase_simple(LAS unsigned char* lds, int lda, int ldb, const Sched& S, const Epi& E) {
    const int tid = threadIdx.x, wid = __builtin_amdgcn_readfirstlane(tid >> 6), lane = tid & 63, wr = wid >> 2, wc = wid & 3, fr = lane & 15, fq = lane >> 4;
    Unit u;
    for (int ui = 0; S.next(ui, u); ++ui) {
        Acc acc;
#pragma unroll
        for (int a = 0; a < 2; ++a)
#pragma unroll
            for (int b = 0; b < 2; ++b)
#pragma unroll
                for (int m = 0; m < 4; ++m)
#pragma unroll
                    for (int n = 0; n < 2; ++n) acc[a][b][m][n] = (f32x4){0.f, 0.f, 0.f, 0.f};
        for (int ks = 0; ks < u.nt * 2; ++ks) {
            f16x8 Af[2][4], Bf[2][2];
            const size_t kb = (size_t)(ks * 32 + fq * 8) * 2;
#pragma unroll
            for (int ai = 0; ai < 2; ++ai)
#pragma unroll
                for (int m = 0; m < 4; ++m) Af[ai][m] = *(const f16x8*)(u.a + (size_t)(ai * 128 + wr * 64 + m * 16 + fr) * lda * 2 + kb);
#pragma unroll
            for (int bj = 0; bj < 2; ++bj)
#pragma unroll
                for (int n = 0; n < 2; ++n) { const int rr = Epi::PERM ? (8 * (fr >> 2) + 4 * n + (fr & 3)) : (n * 16 + fr);
                    Bf[bj][n] = *(const f16x8*)(u.b + (size_t)(bj * 128 + wc * 32 + rr) * ldb * 2 + kb); }
#pragma unroll
            for (int ai = 0; ai < 2; ++ai)
#pragma unroll
                for (int bj = 0; bj < 2; ++bj)
#pragma unroll
                    for (int m = 0; m < 4; ++m)
#pragma unroll
                        for (int n = 0; n < 2; ++n) acc[ai][bj][m][n] = __builtin_amdgcn_mfma_f32_16x16x32_f16(Bf[bj][n], Af[ai][m], acc[ai][bj][m][n], 0, 0, 0);
        }
        if constexpr (Epi::AFTER_DRAIN) { __syncthreads(); E.fused(acc, u, wr, wc, fr, fq, lds, wid, lane); __syncthreads(); }
        else E(acc, u, wr, wc, fr, fq);
    }
}
#define PG8_LAS LAS
template <class Epi, class Sched, bool ALIGN_EPI = false, bool SP2 = false>
__device__ __forceinline__ void gemm_phase(PG8_LAS unsigned char* lds, const int lda, const int ldb, const Sched& S, const Epi& E) {
    const int tid = threadIdx.x, wid = __builtin_amdgcn_readfirstlane(tid >> 6), lane = tid & 63, wr = wid >> 2, wc = wid & 3, fr = lane & 15, fq = lane >> 4;
    unsigned voffA[2], voffB[2];
#pragma unroll
    for (int i = 0; i < 2; ++i) { int R, C; stage_rc(tid * 16 + i * 8192, R, C); const int Rb = Epi::PERM ? ((R & ~31) + perm32(R & 31)) : R;
        voffA[i] = (unsigned)(R * lda + C) * 2u; voffB[i] = (unsigned)(Rb * ldb + C) * 2u; }
    const size_t kstep = (size_t)(BK * 2);
    const size_t hstepA = (size_t)HALF * lda * 2, hstepB = (size_t)HALF * ldb * 2;
    const unsigned ldsw = (unsigned)wid * 1024u;
    const int aoff = lds_byte(wr * 64 + fr, fq * 8), boff = lds_byte(wc * 32 + fr, fq * 8);
#define PG8_SA(b, h) (((b) * 2 + (h)) * HTB)
#define PG8_SB(b, h) ((4 + (b) * 2 + (h)) * HTB)
#define PG8_STAGE(bufoff, gbase, voff) do { _Pragma("unroll") for (int _i = 0; _i < 2; ++_i) \
        __builtin_amdgcn_global_load_lds((const unsigned*)((const char*)(gbase) + (voff)[_i]), (PG8_LAS unsigned*)(lds + (bufoff) + ldsw + _i * 8192), 16, 0, 0); } while (0)
#define PG8_LDA(dst, b, h) do { _Pragma("unroll") for (int m = 0; m < 4; ++m) _Pragma("unroll") for (int k = 0; k < 2; ++k) dst[m][k] = *(const PG8_LAS f16x8*)(lds + PG8_SA(b, h) + aoff + m * 2048 + k * 1024); } while (0)
#define PG8_LDB(dst, b, h) do { _Pragma("unroll") for (int n = 0; n < 2; ++n) _Pragma("unroll") for (int k = 0; k < 2; ++k) dst[n][k] = *(const PG8_LAS f16x8*)(lds + PG8_SB(b, h) + boff + n * 2048 + k * 1024); } while (0)
#define PG8_MMA(ai, bj, At, Bt) do { __builtin_amdgcn_s_setprio(1); _Pragma("unroll") for (int m = 0; m < 4; ++m) _Pragma("unroll") for (int n = 0; n < 2; ++n) _Pragma("unroll") for (int k = 0; k < 2; ++k) \
        acc[ai][bj][m][n] = __builtin_amdgcn_mfma_f32_16x16x32_f16(Bt[n][k], At[m][k], acc[ai][bj][m][n], 0, 0, 0); __builtin_amdgcn_s_setprio(0); } while (0)
#define PG8_WAIT_V(n) asm volatile("s_waitcnt vmcnt(" #n ")" ::: "memory")
#define PG8_WAIT_L(n) asm volatile("s_waitcnt lgkmcnt(" #n ")" ::: "memory")
#define PG8_BAR __builtin_amdgcn_s_barrier()
#define PG8_SCHED __builtin_amdgcn_sched_barrier(0)
    Unit cur, nxt; int ui = 0;
    if (!S.next(0, cur)) return;
    f32x4 acc[2][2][4][2];
#pragma unroll
    for (int a = 0; a < 2; ++a)
#pragma unroll
        for (int b = 0; b < 2; ++b)
#pragma unroll
            for (int m = 0; m < 4; ++m)
#pragma unroll
                for (int n = 0; n < 2; ++n) acc[a][b][m][n] = (f32x4){0.f, 0.f, 0.f, 0.f};
    f16x8 At[4][2], B0[2][2], B1[2][2];
    const char* cA = cur.a; const char* cB = cur.b;
    if constexpr (SP2) {
        PG8_STAGE(PG8_SB(0, 0), cB, voffB); PG8_STAGE(PG8_SB(0, 1), cB + hstepB, voffB); PG8_STAGE(PG8_SA(0, 0), cA, voffA); PG8_STAGE(PG8_SA(0, 1), cA + hstepA, voffA);
        if (wr == 1) PG8_BAR;
        PG8_WAIT_V(2); PG8_BAR;
        PG8_STAGE(PG8_SB(1, 0), cB + kstep, voffB); PG8_STAGE(PG8_SA(1, 0), cA + kstep, voffA); PG8_STAGE(PG8_SB(1, 1), cB + hstepB + kstep, voffB);
        PG8_WAIT_V(6); PG8_BAR;
    } else {
        PG8_STAGE(PG8_SB(0, 0), cB, voffB); PG8_STAGE(PG8_SA(0, 0), cA, voffA); PG8_STAGE(PG8_SB(0, 1), cB + hstepB, voffB); PG8_STAGE(PG8_SA(0, 1), cA + hstepA, voffA);
        if (wr == 1) PG8_BAR;
        PG8_WAIT_V(4); PG8_BAR;
        PG8_STAGE(PG8_SB(1, 0), cB + kstep, voffB); PG8_STAGE(PG8_SA(1, 0), cA + kstep, voffA); PG8_STAGE(PG8_SB(1, 1), cB + hstepB + kstep, voffB);
        PG8_WAIT_V(6); PG8_BAR;
    }
    for (;;) {
        const bool has_next = S.next(ui + 1, nxt);
        const char* nA = has_next ? nxt.a : cA; const char* nB = has_next ? nxt.b : cB; int nt = cur.nt; asm volatile("" : "+s"(nt));
#pragma unroll 1
        for (int t = 0; t < nt; t += 2) {
            const bool last = (t == nt - 2);
            const char* a1 = cA + (size_t)(t + 1) * kstep;
            const char* a2 = last ? nA : cA + (size_t)(t + 2) * kstep; const char* b2 = last ? nB : cB + (size_t)(t + 2) * kstep;
            const char* a3 = a2 + kstep; const char* b3 = b2 + kstep;
            if constexpr (SP2) {
            PG8_LDB(B0, 0, 0); PG8_LDB(B1, 0, 1); PG8_SCHED; PG8_LDA(At, 0, 0); PG8_STAGE(PG8_SA(1, 1), a1 + hstepA, voffA);
            PG8_WAIT_V(8); PG8_WAIT_L(0); PG8_BAR; PG8_MMA(0, 0, At, B0); PG8_MMA(0, 1, At, B1); PG8_BAR; PG8_SCHED;
            PG8_LDA(At, 0, 1); PG8_STAGE(PG8_SB(0, 0), b2, voffB); PG8_STAGE(PG8_SB(0, 1), b2 + hstepB, voffB); PG8_STAGE(PG8_SA(0, 0), a2, voffA);
            PG8_WAIT_V(8); PG8_WAIT_L(0); PG8_BAR; PG8_MMA(1, 0, At, B0); PG8_MMA(1, 1, At, B1); PG8_BAR; PG8_SCHED;
            PG8_LDB(B0, 1, 0); PG8_LDB(B1, 1, 1); PG8_SCHED; PG8_LDA(At, 1, 0); PG8_STAGE(PG8_SA(0, 1), a2 + hstepA, voffA);
            PG8_WAIT_V(8); PG8_WAIT_L(0); PG8_BAR; PG8_MMA(0, 0, At, B0); PG8_MMA(0, 1, At, B1); PG8_BAR; PG8_SCHED;
            PG8_LDA(At, 1, 1); PG8_STAGE(PG8_SB(1, 0), b3, voffB); PG8_STAGE(PG8_SB(1, 1), b3 + hstepB, voffB); PG8_STAGE(PG8_SA(1, 0), a3, voffA);
            PG8_WAIT_V(8); PG8_WAIT_L(0); PG8_BAR; PG8_MMA(1, 0, At, B0); PG8_MMA(1, 1, At, B1); PG8_BAR; PG8_SCHED;
            } else {
            PG8_LDB(B0, 0, 0); PG8_SCHED; PG8_LDA(At, 0, 0); PG8_STAGE(PG8_SA(1, 1), a1 + hstepA, voffA);
            PG8_WAIT_L(8); PG8_BAR; PG8_WAIT_L(0); PG8_MMA(0, 0, At, B0); PG8_BAR; PG8_SCHED;
            PG8_LDB(B1, 0, 1); PG8_STAGE(PG8_SB(0, 0), b2, voffB);
            PG8_BAR; PG8_WAIT_L(0); PG8_MMA(0, 1, At, B1); PG8_BAR;
            PG8_LDA(At, 0, 1); PG8_STAGE(PG8_SA(0, 0), a2, voffA);
            PG8_BAR; PG8_WAIT_L(0); PG8_MMA(1, 0, At, B0); PG8_BAR; PG8_SCHED;
            PG8_STAGE(PG8_SB(0, 1), b2 + hstepB, voffB);
            PG8_WAIT_V(6); PG8_BAR; PG8_MMA(1, 1, At, B1); PG8_BAR;
            PG8_LDB(B0, 1, 0); PG8_SCHED; PG8_LDA(At, 1, 0); PG8_STAGE(PG8_SA(0, 1), a2 + hstepA, voffA);
            PG8_WAIT_L(8); PG8_BAR; PG8_WAIT_L(0); PG8_MMA(0, 0, At, B0); PG8_BAR; PG8_SCHED;
            PG8_LDB(B1, 1, 1); PG8_STAGE(PG8_SB(1, 0), b3, voffB);
            PG8_BAR; PG8_WAIT_L(0); PG8_MMA(0, 1, At, B1); PG8_BAR;
            PG8_LDA(At, 1, 1); PG8_STAGE(PG8_SA(1, 0), a3, voffA);
            PG8_BAR; PG8_WAIT_L(0); PG8_MMA(1, 0, At, B0); PG8_BAR; PG8_SCHED;
            PG8_STAGE(PG8_SB(1, 1), b3 + hstepB, voffB);
            PG8_WAIT_V(6); PG8_BAR; PG8_MMA(1, 1, At, B1); PG8_BAR;
            }
        }
        if constexpr (ALIGN_EPI) { if (wr == 0) PG8_BAR; }
        if constexpr (!Epi::AFTER_DRAIN) { E(acc, cur, wr, wc, fr, fq); }
        if (!has_next) break;
#pragma unroll
        for (int a = 0; a < 2; ++a)
#pragma unroll
            for (int b = 0; b < 2; ++b)
#pragma unroll
                for (int m = 0; m < 4; ++m)
#pragma unroll
                    for (int n = 0; n < 2; ++n) acc[a][b][m][n] = (f32x4){0.f, 0.f, 0.f, 0.f};
        cur = nxt; cA = nA; cB = nB; ++ui;
        if constexpr (ALIGN_EPI) { if (wr == 1) PG8_BAR; }
    }
    PG8_WAIT_V(0);
    if constexpr (!ALIGN_EPI) { if (wr == 0) PG8_BAR; }
    PG8_BAR;
    if constexpr (Epi::AFTER_DRAIN) { E.fused(acc, cur, wr, wc, fr, fq, lds, wid, lane); }
#undef PG8_SA
#undef PG8_SB
#undef PG8_STAGE
#undef PG8_LDA
#undef PG8_LDB
#undef PG8_MMA
#undef PG8_WAIT_V
#undef PG8_WAIT_L
#undef PG8_BAR
#undef PG8_SCHED
}
}
using pg8::Unit; using pg8::Acc;

struct EpiF16 {
    static constexpr bool PERM = true, AFTER_DRAIN = false;
    const float* cs0; float scale;
    __device__ __forceinline__ void operator()(const Acc& acc, const Unit& u, int wr, int wc, int fr, int fq) const {
        f16* base = (f16*)u.o; const int ldc = u.ldc;
        const int row0 = u.r0 + wr * 64 + fr, col0 = u.c0 + wc * 32 + 8 * fq;
        f32x4 sv[2][2];
        const bool has_cs = (u.kind == 0) && (cs0 != nullptr);
#pragma unroll
        for (int bj = 0; bj < 2; ++bj)
#pragma unroll
            for (int n = 0; n < 2; ++n) { sv[bj][n] = (f32x4){scale, scale, scale, scale}; if (has_cs) sv[bj][n] = sv[bj][n] * *(const f32x4*)(cs0 + col0 + bj * 128 + 4 * n); }
#pragma unroll
        for (int ai = 0; ai < 2; ++ai)
#pragma unroll
            for (int m = 0; m < 4; ++m) { f16* rowp = base + (size_t)(row0 + ai * 128 + m * 16) * ldc + col0;
#pragma unroll
                for (int bj = 0; bj < 2; ++bj) { const f32x4 v0 = acc[ai][bj][m][0] * sv[bj][0], v1 = acc[ai][bj][m][1] * sv[bj][1];
                    u32x4 w; w.x = pk2h(v0[0], v0[1]); w.y = pk2h(v0[2], v0[3]); w.z = pk2h(v1[0], v1[1]); w.w = pk2h(v1[2], v1[3]);
                    *(u32x4*)(rowp + bj * 128) = w; } }
    }
};
struct EpiResF32 {
    static constexpr bool PERM = false, AFTER_DRAIN = false;
    const float* base; float* out; int ldc;
    __device__ __forceinline__ void operator()(const Acc& acc, const Unit& u, int wr, int wc, int fr, int fq) const {
        const int row0 = u.r0 + wr * 64 + fr, col0 = u.c0 + wc * 32 + 4 * fq;
#pragma unroll
        for (int ai = 0; ai < 2; ++ai)
#pragma unroll
            for (int m = 0; m < 4; ++m) { const size_t off = (size_t)(row0 + ai * 128 + m * 16) * ldc + col0;
#pragma unroll
                for (int bj = 0; bj < 2; ++bj)
#pragma unroll
                    for (int n = 0; n < 2; ++n) { const f32x4 bs = *(const f32x4*)(base + off + bj * 128 + n * 16); *(f32x4*)(out + off + bj * 128 + n * 16) = bs + acc[ai][bj][m][n]; } }
    }
};
struct EpiSwiGLU {
    static constexpr bool PERM = true, AFTER_DRAIN = false;
    f16* hid;
    __device__ __forceinline__ void operator()(const Acc& acc, const Unit& u, int wr, int wc, int fr, int fq) const {
        const int row0 = u.r0 + wr * 64 + fr, col0 = u.c0 + wc * 32 + 8 * fq;
#pragma unroll
        for (int ai = 0; ai < 2; ++ai)
#pragma unroll
            for (int m = 0; m < 4; ++m) { f16* rowp = hid + (size_t)(row0 + ai * 128 + m * 16) * DE + col0;
                float h[8];
#pragma unroll
                for (int n = 0; n < 2; ++n)
#pragma unroll
                    for (int j = 0; j < 4; ++j) { const float g = acc[ai][0][m][n][j], up = acc[ai][1][m][n][j]; h[n * 4 + j] = g * fast_sigmoid(g) * up; }
                u32x4 w; w.x = pk2h(h[0], h[1]); w.y = pk2h(h[2], h[3]); w.z = pk2h(h[4], h[5]); w.w = pk2h(h[6], h[7]);
                *(u32x4*)rowp = w; }
    }
};
struct EpiDown {
    static constexpr bool PERM = true, AFTER_DRAIN = false;
    f16* ys; const float* slot_w;
    __device__ __forceinline__ void operator()(const Acc& acc, const Unit& u, int wr, int wc, int fr, int fq) const {
        const int row0 = u.r0 + wr * 64 + fr, col0 = u.c0 + wc * 32 + 8 * fq;
#pragma unroll
        for (int ai = 0; ai < 2; ++ai)
#pragma unroll
            for (int m = 0; m < 4; ++m) { const int row = row0 + ai * 128 + m * 16; const float sw = slot_w[row]; f16* rowp = ys + (size_t)row * D + col0;
#pragma unroll
                for (int bj = 0; bj < 2; ++bj) { const f32x4 v0 = acc[ai][bj][m][0] * sw, v1 = acc[ai][bj][m][1] * sw;
                    u32x4 w; w.x = pk2h(v0[0], v0[1]); w.y = pk2h(v0[2], v0[3]); w.z = pk2h(v1[0], v1[1]); w.w = pk2h(v1[2], v1[3]);
                    *(u32x4*)(rowp + bj * 128) = w; } }
    }
};
struct EpiSoftmax {
    static constexpr bool PERM = true, AFTER_DRAIN = true;
    f16* P;
    __device__ __forceinline__ void operator()(const Acc&, const Unit&, int, int, int, int) const {}
    __device__ __forceinline__ void fused(Acc& acc, const Unit& u, int wr, int wc, int fr, int fq, LAS unsigned char* lds, int wid, int lane) const {
        LAS f32x2* T = (LAS f32x2*)lds;
        float mloc[2][4], lloc[2][4];
#pragma unroll
        for (int ai = 0; ai < 2; ++ai)
#pragma unroll
            for (int m = 0; m < 4; ++m) {
                float mx = -3.0e38f;
#pragma unroll
                for (int bj = 0; bj < 2; ++bj)
#pragma unroll
                    for (int n = 0; n < 2; ++n)
#pragma unroll
                        for (int j = 0; j < 4; ++j) mx = fmaxf(mx, acc[ai][bj][m][n][j]);
                mx = fmaxf(mx, __shfl_xor(mx, 16)); mx = fmaxf(mx, __shfl_xor(mx, 32));
                float s = 0.f;
#pragma unroll
                for (int bj = 0; bj < 2; ++bj)
#pragma unroll
                    for (int n = 0; n < 2; ++n)
#pragma unroll
                        for (int j = 0; j < 4; ++j) { const float e = __expf(acc[ai][bj][m][n][j] - mx); acc[ai][bj][m][n][j] = e; s += e; }
                s += __shfl_xor(s, 16); s += __shfl_xor(s, 32);
                mloc[ai][m] = mx; lloc[ai][m] = s;
                if (fq == 0) T[(ai * 128 + wr * 64 + m * 16 + fr) * 4 + wc] = (f32x2){mx, s};
            }
        LDS_WAIT(); __builtin_amdgcn_s_barrier(); asm volatile("" ::: "memory");
        const int row0 = u.r0 + wr * 64 + fr, col0 = u.c0 + wc * 32 + 8 * fq;
#pragma unroll
        for (int ai = 0; ai < 2; ++ai)
#pragma unroll
            for (int m = 0; m < 4; ++m) { const int r = ai * 128 + wr * 64 + m * 16 + fr;
                const f32x2 t0 = T[r * 4 + 0], t1 = T[r * 4 + 1], t2 = T[r * 4 + 2], t3 = T[r * 4 + 3];
                const float M = fmaxf(fmaxf(t0.x, t1.x), fmaxf(t2.x, t3.x));
                const float L = t0.y * __expf(t0.x - M) + t1.y * __expf(t1.x - M) + t2.y * __expf(t2.x - M) + t3.y * __expf(t3.x - M);
                const float f = __expf(mloc[ai][m] - M) / L;
                f16* rowp = P + (size_t)(row0 + ai * 128 + m * 16) * 256 + col0;
#pragma unroll
                for (int bj = 0; bj < 2; ++bj) { const f32x4 v0 = acc[ai][bj][m][0] * f, v1 = acc[ai][bj][m][1] * f;
                    u32x4 w; w.x = pk2h(v0[0], v0[1]); w.y = pk2h(v0[2], v0[3]); w.z = pk2h(v1[0], v1[1]); w.w = pk2h(v1[2], v1[3]);
                    *(u32x4*)(rowp + bj * 128) = w; } }
        (void)lloc;
    }
};

struct Frame {
    LAS unsigned char* lds;
    unsigned char* ws;
    int tid, lane, wave, G, c;
};
struct Args { const float* in[28]; float* out; unsigned char* ws; int ph_lo, ph_hi, li, pad; };

struct SchedP1 {
    int G, c; const char* h16; const char* win; const char* m16; const char* wkv; char* proj; char* k16; char* vt16;
    __device__ __forceinline__ bool next(int i, Unit& u) const {
        if (i > 1) return false;
        const int L = (G == 256) ? (64 * (c & 7) + 32 * i + (c >> 3)) : (i * G + c); if (L >= 400) return false;
        u.nt = 32; u.aux = 0;
        if (L < 384) { int pm, pn; if (G == 256) pg8::tile_of_w(L, 32, 12, pm, pn); else pg8::tile_of(L, 32, 12, pm, pn); u.a = h16 + (size_t)pm * 256 * D * 2; u.b = win + (size_t)pn * 256 * D * 2; u.r0 = pm * 256; u.c0 = pn * 256; u.kind = 0; u.o = proj; u.ldc = NPROJ; }
        else if (L < 392) { const int pn = L - 384; u.a = m16; u.b = wkv + (size_t)pn * 256 * D * 2; u.r0 = 0; u.c0 = pn * 256; u.kind = 1; u.o = k16; u.ldc = D; }
        else { const int pm = L - 392; u.a = wkv + (size_t)(2048 + pm * 256) * D * 2; u.b = m16; u.r0 = pm * 256; u.c0 = 0; u.kind = 2; u.o = vt16; u.ldc = 256; }
        return true;
    }
};
struct SchedG2 {
    int G, c; const char* dc; const char* wpw; const char* wpool; char* y;
    __device__ __forceinline__ bool next(int i, Unit& u) const {
        const int L = i * G + c; if (L >= 256) return false;
        u.aux = 0; u.o = y; u.ldc = D;
        if (L < 128) { int pm, pn; pg8::tile_of(L, 32, 4, pm, pn); u.a = dc + ((size_t)pm * 256 * D + 1024) * 2; u.b = wpw + (size_t)pn * 256 * 1024 * 2; u.nt = 16; u.r0 = pm * 256; u.c0 = 1024 + pn * 256; u.kind = 1; }
        else { int pm, g; pg8::tile_of(L - 128, 32, 4, pm, g); u.a = dc + ((size_t)pm * 256 * D + g * 256) * 2; u.b = wpool + (size_t)g * 256 * 1024 * 2; u.nt = 4; u.r0 = pm * 256; u.c0 = g * 256; u.kind = 0; }
        return true;
    }
};
struct SchedDense {
    int G, c; const char* A; const char* B; char* o;
    __device__ __forceinline__ bool next(int i, Unit& u) const {
        const int L = i * G + c; if (L >= 256) return false;
        int pm, pn; pg8::tile_of(L, 32, 8, pm, pn);
        u.a = A + (size_t)pm * 256 * D * 2; u.b = B + (size_t)pn * 256 * D * 2; u.nt = 32; u.r0 = pm * 256; u.c0 = pn * 256; u.kind = 1; u.aux = 0; u.o = o; u.ldc = D; return true;
    }
};
struct SchedS {
    int G, c; const char* q; const char* k16;
    __device__ __forceinline__ bool next(int i, Unit& u) const {
        const int L = i * G + c; if (L >= 128 || i > 0) return false;
        const int h = L >> 5, pm = L & 31;
        u.a = q + ((size_t)pm * 256 * D + h * HD) * 2; u.b = k16 + (size_t)h * HD * 2; u.nt = 8; u.r0 = h * SEQ + pm * 256; u.c0 = 0; u.kind = 1; u.aux = 0; u.o = nullptr; u.ldc = 256; return true;
    }
};
struct SchedPV {
    int G, c; const char* p; const char* vt; char* o;
    __device__ __forceinline__ bool next(int i, Unit& u) const {
        const int L = i * G + c; if (L >= 256) return false;
        const int w = pg8::xcd_chunk(L, 256); const int h = w >> 6, pm = (w >> 1) & 31, pn = w & 1;
        u.a = p + (size_t)(h * SEQ + pm * 256) * 256 * 2; u.b = vt + (size_t)(h * HD + pn * 256) * 256 * 2; u.nt = 4; u.r0 = pm * 256; u.c0 = h * HD + pn * 256; u.kind = 1; u.aux = 0; u.o = o; u.ldc = D; return true;
    }
};
struct SchedGU {
    int G, c; const char* xs; const char* wgu; const LAS int* tab;
    __device__ __forceinline__ bool next(int i, Unit& u) const {
        const int T = __builtin_amdgcn_readfirstlane(tab[0]); const int L = i * G + c; if (L >= T * 4) return false;
        const int w = pg8::xcd_chunk(L, T * 4); const int j = w >> 2, pn = w & 3; const int e = __builtin_amdgcn_readfirstlane(tab[1 + j]);
        u.a = xs + (size_t)j * 256 * D * 2; u.b = wgu + (size_t)(e * 1024 + pn * 256) * D * 2; u.nt = 32; u.r0 = j * 256; u.c0 = pn * 128; u.kind = 1; u.aux = e; u.o = nullptr; u.ldc = DE; return true;
    }
};
struct SchedDN {
    int G, c; const char* hid; const char* wdn; const LAS int* tab;
    __device__ __forceinline__ bool next(int i, Unit& u) const {
        const int T = __builtin_amdgcn_readfirstlane(tab[0]); const int L = i * G + c; if (L >= T * 8) return false;
        const int w = pg8::xcd_chunk(L, T * 8); const int j = w >> 3, pn = w & 7; const int e = __builtin_amdgcn_readfirstlane(tab[1 + j]);
        u.a = hid + (size_t)j * 256 * DE * 2; u.b = wdn + (size_t)(e * 2048 + pn * 256) * DE * 2; u.nt = 8; u.r0 = j * 256; u.c0 = pn * 256; u.kind = 1; u.aux = e; u.o = nullptr; u.ldc = D; return true;
    }
};

struct TrItem { const float* src; f16* dst; int N; int pitch; };
__device__ __forceinline__ void tr_load(const TrItem& d, f32x4 (&v)[8]) {
#pragma unroll
    for (int i = 0; i < 8; ++i) v[i] = __builtin_nontemporal_load((const f32x4*)(d.src + (size_t)(8 * i) * d.N));
}
__device__ __forceinline__ void tr_store(const TrItem& d, const f32x4 (&v)[8], LAS float* scr, int lane) {
#pragma unroll
    for (int i = 0; i < 8; ++i) { LAS float* p = scr + ((lane >> 3) + 8 * i) * 33 + 4 * (lane & 7); p[0] = v[i][0]; p[1] = v[i][1]; p[2] = v[i][2]; p[3] = v[i][3]; }
    LDS_WAIT(); asm volatile("" ::: "memory");
    const int c = lane >> 3, nl = lane & 7;
#pragma unroll
    for (int jj = 0; jj < 4; ++jj) { const int n = nl + 8 * jj; const LAS float* s = scr + (8 * c) * 33 + n;
        u32x4 o; o.x = pk2h(s[0 * 33], s[1 * 33]); o.y = pk2h(s[2 * 33], s[3 * 33]); o.z = pk2h(s[4 * 33], s[5 * 33]); o.w = pk2h(s[6 * 33], s[7 * 33]);
        __builtin_nontemporal_store(o, (u32x4*)(d.dst + (size_t)n * d.pitch + 8 * c)); }
    LDS_WAIT(); asm volatile("" ::: "memory");
}
__device__ __forceinline__ void rms_row_f32(const float* xrow, const float* g, f16* orow, int lane) {
    f32x4 v[8]; float s = 0.f;
#pragma unroll
    for (int j = 0; j < 4; ++j) { const f32x4* p = (const f32x4*)(xrow + 8 * (lane + 64 * j)); v[2 * j] = p[0]; v[2 * j + 1] = p[1];
        s += v[2 * j][0] * v[2 * j][0] + v[2 * j][1] * v[2 * j][1] + v[2 * j][2] * v[2 * j][2] + v[2 * j][3] * v[2 * j][3];
        s += v[2 * j + 1][0] * v[2 * j + 1][0] + v[2 * j + 1][1] * v[2 * j + 1][1] + v[2 * j + 1][2] * v[2 * j + 1][2] + v[2 * j + 1][3] * v[2 * j + 1][3]; }
    const float rs = rsqrtf(wave_sum(s) * (1.0f / D) + EPS);
#pragma unroll
    for (int j = 0; j < 4; ++j) { const f32x4* gp = (const f32x4*)(g + 8 * (lane + 64 * j)); const f32x4 a = v[2 * j] * rs * gp[0], b = v[2 * j + 1] * rs * gp[1];
        u32x4 o; o.x = pk2h(a[0], a[1]); o.y = pk2h(a[2], a[3]); o.z = pk2h(b[0], b[1]); o.w = pk2h(b[2], b[3]);
        *(u32x4*)(orow + 8 * (lane + 64 * j)) = o; }
}

constexpr int I_IN = 32 * 96, I_POOL = 4 * 4 * 8, I_PW = 16 * 32, I_SQ = 32 * 64, I_KV = 32 * 128, I_G = 32 * 32 * 16, I_D = 32 * 8 * 64;
constexpr int NITEMS = I_IN + I_POOL + I_PW + 3 * I_SQ + I_KV + 2 * I_G + I_D;
__device__ __forceinline__ void blk_order(int r, int NB, int KL, int NL, int& kb, int& nb) {
    const int per = KL * NL, blk = r / per, lo = r % per, nbh = NB / NL; nb = (blk % nbh) * NL + lo % NL; kb = (blk / nbh) * KL + lo / NL;
}
constexpr int SEG_A = I_IN + I_KV, SEG_B = SEG_A + I_POOL + I_PW + 3 * I_SQ, SEG_GU = SEG_B + 2 * I_G;
static_assert(SEG_GU + I_D == NITEMS, "item segments");
__device__ __forceinline__ TrItem tr_decode(int r, const Args& A, unsigned char* ws, int lane) {
    const float* W; int N, k0, n0, pitch, kb, nb; f16* dst;
    if (r < I_IN) { blk_order(r, 96, 16, 16, kb, nb); W = A.in[3]; N = NPROJ; k0 = kb * 64; n0 = nb * 32; pitch = D; dst = (f16*)(ws + WS_WIN) + (size_t)n0 * D + k0; }
    else if ((r -= I_IN) < I_KV) { blk_order(r, 128, 16, 16, kb, nb); W = A.in[17]; N = 4096; k0 = kb * 64; n0 = nb * 32; pitch = D; dst = (f16*)(ws + WS_WKV) + (size_t)n0 * D + k0; }
    else if ((r -= I_KV) < I_POOL) { const int g = r / 32, q = r % 32; kb = q / 8; nb = q % 8; W = A.in[4] + (size_t)g * 65536; N = 256; k0 = kb * 64; n0 = nb * 32; pitch = 1024; dst = (f16*)(ws + WS_WPOOL) + (size_t)(g * 256 + n0) * 1024 + k0; }
    else if ((r -= I_POOL) < I_PW) { blk_order(r, 32, 16, 16, kb, nb); W = A.in[10]; N = 1024; k0 = kb * 64; n0 = nb * 32; pitch = 1024; dst = (f16*)(ws + WS_WPW) + (size_t)n0 * 1024 + k0; }
    else if ((r -= I_PW) < I_SQ) { blk_order(r, 64, 16, 16, kb, nb); W = A.in[13]; N = D; k0 = kb * 64; n0 = nb * 32; pitch = D; dst = (f16*)(ws + WS_WOUT) + (size_t)n0 * D + k0; }
    else if ((r -= I_SQ) < I_SQ) { blk_order(r, 64, 16, 16, kb, nb); W = A.in[16]; N = D; k0 = kb * 64; n0 = nb * 32; pitch = D; dst = (f16*)(ws + WS_WQ) + (size_t)n0 * D + k0; }
    else if ((r -= I_SQ) < I_SQ) { blk_order(r, 64, 16, 16, kb, nb); W = A.in[18]; N = D; k0 = kb * 64; n0 = nb * 32; pitch = D; dst = (f16*)(ws + WS_WO) + (size_t)n0 * D + k0; }
    else if ((r -= I_SQ) < 2 * I_G) { const int up = r >= I_G; if (up) r -= I_G; const int e = r / 512; blk_order(r % 512, 16, 16, 16, kb, nb); n0 = nb * 32; k0 = kb * 64;
        const int drow = e * 1024 + (n0 >> 7) * 256 + up * 128 + (n0 & 127);
        W = (up ? A.in[25] : A.in[24]) + (size_t)e * D * DE; N = DE; pitch = D; dst = (f16*)(ws + WS_WGU) + (size_t)drow * D + k0; }
    else { r -= 2 * I_G; const int e = r / 512; blk_order(r % 512, 64, 8, 32, kb, nb); W = A.in[26] + (size_t)e * DE * D; N = D; k0 = kb * 64; n0 = nb * 32; pitch = DE; dst = (f16*)(ws + WS_WDN) + (size_t)(e * 2048 + n0) * DE + k0; }
    TrItem d; d.src = W + (size_t)(k0 + (lane >> 3)) * N + n0 + 4 * (lane & 7); d.dst = dst; d.N = N; d.pitch = pitch; return d;
}
constexpr int CW_QHEAD = 64, CW_ARRIVE = 1024;
__device__ __forceinline__ void tr_batch16(const Frame& F, const Args& A, int first) {
    LAS float* scr = (LAS float*)(F.lds + F.wave * 16384);
    const int i0 = first + F.wave, i1 = first + 8 + F.wave; const bool v0 = i0 < NITEMS, v1 = i1 < NITEMS;
    TrItem d0, d1; f32x4 a[8], b[8];
    if (v0) { d0 = tr_decode(i0, A, F.ws, F.lane); tr_load(d0, a); }
    if (v1) { d1 = tr_decode(i1, A, F.ws, F.lane); tr_load(d1, b); }
    if (v0) tr_store(d0, a, scr, F.lane);
    if (v1) tr_store(d1, b, scr, F.lane);
}
__device__ __forceinline__ void tr_batch8(const Frame& F, const Args& A, int first) {
    LAS float* scr = (LAS float*)(F.lds + F.wave * 16384);
    const int i0 = first + F.wave;
    if (i0 < NITEMS) { f32x4 a[8]; const TrItem d0 = tr_decode(i0, A, F.ws, F.lane); tr_load(d0, a); tr_store(d0, a, scr, F.lane); }
}
__device__ __forceinline__ void tr_drain(const Frame& F, const Args& A, int limit) {
    unsigned* head = (unsigned*)(F.ws + WS_CTL) + CW_QHEAD; volatile LAS int* slot = (volatile LAS int*)(F.lds + MISC_OFF) + 16;
    for (;;) {
        __syncthreads();
        if (F.tid == 0) { int it = NITEMS; if ((int)xb_ld(head) < limit) it = (int)xb_add(head, 16u); slot[0] = it; }
        __syncthreads();
        const int it = slot[0];
        if (it >= NITEMS) break;
        tr_batch16(F, A, it);
    }
}
__device__ __forceinline__ void tr_idle(const Frame& F, const Args& A, int ph) {
    unsigned* head = (unsigned*)(F.ws + WS_CTL) + CW_QHEAD; unsigned* arr = (unsigned*)(F.ws + WS_CTL) + CW_ARRIVE + 64 * ph;
    volatile LAS int* slot = (volatile LAS int*)(F.lds + MISC_OFF) + 16;
    __syncthreads();
    if (F.tid == 0) (void)xb_add(arr, 1u);
    for (;;) {
        __syncthreads();
        if (F.tid == 0) { int it = NITEMS; if (xb_ld(arr) < (unsigned)F.G && (int)xb_ld(head) < NITEMS) it = (int)xb_add(head, 16u); slot[0] = it; }
        __syncthreads();
        const int it = slot[0];
        if (it >= NITEMS) break;
        tr_batch16(F, A, it);
    }
}
__device__ __forceinline__ void phase_prep(const Frame& F, const Args& A) {
    const int gw = F.c * 8 + F.wave, NGW = F.G * 8;
    unsigned char* ws = F.ws;
    for (int m = gw; m < SEQ; m += NGW) rms_row_f32(A.in[0] + (size_t)m * D, A.in[2], (f16*)(ws + WS_H) + (size_t)m * D, F.lane);
    for (int m = gw; m < MEMLEN; m += NGW) rms_row_f32(A.in[1] + (size_t)m * D, A.in[15], (f16*)(ws + WS_M16) + (size_t)m * D, F.lane);
    tr_drain(F, A, SEG_A);
}

template <int TT> __device__ __forceinline__ void conv_step(f32x2 (&acc)[32], const f32x2 (&w)[CK], const LAS unsigned* yl, const unsigned ycur) {
    unsigned ynext = 0u;
    if constexpr (TT + 1 < 62) ynext = yl[(TT + 1) * 512];
    const f32x2 y = unpk2h(ycur);
#pragma unroll
    for (int r = (TT - 30 > 0 ? TT - 30 : 0); r <= (TT < 31 ? TT : 31); ++r) acc[r] = acc[r] + w[TT - r] * y;
    __builtin_amdgcn_sched_barrier(0);
    if constexpr (TT + 1 < 62) conv_step<TT + 1>(acc, w, yl, ynext);
}
__device__ __forceinline__ void phase_mixpre(const Frame& F, const Args& A) {
    const f16* proj = (const f16*)(F.ws + WS_PROJ);
    f16* dc = (f16*)(F.ws + WS_DC);
    LAS unsigned* ylds = (LAS unsigned*)F.lds;
    LAS float* red = (LAS float*)F.lds;
    LAS float* stat = (LAS float*)(F.lds + TAB_OFF);
    const int tid = F.tid, lane = F.lane;
    for (int blk = F.c; blk < SEQ / 32; blk += F.G) {
        const int t0 = blk * 32;
#pragma unroll 4
        for (int p = 0; p < 12; ++p) { const int rr = p * 4 + (tid >> 7); const int t = t0 - 15 + rr; u32x4 v = (u32x4){0u, 0u, 0u, 0u};
            if (t >= 0 && t < SEQ) v = *(const u32x4*)(proj + (size_t)t * NPROJ + (tid & 127) * 8);
            *(LAS u32x4*)(ylds + rr * 512 + (tid & 127) * 4) = v; }
        __syncthreads();
        { const int g = tid >> 7, wnd = 2 << g; f32x2 S = (f32x2){0.f, 0.f};
          for (int i = 1; i < wnd; ++i) S = S + unpk2h(ylds[(15 - i) * 512 + tid]);
#pragma unroll 4
          for (int r = 0; r < 32; ++r) { const int t = t0 + r; const f32x2 cur = unpk2h(ylds[(15 + r) * 512 + tid]); S = S + cur;
              const int cnt = (t + 1 < wnd) ? (t + 1) : wnd; const float ic = 1.0f / (float)cnt;
              *(unsigned*)(dc + (size_t)t * D + 2 * tid) = pk2h(S[0] * ic - cur[0], S[1] * ic - cur[1]);
              S = S - unpk2h(ylds[(15 + r - wnd + 1) * 512 + tid]); } }
        __syncthreads();
#pragma unroll 4
        for (int p = 0; p < 16; ++p) { const int r = p * 4 + (tid >> 7), c8 = (tid & 127) * 8; const int t = t0 - 30 + r;
            u32x4 o = (u32x4){0u, 0u, 0u, 0u};
            if (t >= 0 && r < 62) { const u32x4 av = *(const u32x4*)(proj + (size_t)t * NPROJ + 1024 + c8), gv = *(const u32x4*)(proj + (size_t)t * NPROJ + 2048 + c8);
#pragma unroll
                for (int q = 0; q < 4; ++q) { const f32x2 a2 = unpk2h(av[q]), g2 = unpk2h(gv[q]); o[q] = pk2h(a2[0] * fast_sigmoid(g2[0]), a2[1] * fast_sigmoid(g2[1])); } }
            if (r < 62) *(LAS u32x4*)(ylds + r * 512 + (tid & 127) * 4) = o; }
        __syncthreads();
        f32x2 acc[32];
        { f32x2 w[CK];
#pragma unroll
          for (int j = 0; j < CK; ++j) w[j] = *(const f32x2*)(A.in[6] + j * 1024 + 2 * tid);
          const f32x2 bdw = *(const f32x2*)(A.in[7] + 2 * tid);
#pragma unroll
          for (int r = 0; r < 32; ++r) acc[r] = bdw;
          conv_step<0>(acc, w, ylds + tid, ylds[tid]); }
        __syncthreads();
#pragma unroll
        for (int r = 0; r < 32; ++r) { red[(2 * r) * 512 + tid] = acc[r][0] + acc[r][1]; red[(2 * r + 1) * 512 + tid] = acc[r][0] * acc[r][0] + acc[r][1] * acc[r][1]; }
        __syncthreads();
        { const int s = tid >> 3, sl = tid & 7; float a = 0.f;
#pragma unroll 8
          for (int i = 0; i < 64; ++i) a += red[s * 512 + sl * 64 + ((i + lane) & 63)];
          a += __shfl_xor(a, 1); a += __shfl_xor(a, 2); a += __shfl_xor(a, 4);
          if (sl == 0) stat[s] = a; }
        __syncthreads();
        { const f32x2 lng = *(const f32x2*)(A.in[8] + 2 * tid), lnb = *(const f32x2*)(A.in[9] + 2 * tid);
#pragma unroll
          for (int r = 0; r < 32; ++r) { const float mean = stat[2 * r] * (1.0f / 1024.f); const float var = stat[2 * r + 1] * (1.0f / 1024.f) - mean * mean; const float rstd = rsqrtf(var + EPS);
              const float y0 = (acc[r][0] - mean) * rstd * lng[0] + lnb[0], y1 = (acc[r][1] - mean) * rstd * lng[1] + lnb[1];
              *(unsigned*)(dc + (size_t)(t0 + r) * D + 1024 + 2 * tid) = pk2h(y0 * fast_sigmoid(y0), y1 * fast_sigmoid(y1)); } }
        __syncthreads();
    }
}

__device__ __forceinline__ void phase_rownorm(const Frame& F, const Args& A) {
    const f16* y = (const f16*)(F.ws + WS_Y); f16* yn = (f16*)(F.ws + WS_YN);
    const int gw = F.c * 8 + F.wave, NGW = F.G * 8, lane = F.lane;
    for (int m = gw; m < SEQ; m += NGW) {
        u32x4 v[4]; float sa = 0.f, sb = 0.f;
#pragma unroll
        for (int j = 0; j < 4; ++j) { v[j] = *(const u32x4*)(y + (size_t)m * D + 8 * (lane + 64 * j)); float s = 0.f;
#pragma unroll
            for (int q = 0; q < 4; ++q) { const f32x2 a = unpk2h(v[j][q]); s += a[0] * a[0] + a[1] * a[1]; }
            if (j < 2) sa += s; else sb += s; }
        const float ra = rsqrtf(wave_sum(sa) * (1.0f / 1024.f) + EPS), rb = rsqrtf(wave_sum(sb) * (1.0f / 1024.f) + EPS);
#pragma unroll
        for (int j = 0; j < 4; ++j) { const int col = 8 * (lane + 64 * j); const float* g = (j < 2) ? (A.in[11] + col) : (A.in[12] + col - 1024); const float rs = (j < 2) ? ra : rb;
            const f32x4 g0 = *(const f32x4*)g, g1 = *(const f32x4*)(g + 4); u32x4 o;
            { const f32x2 a = unpk2h(v[j][0]); o.x = pk2h(a[0] * rs * g0[0], a[1] * rs * g0[1]); }
            { const f32x2 a = unpk2h(v[j][1]); o.y = pk2h(a[0] * rs * g0[2], a[1] * rs * g0[3]); }
            { const f32x2 a = unpk2h(v[j][2]); o.z = pk2h(a[0] * rs * g1[0], a[1] * rs * g1[1]); }
            { const f32x2 a = unpk2h(v[j][3]); o.w = pk2h(a[0] * rs * g1[2], a[1] * rs * g1[3]); }
            *(u32x4*)(yn + (size_t)m * D + col) = o; }
    }
}
__device__ __forceinline__ void phase_norm_x(const Frame& F, const float* x, const float* g) {
    const int gw = F.c * 8 + F.wave, NGW = F.G * 8;
    for (int m = gw; m < SEQ; m += NGW) rms_row_f32(x + (size_t)m * D, g, (f16*)(F.ws + WS_H) + (size_t)m * D, F.lane);
}

typedef float f32x16 __attribute__((ext_vector_type(16)));
__device__ __forceinline__ void phase_router(const Frame& F, const Args& A, const float* x2) {
    const float* gf = A.in[19]; const float* wrg = A.in[20]; const float* brg = A.in[21]; const float* wre = A.in[22]; const float* bre = A.in[23];
    LAS float* xt = (LAS float*)(F.lds) + F.wave * (32 * 68 + 256);
    LAS float* wgt = xt + 32 * 68;
    constexpr int XT_BYTES = 8 * (32 * 68 + 256) * 4;
    LAS float* part = (LAS float*)(F.lds + XT_BYTES);
    LAS float* gpart = (LAS float*)(F.lds + XT_BYTES + 36864);
    LAS float* ssqp = (LAS float*)(F.lds + XT_BYTES + 40960);
    LAS float* lgf = (LAS float*)(F.lds + XT_BYTES + 45056);
    LAS int* hist = (LAS int*)(F.lds + XT_BYTES + 51200);
    int* histg = (int*)(F.ws + WS_HIST); int* toke = (int*)(F.ws + WS_TOKE); float* tokw = (float*)(F.ws + WS_TOKW); float* tokrs = (float*)(F.ws + WS_TOKRS);
    f16* h3 = (f16*)(F.ws + WS_H);
    const int tid = F.tid, lane = F.lane, w = F.wave, tok = lane & 31, h = lane >> 5;
    for (int ch = F.c; ch < SEQ / 32; ch += F.G) {
        if (tid < 32) hist[tid] = 0;
        const int t0 = ch * 32;
        const float* xs0 = x2 + (size_t)(t0 + (lane >> 3)) * D + 256 * w + 8 * (lane & 7);
        f16* ho0 = h3 + (size_t)(t0 + (lane >> 3)) * D + 256 * w + 8 * (lane & 7);
        const float* wre0 = wre + (size_t)(256 * w + h) * 32 + tok;
        const float* wrg0 = wrg + (size_t)(256 * w + lane) * 4;
        f32x4 pre[8], wgn; float bwn[32];
#pragma unroll
        for (int i = 0; i < 4; ++i) { pre[2 * i] = *(const f32x4*)(xs0 + (size_t)(8 * i) * D); pre[2 * i + 1] = *(const f32x4*)(xs0 + (size_t)(8 * i) * D + 4); }
        { const float* p0 = wre0; const float* p1 = wre0 + 1024; asm volatile("" : "+v"(p0)); asm volatile("" : "+v"(p1));
#pragma unroll
          for (int s = 0; s < 16; ++s) { bwn[s] = p0[64 * s]; bwn[16 + s] = p1[64 * s]; } }
        wgn = *(const f32x4*)wrg0;
        f32x16 acc;
#pragma unroll
        for (int i = 0; i < 16; ++i) acc[i] = 0.f;
        float ga0 = 0.f, ga1 = 0.f, ga2 = 0.f, ga3 = 0.f; float sq[4] = {0.f, 0.f, 0.f, 0.f};
#pragma unroll 1
        for (int b = 0; b < 4; ++b) {
            float bw[32];
            { const f32x4 gA = *(const f32x4*)(gf + 256 * w + 64 * b + 8 * (lane & 7)), gB = *(const f32x4*)(gf + 256 * w + 64 * b + 8 * (lane & 7) + 4);
#pragma unroll
              for (int i = 0; i < 4; ++i) { const f32x4 xa = pre[2 * i], xb = pre[2 * i + 1];
                  sq[i] += xa[0] * xa[0] + xa[1] * xa[1] + xa[2] * xa[2] + xa[3] * xa[3] + xb[0] * xb[0] + xb[1] * xb[1] + xb[2] * xb[2] + xb[3] * xb[3];
                  const f32x4 a = xa * gA, c = xb * gB;
                  LAS float* p = xt + (8 * i + (lane >> 3)) * 68 + 8 * (lane & 7); *(LAS f32x4*)p = a; *(LAS f32x4*)(p + 4) = c;
                  u32x4 o; o.x = pk2h(a[0], a[1]); o.y = pk2h(a[2], a[3]); o.z = pk2h(c[0], c[1]); o.w = pk2h(c[2], c[3]);
                  *(u32x4*)(ho0 + (size_t)(8 * i) * D + 64 * b) = o; } }
            *(LAS f32x4*)(wgt + 4 * lane) = wgn;
#pragma unroll
            for (int s = 0; s < 32; ++s) bw[s] = bwn[s];
            if (b < 3) {
#pragma unroll
                for (int i = 0; i < 4; ++i) { pre[2 * i] = *(const f32x4*)(xs0 + (size_t)(8 * i) * D + 64 * (b + 1)); pre[2 * i + 1] = *(const f32x4*)(xs0 + (size_t)(8 * i) * D + 64 * (b + 1) + 4); }
                { const float* p0 = wre0 + 2048 * (b + 1); const float* p1 = p0 + 1024; asm volatile("" : "+v"(p0)); asm volatile("" : "+v"(p1));
#pragma unroll
                  for (int s = 0; s < 16; ++s) { bwn[s] = p0[64 * s]; bwn[16 + s] = p1[64 * s]; } }
                wgn = *(const f32x4*)(wrg0 + 256 * (b + 1)); }
            LDS_WAIT(); asm volatile("" ::: "memory");
#pragma unroll
            for (int q = 0; q < 16; ++q) {
                const f32x4 xv = *(const LAS f32x4*)(xt + tok * 68 + 4 * q);
                const f32x4 wg0 = *(const LAS f32x4*)(wgt + 4 * (4 * q + h)), wg1 = *(const LAS f32x4*)(wgt + 4 * (4 * q + 2 + h));
                const float a0 = h ? xv[1] : xv[0], a1 = h ? xv[3] : xv[2];
                acc = __builtin_amdgcn_mfma_f32_32x32x2f32(a0, bw[2 * q], acc, 0, 0, 0);
                acc = __builtin_amdgcn_mfma_f32_32x32x2f32(a1, bw[2 * q + 1], acc, 0, 0, 0);
                ga0 += a0 * wg0[0] + a1 * wg1[0]; ga1 += a0 * wg0[1] + a1 * wg1[1]; ga2 += a0 * wg0[2] + a1 * wg1[2]; ga3 += a0 * wg0[3] + a1 * wg1[3];
                if ((q & 1) == 1) __builtin_amdgcn_sched_barrier(0); }
            LDS_WAIT(); asm volatile("" ::: "memory");
        }
#pragma unroll
        for (int i = 0; i < 4; ++i) { float s = sq[i]; s += __shfl_xor(s, 1); s += __shfl_xor(s, 2); s += __shfl_xor(s, 4); if ((lane & 7) == 0) ssqp[w * 32 + 8 * i + (lane >> 3)] = s; }
#pragma unroll
        for (int r = 0; r < 16; ++r) part[(w * 32 + (r & 3) + 8 * (r >> 2) + 4 * h) * 33 + tok] = acc[r];
        ga0 += __shfl_xor(ga0, 32); ga1 += __shfl_xor(ga1, 32); ga2 += __shfl_xor(ga2, 32); ga3 += __shfl_xor(ga3, 32);
        if (h == 0) { *(LAS f32x4*)(gpart + (w * 32 + tok) * 4) = (f32x4){ga0, ga1, ga2, ga3}; }
        __syncthreads();
        { const int token = tid >> 4, e2 = tid & 15; float s0 = 0.f, s1 = 0.f;
#pragma unroll
          for (int ww = 0; ww < 8; ++ww) { s0 += part[(ww * 32 + token) * 33 + 2 * e2]; s1 += part[(ww * 32 + token) * 33 + 2 * e2 + 1]; }
          lgf[token * 40 + 4 + 2 * e2] = s0; lgf[token * 40 + 5 + 2 * e2] = s1;
          if (e2 < 4) { float s = 0.f;
#pragma unroll
              for (int ww = 0; ww < 8; ++ww) s += gpart[(ww * 32 + token) * 4 + e2];
              lgf[token * 40 + e2] = s; }
          if (e2 == 4) { float s = 0.f;
#pragma unroll
              for (int ww = 0; ww < 8; ++ww) s += ssqp[ww * 32 + token];
              lgf[token * 40 + 36] = rsqrtf(s * (1.0f / D) + EPS); } }
        __syncthreads();
        if (tid < 32) { const int t = tid; const LAS float* L = lgf + t * 40; const float rs = L[36];
            const float g0 = L[0] * rs + brg[0], g1 = L[1] * rs + brg[1], g2 = L[2] * rs + brg[2], g3 = L[3] * rs + brg[3];
            int gi = 0; float gm = g0; if (g1 > gm) { gm = g1; gi = 1; } if (g2 > gm) { gm = g2; gi = 2; } if (g3 > gm) { gm = g3; gi = 3; }
            const float pg = 1.0f / (__expf(g0 - gm) + __expf(g1 - gm) + __expf(g2 - gm) + __expf(g3 - gm));
            float le[8];
#pragma unroll
            for (int i = 0; i < 8; ++i) le[i] = L[4 + gi * 8 + i] * rs + bre[gi * 8 + i];
            int i1 = 0; float m1 = le[0];
#pragma unroll
            for (int i = 1; i < 8; ++i) if (le[i] > m1) { m1 = le[i]; i1 = i; }
            int i2 = -1; float m2 = -3.0e38f;
#pragma unroll
            for (int i = 0; i < 8; ++i) if (i != i1 && le[i] > m2) { m2 = le[i]; i2 = i; }
            const float ex = __expf(m2 - m1); const float w1 = pg / (1.0f + ex), w2 = pg * ex / (1.0f + ex);
            const int tk = t0 + t; const int e1 = gi * 8 + i1, e2 = gi * 8 + i2;
            tokrs[tk] = rs;
            toke[tk * 2] = e1; toke[tk * 2 + 1] = e2; tokw[tk * 2] = w1; tokw[tk * 2 + 1] = w2;
            atomicAdd((int*)(hist + e1), 1); atomicAdd((int*)(hist + e2), 1); }
        __syncthreads();
        if (tid < 32) histg[ch * 32 + tid] = hist[tid];
        __syncthreads();
    }
}

__device__ __forceinline__ void phase_scatter(const Frame& F) {
    const int* histg = (const int*)(F.ws + WS_HIST); const int* toke = (const int*)(F.ws + WS_TOKE); const float* tokw = (const float*)(F.ws + WS_TOKW);
    int* totg = (int*)(F.ws + WS_TOT); int* tokslot = (int*)(F.ws + WS_TOKSLOT); float* slotw = (float*)(F.ws + WS_SLOTW); const float* tokrs = (const float*)(F.ws + WS_TOKRS);
    const f16* h3 = (const f16*)(F.ws + WS_H); f16* xs = (f16*)(F.ws + WS_XS);
    LAS int* ps = (LAS int*)F.lds;
    LAS int* tot = ps + 1024;
    LAS int* bas = ps + 1056;
    LAS int* sl = ps + 1088;
    const int tid = F.tid, lane = F.lane;
    for (int ch = F.c; ch < SEQ / 32; ch += F.G) {
        { const int e = tid & 31, part = tid >> 5; int s = 0, b = 0;
#pragma unroll
          for (int q = 0; q < 16; ++q) { const int cq = part * 16 + q; const int h = histg[cq * 32 + e]; s += h; b += (cq < ch) ? h : 0; }
          ps[part * 32 + e] = s; ps[512 + part * 32 + e] = b; }
        __syncthreads();
        if (tid < 32) { int s = 0, b = 0;
#pragma unroll
            for (int p = 0; p < 16; ++p) { s += ps[p * 32 + tid]; b += ps[512 + p * 32 + tid]; }
            tot[tid] = s; bas[tid] = b; }
        __syncthreads();
        if (tid < 32) { int pst = 0; for (int e = 0; e < tid; ++e) pst += (tot[e] + 255) >> 8; pst <<= 8;
            bas[tid] = pst + bas[tid];
            if (ch == 0) totg[tid] = tot[tid]; }
        __syncthreads();
        if (ch < 32) { int pst = 0; for (int e = 0; e < ch; ++e) pst += (tot[e] + 255) >> 8; pst <<= 8; const int n = tot[ch]; const int end = pst + (((n + 255) >> 8) << 8);
            for (int s = pst + n + tid; s < end; s += 512) slotw[s] = 0.f; }
        if (F.wave == 0) { const int a = lane; const int tok = ch * 32 + (a >> 1); const int e = toke[tok * 2 + (a & 1)]; const float wv = tokw[tok * 2 + (a & 1)];
            int rank = 0;
            for (int ee = 0; ee < 32; ++ee) { const unsigned long long mk = __ballot(e == ee); if (e == ee) rank = __popcll(mk & ((1ull << lane) - 1ull)); }
            const int slot = bas[e] + rank; sl[a] = slot; slotw[slot] = wv; tokslot[tok * 2 + (a & 1)] = slot; }
        __syncthreads();
#pragma unroll
        for (int r = 0; r < 8; ++r) { const int a = F.wave * 8 + r; const int tok = ch * 32 + (a >> 1); const int slot = sl[a]; const float rs = tokrs[tok];
            const u32x4* src = (const u32x4*)(h3 + (size_t)tok * D); u32x4* dst = (u32x4*)(xs + (size_t)slot * D);
#pragma unroll
            for (int j = 0; j < 4; ++j) { const u32x4 v = src[lane + 64 * j]; u32x4 o;
                { const f32x2 q = unpk2h(v.x); o.x = pk2h(q[0] * rs, q[1] * rs); } { const f32x2 q = unpk2h(v.y); o.y = pk2h(q[0] * rs, q[1] * rs); }
                { const f32x2 q = unpk2h(v.z); o.z = pk2h(q[0] * rs, q[1] * rs); } { const f32x2 q = unpk2h(v.w); o.w = pk2h(q[0] * rs, q[1] * rs); }
                dst[lane + 64 * j] = o; } }
        __syncthreads();
    }
}
__device__ __forceinline__ void moe_table(const Frame& F) {
    const int* totg = (const int*)(F.ws + WS_TOT); LAS int* tab = (LAS int*)(F.lds + TAB_OFF);
    if (F.tid == 0) { int T = 0; for (int e = 0; e < NE; ++e) { const int n = totg[e]; const int te = (n + 255) >> 8; for (int q = 0; q < te; ++q) tab[1 + T + q] = e; T += te; } tab[0] = T; }
    __syncthreads();
}

__device__ __forceinline__ void phase_final(const Frame& F, const Args& A, float* out) {
    const int* tokslot = (const int*)(F.ws + WS_TOKSLOT); const f16* ys = (const f16*)(F.ws + WS_YS); const float* g = A.in[27];
    const int gw = F.c * 8 + F.wave, NGW = F.G * 8, lane = F.lane;
    for (int m = gw; m < SEQ; m += NGW) {
        const int s0 = tokslot[m * 2], s1 = tokslot[m * 2 + 1];
        f32x4 v[8]; float s = 0.f;
#pragma unroll
        for (int j = 0; j < 4; ++j) { const int col = 8 * (lane + 64 * j); const f32x4* p = (const f32x4*)(out + (size_t)m * D + col);
            const u32x4 y0 = *(const u32x4*)(ys + (size_t)s0 * D + col), y1 = *(const u32x4*)(ys + (size_t)s1 * D + col);
            f32x4 a = p[0], b = p[1];
            { const f32x2 q0 = unpk2h(y0.x), q1 = unpk2h(y1.x); a[0] += q0[0] + q1[0]; a[1] += q0[1] + q1[1]; }
            { const f32x2 q0 = unpk2h(y0.y), q1 = unpk2h(y1.y); a[2] += q0[0] + q1[0]; a[3] += q0[1] + q1[1]; }
            { const f32x2 q0 = unpk2h(y0.z), q1 = unpk2h(y1.z); b[0] += q0[0] + q1[0]; b[1] += q0[1] + q1[1]; }
            { const f32x2 q0 = unpk2h(y0.w), q1 = unpk2h(y1.w); b[2] += q0[0] + q1[0]; b[3] += q0[1] + q1[1]; }
            v[2 * j] = a; v[2 * j + 1] = b;
            s += a[0] * a[0] + a[1] * a[1] + a[2] * a[2] + a[3] * a[3] + b[0] * b[0] + b[1] * b[1] + b[2] * b[2] + b[3] * b[3]; }
        const float rs = rsqrtf(wave_sum(s) * (1.0f / D) + EPS);
#pragma unroll
        for (int j = 0; j < 4; ++j) { const int col = 8 * (lane + 64 * j); f32x4* p = (f32x4*)(out + (size_t)m * D + col);
            p[0] = v[2 * j] * rs * *(const f32x4*)(g + col); p[1] = v[2 * j + 1] * rs * *(const f32x4*)(g + col + 4); }
    }
}

#if FAST_GEMM
#define RUN_GEMM(EpiT, SchedT, lda, ldb, S, E) pg8::gemm_phase<EpiT, SchedT, !EpiT::AFTER_DRAIN, true>(F.lds, lda, ldb, S, E)
#else
#define RUN_GEMM(EpiT, SchedT, lda, ldb, S, E) pg8::gemm_phase_simple<EpiT, SchedT>(F.lds, lda, ldb, S, E)
#endif

__global__ void __launch_bounds__(512, 2) fwd(Args args) {
    extern __shared__ __attribute__((aligned(16))) unsigned char lds_raw[];
    Frame F;
    F.lds = (LAS unsigned char*)lds_raw; F.ws = args.ws;
    F.tid = threadIdx.x; F.lane = F.tid & 63; F.wave = __builtin_amdgcn_readfirstlane(F.tid >> 6);
    F.G = gridDim.x; F.c = blockIdx.x;
    volatile LAS unsigned* MISC = (volatile LAS unsigned*)(F.lds + MISC_OFF);
    if (F.tid < 64) MISC[F.tid] = 0u;
    __syncthreads();
    XcdBarrier bar; bar.bar = (unsigned*)(args.ws + WS_CTL) + CW_BAR; bar.x = 0; bar.st = nullptr;
    if (MK_N_LAUNCHES == 1) bar = xcd_barrier_post((unsigned*)(args.ws + WS_CTL) + CW_BAR, MISC + 8);
    const int lo = args.ph_lo, hi = args.ph_hi;
#ifndef ONLY_PHASE
#define ONLY_PHASE -1
#endif
#define IN(k) ((ONLY_PHASE < 0 || (k) == ONLY_PHASE) && lo <= (k) && (k) < hi)
#ifndef REP_PHASE
#define REP_PHASE -1
#endif
#ifndef REP_N
#define REP_N 1
#endif
#define REPS(k) _Pragma("unroll 1") for (int rep_ = 0; rep_ < (((k) == REP_PHASE) ? args.pad : 1); ++rep_)
#define SEAM(k) do { if (IN(k) && IN((k) + 1)) xcd_barrier(bar); } while (0)
    unsigned char* ws = args.ws; float* out = args.out;
    const char* wsc = (const char*)ws;

    if (IN(0)) REPS(0) { phase_prep(F, args); } SEAM(0);
    if (IN(1)) REPS(1) { SchedP1 S{F.G, F.c, wsc + WS_H, wsc + WS_WIN, wsc + WS_M16, wsc + WS_WKV, (char*)(ws + WS_PROJ), (char*)(ws + WS_K16), (char*)(ws + WS_VT16)};
        EpiF16 E{nullptr, 1.0f};
        RUN_GEMM(EpiF16, SchedP1, D, D, S, E); tr_idle(F, args, 1); } SEAM(1);
#ifndef DUP2
#define DUP2 0
#endif
    if (IN(2)) { phase_mixpre(F, args); tr_drain(F, args, SEG_B); } SEAM(2);
    if (IN(3)) REPS(3) { SchedG2 S{F.G, F.c, wsc + WS_DC, wsc + WS_WPW, wsc + WS_WPOOL, (char*)(ws + WS_Y)};
        EpiF16 E{args.in[5], 1.0f};
        RUN_GEMM(EpiF16, SchedG2, D, 1024, S, E); tr_idle(F, args, 3); } SEAM(3);
    if (IN(4)) REPS(4) { phase_rownorm(F, args); } SEAM(4);
    if (IN(5)) REPS(5) { SchedDense S{F.G, F.c, wsc + WS_YN, wsc + WS_WOUT, nullptr}; EpiResF32 E{args.in[0], out, D};
        RUN_GEMM(EpiResF32, SchedDense, D, D, S, E); } SEAM(5);
    if (IN(6)) REPS(6) { phase_norm_x(F, out, args.in[14]); } SEAM(6);
#ifndef EXTRA_BARS
#define EXTRA_BARS 0
#endif
    if (IN(6) && IN(7)) { for (int xb = 0; xb < EXTRA_BARS; ++xb) xcd_barrier(bar); }
    if (IN(7)) REPS(7) { SchedDense S{F.G, F.c, wsc + WS_H, wsc + WS_WQ, (char*)(ws + WS_Q)};
        EpiF16 E{nullptr, 0.044194173824159216f};
        RUN_GEMM(EpiF16, SchedDense, D, D, S, E); } SEAM(7);
    if (IN(8)) REPS(8) { SchedS S{F.G, F.c, wsc + WS_Q, wsc + WS_K16}; EpiSoftmax E{(f16*)(ws + WS_P)};
        RUN_GEMM(EpiSoftmax, SchedS, D, D, S, E); tr_idle(F, args, 8); } SEAM(8);
    if (IN(9)) REPS(9) { SchedPV S{F.G, F.c, wsc + WS_P, wsc + WS_VT16, (char*)(ws + WS_O)};
        EpiF16 E{nullptr, 1.0f};
        RUN_GEMM(EpiF16, SchedPV, 256, 256, S, E); } SEAM(9);
    if (IN(10)) REPS(10) { SchedDense S{F.G, F.c, wsc + WS_O, wsc + WS_WO, nullptr}; EpiResF32 E{out, out, D};
        RUN_GEMM(EpiResF32, SchedDense, D, D, S, E); } SEAM(10);
    if (IN(11)) REPS(11) { phase_router(F, args, out); } SEAM(11);
    if (IN(12)) REPS(12) { phase_scatter(F); tr_drain(F, args, SEG_GU); } SEAM(12);
    if (IN(13)) REPS(13) { moe_table(F); SchedGU S{F.G, F.c, wsc + WS_XS, wsc + WS_WGU, (const LAS int*)(F.lds + TAB_OFF)}; EpiSwiGLU E{(f16*)(ws + WS_HID)};
        RUN_GEMM(EpiSwiGLU, SchedGU, D, D, S, E); tr_idle(F, args, 13); tr_drain(F, args, NITEMS); } SEAM(13);
    if (IN(14)) REPS(14) { moe_table(F); SchedDN S{F.G, F.c, wsc + WS_HID, wsc + WS_WDN, (const LAS int*)(F.lds + TAB_OFF)}; EpiDown E{(f16*)(ws + WS_YS), (const float*)(ws + WS_SLOTW)};
        RUN_GEMM(EpiDown, SchedDN, DE, DE, S, E); } SEAM(14);
    if (IN(15)) REPS(15) { phase_final(F, args, out); }
#undef IN
#undef SEAM
}

extern "C" void kernel_launch(void* const* d_in, const int* in_sizes, int n_in, void* d_out, int out_size, void* d_ws, size_t ws_size, hipStream_t stream) {
    static int grid = 0;
    if (grid == 0) {
        if (n_in != 28 || out_size != SEQ * D || ws_size < WS_END) { fprintf(stderr, "kernel_launch: unexpected sizes n_in %d out %d ws %zu\n", n_in, out_size, ws_size); grid = -1; return; }
        int dev = 0, cus = 0;
        if (hipGetDevice(&dev) != hipSuccess || hipDeviceGetAttribute(&cus, hipDeviceAttributeMultiprocessorCount, dev) != hipSuccess) { grid = -1; return; }
        if (hipFuncSetAttribute((const void*)fwd, hipFuncAttributeMaxDynamicSharedMemorySize, LDS_BYTES) != hipSuccess) { grid = -1; return; }
        int per_cu = 0;
        (void)hipOccupancyMaxActiveBlocksPerMultiprocessor(&per_cu, (const void*)fwd, 512, LDS_BYTES);
        (void)hipGetLastError();
        grid = cus;
    }
    if (grid < 0) return;
    (void)hipMemsetAsync((char*)d_ws + WS_CTL, 0, CTL_ZERO_BYTES, stream);
    Args a{};
    for (int i = 0; i < 28; ++i) a.in[i] = (const float*)d_in[i];
    a.out = (float*)d_out; a.ws = (unsigned char*)d_ws; a.pad = REP_N;
    if (MK_N_LAUNCHES == 1) { a.ph_lo = 0; a.ph_hi = NPHASE; a.li = 0; hipLaunchKernelGGL(fwd, dim3(grid), dim3(512), LDS_BYTES, stream, a);
#if EXTRA_PHASE >= 0
        for (int r = 0; r < EXTRA_N; ++r) { a.ph_lo = EXTRA_PHASE; a.ph_hi = EXTRA_PHASE + 1; a.li = 1 + r;
#if EXTRA_REQUEUE
            { static const unsigned hv = SEG_B; (void)hipMemsetAsync((char*)d_ws + WS_CTL + (CW_ARRIVE + 64 * EXTRA_PHASE) * 4, 0, 4, stream);
              (void)hipMemsetD32Async((hipDeviceptr_t)((char*)d_ws + WS_CTL + CW_QHEAD * 4), (int)hv, 1, stream); }
#endif
            hipLaunchKernelGGL(fwd, dim3(grid), dim3(512), LDS_BYTES, stream, a); }
#endif
    }
    else { for (int p = 0; p < NPHASE; ++p) { a.ph_lo = p; a.ph_hi = p + 1; a.li = p; hipLaunchKernelGGL(fwd, dim3(grid), dim3(512), LDS_BYTES, stream, a); } }
}
```

```cpp
#include <hip/hip_runtime.h>
#include <cstdio>
#include <cstdint>

#ifndef MK_N_LAUNCHES
#define MK_N_LAUNCHES 1
#endif
#ifndef EXTRA_PHASE
#define EXTRA_PHASE -1
#endif
#ifndef EXTRA_REQUEUE
#define EXTRA_REQUEUE 0
#endif
#ifndef EXTRA_N
#define EXTRA_N 2
#endif
#ifndef FAST_GEMM
#define FAST_GEMM 1
#endif

#define LAS __attribute__((address_space(3)))
#define GAS __attribute__((address_space(1)))
typedef _Float16 f16;
typedef _Float16 f16x8 __attribute__((ext_vector_type(8)));
typedef _Float16 f16x2 __attribute__((ext_vector_type(2)));
typedef float f32x4 __attribute__((ext_vector_type(4)));
typedef float f32x2 __attribute__((ext_vector_type(2)));
typedef unsigned u32x4 __attribute__((ext_vector_type(4)));
typedef unsigned u32x2 __attribute__((ext_vector_type(2)));

constexpr int SEQ = 8192, D = 2048, NPROJ = 3072, MEMLEN = 256, NHEAD = 4, HD = 512, NE = 32, DE = 512, CK = 31;
constexpr float EPS = 1e-6f;
constexpr int NPHASE = 16;

constexpr size_t MiB = 1u << 20;
constexpr size_t WS_CTL = 0, CTL_ZERO_BYTES = 65536;
constexpr size_t WS_HIST = 65536;
constexpr size_t WS_TOT = 98304;
constexpr size_t WS_TOKE = 131072;
constexpr size_t WS_TOKW = 196608;
constexpr size_t WS_TOKSLOT = 262144;
constexpr size_t WS_SLOTW = 327680;
constexpr size_t WS_TOKRS = 458752;
constexpr size_t WS_M16 = 1 * MiB, WS_K16 = 2 * MiB, WS_VT16 = 3 * MiB;
constexpr size_t WS_SSQY = 4 * MiB, WS_SSQX = 5 * MiB;
constexpr size_t WS_WIN = 8 * MiB, WS_WPOOL = 20 * MiB, WS_WPW = 22 * MiB, WS_WOUT = 24 * MiB, WS_WQ = 32 * MiB, WS_WKV = 40 * MiB, WS_WO = 56 * MiB,
                 WS_WGU = 64 * MiB, WS_WDN = 192 * MiB;
constexpr size_t WS_PROJ = 256 * MiB, WS_DC = 304 * MiB, WS_XS = 256 * MiB;
constexpr size_t WS_H = 352 * MiB, WS_Y = 384 * MiB, WS_YN = 416 * MiB, WS_YS = 352 * MiB;
constexpr size_t WS_Q = 448 * MiB, WS_P = 480 * MiB, WS_O = 496 * MiB, WS_HID = 448 * MiB;
constexpr size_t WS_END = 528 * MiB;
constexpr int CW_BAR = 4096;

constexpr int RING_BYTES = 131072;
constexpr int MISC_OFF = RING_BYTES;
constexpr int TAB_OFF = RING_BYTES + 256;
constexpr int LDS_BYTES = 147456;

#define LDS_WAIT() asm volatile("s_waitcnt lgkmcnt(0)" ::: "memory")
#define VM_WAIT() asm volatile("s_waitcnt vmcnt(0)" ::: "memory")

__device__ __forceinline__ unsigned pk2h(float lo, float hi) { f32x2 v = {lo, hi}; f16x2 h = __builtin_convertvector(v, f16x2); return __builtin_bit_cast(unsigned, h); }
__device__ __forceinline__ f32x2 unpk2h(unsigned u) { f16x2 h = __builtin_bit_cast(f16x2, u); return __builtin_convertvector(h, f32x2); }
__device__ __forceinline__ float wave_sum(float v) {
#pragma unroll
    for (int o = 1; o < 64; o <<= 1) v += __shfl_xor(v, o);
    return v;
}
__device__ __forceinline__ float fast_sigmoid(float x) { return __builtin_amdgcn_rcpf(1.0f + __expf(-x)); }

#define XB_TMO      128
#define XB_XCNT(j)  (256  + 64 * (j))
#define XB_XSUB(j)  (1280 + 64 * (j))
#define XB_XGEN(j)  (2304 + 64 * (j))
#define XB_TOP      3328
#define XB_TOPGEN   3392
#define XCD_BAR_WORDS 3456
#define XB_SPIN_CAP (1u << 18)
__device__ __forceinline__ unsigned xb_ld(unsigned* p)              { return __hip_atomic_load(p, __ATOMIC_RELAXED, __HIP_MEMORY_SCOPE_AGENT); }
__device__ __forceinline__ unsigned xb_add(unsigned* p, unsigned v) { return __hip_atomic_fetch_add(p, v, __ATOMIC_RELAXED, __HIP_MEMORY_SCOPE_AGENT); }
__device__ __forceinline__ unsigned xb_xcc_id() { return (unsigned)__builtin_amdgcn_s_getreg((3 << 11) | 20) & 0xFu; }
#define XB_SPIN(cond, bar) do { unsigned _sp = 0; while (cond) { __builtin_amdgcn_s_sleep(1); \
    if ((++_sp & 255u) == 0u) { if (xb_ld(&(bar)[XB_TMO])) break; if (_sp > XB_SPIN_CAP) { atomicAdd(&(bar)[XB_TMO], 1u); break; } } } } while (0)
struct XcdBarrier { unsigned* bar; unsigned x; volatile LAS unsigned* st; };
__device__ __forceinline__ XcdBarrier xcd_barrier_post(unsigned* bar, volatile LAS unsigned* st) {
    XcdBarrier b; b.bar = bar; b.x = xb_xcc_id(); b.st = st;
    if (threadIdx.x == 0) (void)xb_add(&bar[XB_XCNT(b.x)], 1u);
    return b;
}
__device__ __forceinline__ void xcd_barrier_complete(unsigned* bar, unsigned x, unsigned& nloc, unsigned& nx) {
    const unsigned G = gridDim.x * gridDim.y * gridDim.z;
    unsigned sum, cnt, mine, sp = 0u;
    for (;;) {
        sum = 0u; cnt = 0u; mine = 0u;
#pragma unroll
        for (unsigned j = 0; j < 16; ++j) { const unsigned c = xb_ld(&bar[XB_XCNT(j)]); sum += c; cnt += (c > 0u) ? 1u : 0u; mine = (j == x) ? c : mine; }
        if (sum == G) break;
        __builtin_amdgcn_s_sleep(1);
        if ((++sp & 255u) == 0u) { if (xb_ld(&bar[XB_TMO])) break; if (sp > XB_SPIN_CAP) { atomicAdd(&bar[XB_TMO], 1u); break; } }
    }
    nloc = mine > 0u ? mine : 1u; nx = cnt > 0u ? cnt : 1u;
}
__device__ __forceinline__ void xcd_barrier(const XcdBarrier& b) {
    asm volatile("s_waitcnt vmcnt(0)" ::: "memory");
    __syncthreads();
    if (threadIdx.x == 0) {
        unsigned* bar = b.bar;
        __builtin_amdgcn_s_waitcnt(0);
        unsigned nloc = b.st[0], nx = b.st[1];
        if (nloc == 0u) { xcd_barrier_complete(bar, b.x, nloc, nx); b.st[0] = nloc; b.st[1] = nx; }
        const unsigned old = xb_add(&bar[XB_XSUB(b.x)], 1u);
        const unsigned gen = old / nloc;
        if (old + 1u == (gen + 1u) * nloc) {
            __builtin_amdgcn_fence(__ATOMIC_RELEASE, "agent");
            asm volatile("s_waitcnt vmcnt(0)" ::: "memory");
            const unsigned og = xb_add(&bar[XB_TOP], 1u);
            const unsigned tg = og / nx;
            if (og + 1u == (tg + 1u) * nx) xb_add(&bar[XB_TOPGEN], 1u);
            else XB_SPIN(xb_ld(&bar[XB_TOPGEN]) == tg, bar);
            __builtin_amdgcn_fence(__ATOMIC_ACQUIRE, "agent");
            xb_add(&bar[XB_XGEN(b.x)], 1u);
            asm volatile("s_waitcnt vmcnt(0)" ::: "memory");
        } else {
            XB_SPIN(xb_ld(&bar[XB_XGEN(b.x)]) == gen, bar);
            __builtin_amdgcn_fence(__ATOMIC_ACQUIRE, "agent");
            asm volatile("s_waitcnt vmcnt(0)" ::: "memory");
        }
    }
    __syncthreads();
}

namespace pg8 {
constexpr int BM = 256, BK = 64, HALF = 128, HTB = HALF * BK * 2, STAGE_BYTES = 8 * HTB, NXCD = 8, WGM = 8;
__host__ __device__ __forceinline__ int lds_byte(int r, int c) { const int st = (r >> 4) * 2 + (c >> 5), rr = r & 15, cc = c & 31, ob = rr * 64 + cc * 2; return st * 1024 + (ob ^ (((ob >> 9) & 1) << 5)); }
__host__ __device__ __forceinline__ void stage_rc(int b, int& R, int& C) { const int st = b / 1024, sb = b % 1024, swz = sb ^ (((sb >> 9) & 1) << 5); R = (st >> 1) * 16 + swz / 64; C = (st & 1) * 32 + (swz % 64) / 2; }
__host__ __device__ __forceinline__ int perm32(int rho) { const int n = rho >> 4, i = rho & 15; return 8 * (i >> 2) + 4 * n + (i & 3); }

struct Unit { const char* a; const char* b; char* o; int ldc; int nt; int r0, c0, kind, aux, half; };

__device__ __forceinline__ void tile_of(int L, int nM, int nN, int& pm, int& pn) {
    const int nwg = nM * nN; int wgid = L;
    { const int q = nwg / NXCD, r = nwg % NXCD, xcd = wgid % NXCD, off = wgid / NXCD; wgid = (xcd < r ? xcd * (q + 1) : r * (q + 1) + (xcd - r) * q) + off; }
    const int nig = WGM * nN, gid = wgid / nig, fm = gid * WGM, gsz = (nM - fm) < WGM ? (nM - fm) : WGM;
    pm = fm + ((wgid % nig) % gsz); pn = (wgid % nig) / gsz;
}
__device__ __forceinline__ void tile_of_w(int wgid, int nM, int nN, int& pm, int& pn) {
    const int nig = WGM * nN, gid = wgid / nig, fm = gid * WGM, gsz = (nM - fm) < WGM ? (nM - fm) : WGM;
    pm = fm + ((wgid % nig) % gsz); pn = (wgid % nig) / gsz;
}
__device__ __forceinline__ int xcd_chunk(int L, int nwg) {
    const int q = nwg / NXCD, r = nwg % NXCD, xcd = L % NXCD, off = L / NXCD; return (xcd < r ? xcd * (q + 1) : r * (q + 1) + (xcd - r) * q) + off;
}

typedef f32x4 Acc[2][2][4][2];

template <class Epi, class Sched>
__device__ __forceinline__ void gemm_phase_simple(LAS unsigned char* lds, int lda, int ldb, const Sched& S, const Epi& E) {
    const int tid = threadIdx.x, wid = __builtin_amdgcn_readfirstlane(tid >> 6), lane = tid & 63, wr = wid >> 2, wc = wid & 3, fr = lane & 15, fq = lane >> 4;
    Unit u;
    for (int ui = 0; S.next(ui, u); ++ui) {
        Acc acc;
#pragma unroll
        for (int a = 0; a < 2; ++a)
#pragma unroll
            for (int b = 0; b < 2; ++b)
#pragma unroll
                for (int m = 0; m < 4; ++m)
#pragma unroll
                    for (int n = 0; n < 2; ++n) acc[a][b][m][n] = (f32x4){0.f, 0.f, 0.f, 0.f};
        for (int ks = 0; ks < u.nt * 2; ++ks) {
            f16x8 Af[2][4], Bf[2][2];
            const size_t kb = (size_t)(ks * 32 + fq * 8) * 2;
#pragma unroll
            for (int ai = 0; ai < 2; ++ai)
#pragma unroll
                for (int m = 0; m < 4; ++m) Af[ai][m] = *(const f16x8*)(u.a + (size_t)(ai * 128 + wr * 64 + m * 16 + fr) * lda * 2 + kb);
#pragma unroll
            for (int bj = 0; bj < 2; ++bj)
#pragma unroll
                for (int n = 0; n < 2; ++n) { const int rr = Epi::PERM ? (8 * (fr >> 2) + 4 * n + (fr & 3)) : (n * 16 + fr);
                    Bf[bj][n] = *(const f16x8*)(u.b + (size_t)(bj * 128 + wc * 32 + rr) * ldb * 2 + kb); }
#pragma unroll
            for (int ai = 0; ai < 2; ++ai)
#pragma unroll
                for (int bj = 0; bj < 2; ++bj)
#pragma unroll
                    for (int m = 0; m < 4; ++m)
#pragma unroll
                        for (int n = 0; n < 2; ++n) acc[ai][bj][m][n] = __builtin_amdgcn_mfma_f32_16x16x32_f16(Bf[bj][n], Af[ai][m], acc[ai][bj][m][n], 0, 0, 0);
        }
        if constexpr (Epi::AFTER_DRAIN) { __syncthreads(); E.fused(acc, u, wr, wc, fr, fq, lds, wid, lane); __syncthreads(); }
        else E(acc, u, wr, wc, fr, fq);
    }
}
#define PG8_LAS LAS
template <class Epi, class Sched, bool ALIGN_EPI = false, bool SP2 = false>
__device__ __forceinline__ void gemm_phase(PG8_LAS unsigned char* lds, const int lda, const int ldb, const size_t kstepB, const Sched& S, const Epi& E) {
    const int tid = threadIdx.x, wid = __builtin_amdgcn_readfirstlane(tid >> 6), lane = tid & 63, wr = wid >> 2, wc = wid & 3, fr = lane & 15, fq = lane >> 4;
    unsigned voffA[2], voffB[2];
#pragma unroll
    for (int i = 0; i < 2; ++i) { int R, C; stage_rc(tid * 16 + i * 8192, R, C); const int Rb = Epi::PERM ? ((R & ~31) + perm32(R & 31)) : R;
        voffA[i] = (unsigned)(R * lda + C) * 2u; voffB[i] = (unsigned)(Rb * ldb + C) * 2u; }
    const size_t kstep = (size_t)(BK * 2);
    const size_t hstepA = (size_t)HALF * lda * 2, hstepB = (size_t)HALF * ldb * 2;
    const unsigned ldsw = (unsigned)wid * 1024u;
    const int aoff = lds_byte(wr * 64 + fr, fq * 8), boff = lds_byte(wc * 32 + fr, fq * 8);
#define PG8_SA(b, h) (((b) * 2 + (h)) * HTB)
#define PG8_SB(b, h) ((4 + (b) * 2 + (h)) * HTB)
#define PG8_STAGE(bufoff, gbase, voff) do { _Pragma("unroll") for (int _i = 0; _i < 2; ++_i) \
        __builtin_amdgcn_global_load_lds((const unsigned*)((const char*)(gbase) + (voff)[_i]), (PG8_LAS unsigned*)(lds + (bufoff) + ldsw + _i * 8192), 16, 0, 0); } while (0)
#define PG8_LDA(dst, b, h) do { _Pragma("unroll") for (int m = 0; m < 4; ++m) _Pragma("unroll") for (int k = 0; k < 2; ++k) dst[m][k] = *(const PG8_LAS f16x8*)(lds + PG8_SA(b, h) + aoff + m * 2048 + k * 1024); } while (0)
#define PG8_LDB(dst, b, h) do { _Pragma("unroll") for (int n = 0; n < 2; ++n) _Pragma("unroll") for (int k = 0; k < 2; ++k) dst[n][k] = *(const PG8_LAS f16x8*)(lds + PG8_SB(b, h) + boff + n * 2048 + k * 1024); } while (0)
#define PG8_MMA(ai, bj, At, Bt) do { __builtin_amdgcn_s_setprio(1); _Pragma("unroll") for (int m = 0; m < 4; ++m) _Pragma("unroll") for (int n = 0; n < 2; ++n) _Pragma("unroll") for (int k = 0; k < 2; ++k) \
        acc[ai][bj][m][n] = __builtin_amdgcn_mfma_f32_16x16x32_f16(Bt[n][k], At[m][k], acc[ai][bj][m][n], 0, 0, 0); __builtin_amdgcn_s_setprio(0); } while (0)
#define PG8_WAIT_V(n) asm volatile("s_waitcnt vmcnt(" #n ")" ::: "memory")
#define PG8_WAIT_L(n) asm volatile("s_waitcnt lgkmcnt(" #n ")" ::: "memory")
#define PG8_BAR __builtin_amdgcn_s_barrier()
#define PG8_SCHED __builtin_amdgcn_sched_barrier(0)
    Unit cur, nxt; int ui = 0;
    if (!S.next(0, cur)) return;
    f32x4 acc[2][2][4][2];
#pragma unroll
    for (int a = 0; a < 2; ++a)
#pragma unroll
        for (int b = 0; b < 2; ++b)
#pragma unroll
            for (int m = 0; m < 4; ++m)
#pragma unroll
                for (int n = 0; n < 2; ++n) acc[a][b][m][n] = (f32x4){0.f, 0.f, 0.f, 0.f};
    f16x8 At[4][2], B0[2][2], B1[2][2];
    const char* cA = cur.a; const char* cB = cur.b;
    if constexpr (SP2) {
        PG8_STAGE(PG8_SB(0, 0), cB, voffB); PG8_STAGE(PG8_SB(0, 1), cB + hstepB, voffB); PG8_STAGE(PG8_SA(0, 0), cA, voffA); PG8_STAGE(PG8_SA(0, 1), cA + hstepA, voffA);
        if (wr == 1) PG8_BAR;
        PG8_WAIT_V(2); PG8_BAR;
        PG8_STAGE(PG8_SB(1, 0), cB + kstepB, voffB); PG8_STAGE(PG8_SA(1, 0), cA + kstep, voffA); PG8_STAGE(PG8_SB(1, 1), cB + hstepB + kstepB, voffB);
        PG8_WAIT_V(6); PG8_BAR;
    } else {
        PG8_STAGE(PG8_SB(0, 0), cB, voffB); PG8_STAGE(PG8_SA(0, 0), cA, voffA); PG8_STAGE(PG8_SB(0, 1), cB + hstepB, voffB); PG8_STAGE(PG8_SA(0, 1), cA + hstepA, voffA);
        if (wr == 1) PG8_BAR;
        PG8_WAIT_V(4); PG8_BAR;
        PG8_STAGE(PG8_SB(1, 0), cB + kstepB, voffB); PG8_STAGE(PG8_SA(1, 0), cA + kstep, voffA); PG8_STAGE(PG8_SB(1, 1), cB + hstepB + kstepB, voffB);
        PG8_WAIT_V(6); PG8_BAR;
    }
    for (;;) {
        const bool has_next = S.next(ui + 1, nxt);
        const char* nA = has_next ? nxt.a : cA; const char* nB = has_next ? nxt.b : cB; int nt = __builtin_amdgcn_readfirstlane(cur.nt); asm volatile("" : "+s"(nt)); int fullu = __builtin_amdgcn_readfirstlane(cur.half ? 0 : 1); asm volatile("" : "+s"(fullu));
#pragma unroll 1
        for (int t = 0; t < nt; t += 2) {
            const bool last = (t == nt - 2);
            const char* a1 = cA + (size_t)(t + 1) * kstep;
            const char* a2 = last ? nA : cA + (size_t)(t + 2) * kstep; const char* b2 = last ? nB : cB + (size_t)(t + 2) * kstepB;
            const char* a3 = a2 + kstep; const char* b3 = b2 + kstepB;
            if constexpr (SP2) {
            PG8_LDB(B0, 0, 0); PG8_LDB(B1, 0, 1); PG8_SCHED; PG8_LDA(At, 0, 0); PG8_STAGE(PG8_SA(1, 1), a1 + hstepA, voffA);
            PG8_WAIT_V(8); PG8_WAIT_L(0); PG8_BAR; PG8_MMA(0, 0, At, B0); PG8_MMA(0, 1, At, B1); PG8_BAR; PG8_SCHED;
            PG8_LDA(At, 0, 1); PG8_STAGE(PG8_SB(0, 0), b2, voffB); PG8_STAGE(PG8_SB(0, 1), b2 + hstepB, voffB); PG8_STAGE(PG8_SA(0, 0), a2, voffA);
            PG8_WAIT_V(8); PG8_WAIT_L(0); PG8_BAR; if (fullu) { PG8_MMA(1, 0, At, B0); PG8_MMA(1, 1, At, B1); } PG8_BAR; PG8_SCHED;
            PG8_LDB(B0, 1, 0); PG8_LDB(B1, 1, 1); PG8_SCHED; PG8_LDA(At, 1, 0); PG8_STAGE(PG8_SA(0, 1), a2 + hstepA, voffA);
            PG8_WAIT_V(8); PG8_WAIT_L(0); PG8_BAR; PG8_MMA(0, 0, At, B0); PG8_MMA(0, 1, At, B1); PG8_BAR; PG8_SCHED;
            PG8_LDA(At, 1, 1); PG8_STAGE(PG8_SB(1, 0), b3, voffB); PG8_STAGE(PG8_SB(1, 1), b3 + hstepB, voffB); PG8_STAGE(PG8_SA(1, 0), a3, voffA);
            PG8_WAIT_V(8); PG8_WAIT_L(0); PG8_BAR; if (fullu) { PG8_MMA(1, 0, At, B0); PG8_MMA(1, 1, At, B1); } PG8_BAR; PG8_SCHED;
            } else {
            PG8_LDB(B0, 0, 0); PG8_SCHED; PG8_LDA(At, 0, 0); PG8_STAGE(PG8_SA(1, 1), a1 + hstepA, voffA);
            PG8_WAIT_L(8); PG8_BAR; PG8_WAIT_L(0); PG8_MMA(0, 0, At, B0); PG8_BAR; PG8_SCHED;
            PG8_LDB(B1, 0, 1); PG8_STAGE(PG8_SB(0, 0), b2, voffB);
            PG8_BAR; PG8_WAIT_L(0); PG8_MMA(0, 1, At, B1); PG8_BAR;
            PG8_LDA(At, 0, 1); PG8_STAGE(PG8_SA(0, 0), a2, voffA);
            PG8_BAR; PG8_WAIT_L(0); PG8_MMA(1, 0, At, B0); PG8_BAR; PG8_SCHED;
            PG8_STAGE(PG8_SB(0, 1), b2 + hstepB, voffB);
            PG8_WAIT_V(6); PG8_BAR; PG8_MMA(1, 1, At, B1); PG8_BAR;
            PG8_LDB(B0, 1, 0); PG8_SCHED; PG8_LDA(At, 1, 0); PG8_STAGE(PG8_SA(0, 1), a2 + hstepA, voffA);
            PG8_WAIT_L(8); PG8_BAR; PG8_WAIT_L(0); PG8_MMA(0, 0, At, B0); PG8_BAR; PG8_SCHED;
            PG8_LDB(B1, 1, 1); PG8_STAGE(PG8_SB(1, 0), b3, voffB);
            PG8_BAR; PG8_WAIT_L(0); PG8_MMA(0, 1, At, B1); PG8_BAR;
            PG8_LDA(At, 1, 1); PG8_STAGE(PG8_SA(1, 0), a3, voffA);
            PG8_BAR; PG8_WAIT_L(0); PG8_MMA(1, 0, At, B0); PG8_BAR; PG8_SCHED;
            PG8_STAGE(PG8_SB(1, 1), b3 + hstepB, voffB);
            PG8_WAIT_V(6); PG8_BAR; PG8_MMA(1, 1, At, B1); PG8_BAR;
            }
        }
        if constexpr (ALIGN_EPI) { if (wr == 0) PG8_BAR; }
        bool keep_acc = false;
        if constexpr (Epi::HAS_MID) { if (cur.kind == 2) { E.mid(acc, cur, wr, wc, fr, fq); keep_acc = true; } }
        if constexpr (!Epi::AFTER_DRAIN) { if (!keep_acc) E(acc, cur, wr, wc, fr, fq); }
        if (!has_next) break;
        if (!keep_acc) {
#pragma unroll
        for (int a = 0; a < 2; ++a)
#pragma unroll
            for (int b = 0; b < 2; ++b)
#pragma unroll
                for (int m = 0; m < 4; ++m)
#pragma unroll
                    for (int n = 0; n < 2; ++n) acc[a][b][m][n] = (f32x4){0.f, 0.f, 0.f, 0.f};
        }
        cur = nxt; cA = nA; cB = nB; ++ui;
        if constexpr (ALIGN_EPI) { if (wr == 1) PG8_BAR; }
    }
    PG8_WAIT_V(0);
    if constexpr (!ALIGN_EPI) { if (wr == 0) PG8_BAR; }
    PG8_BAR;
    if constexpr (Epi::AFTER_DRAIN) { E.fused(acc, cur, wr, wc, fr, fq, lds, wid, lane); }
#undef PG8_SA
#undef PG8_SB
#undef PG8_STAGE
#undef PG8_LDA
#undef PG8_LDB
#undef PG8_MMA
#undef PG8_WAIT_V
#undef PG8_WAIT_L
#undef PG8_BAR
#undef PG8_SCHED
}
}
using pg8::Unit; using pg8::Acc;

struct EpiF16 {
    static constexpr bool PERM = true, AFTER_DRAIN = false, HAS_MID = false;
    const float* cs0; float scale;
    float* ssq = nullptr;
    const LAS float* rowscale = nullptr;
    __device__ __forceinline__ void mid(Acc&, const Unit&, int, int, int, int) const {}
    __device__ __forceinline__ void operator()(const Acc& acc, const Unit& u, int wr, int wc, int fr, int fq) const {
        f16* base = (f16*)u.o; const int ldc = u.ldc;
        const int row0 = u.r0 + wr * 64 + fr, col0 = u.c0 + wc * 32 + 8 * fq;
        const bool has_cs = (u.kind == 0) && (cs0 != nullptr);
        f32x4 c00, c01, c10, c11;
        if (has_cs) { c00 = *(const f32x4*)(cs0 + col0); c01 = *(const f32x4*)(cs0 + col0 + 4); c10 = *(const f32x4*)(cs0 + col0 + 128); c11 = *(const f32x4*)(cs0 + col0 + 132); }
#pragma unroll
        for (int ai = 0; ai < 2; ++ai) { if (ai == 1 && u.half) break;
#pragma unroll
            for (int m = 0; m < 4; ++m) { f16* rowp = base + (size_t)(row0 + ai * 128 + m * 16) * ldc + col0;
                float rsc = scale; if (rowscale) rsc *= rowscale[ai * 128 + wr * 64 + m * 16 + fr];
                float sq = 0.f;
#pragma unroll
                for (int bj = 0; bj < 2; ++bj) { f32x4 v0 = acc[ai][bj][m][0] * rsc, v1 = acc[ai][bj][m][1] * rsc;
                    if (has_cs) { v0 = v0 * (bj ? c10 : c00); v1 = v1 * (bj ? c11 : c01); }
                    sq += v0[0] * v0[0] + v0[1] * v0[1] + v0[2] * v0[2] + v0[3] * v0[3] + v1[0] * v1[0] + v1[1] * v1[1] + v1[2] * v1[2] + v1[3] * v1[3];
                    u32x4 w; w.x = pk2h(v0[0], v0[1]); w.y = pk2h(v0[2], v0[3]); w.z = pk2h(v1[0], v1[1]); w.w = pk2h(v1[2], v1[3]);
                    *(u32x4*)(rowp + bj * 128) = w; }
                if (ssq) { sq += __shfl_xor(sq, 16); sq += __shfl_xor(sq, 32); if (fq == 0) ssq[(size_t)(row0 + ai * 128 + m * 16) * 32 + (u.c0 >> 8) * 4 + wc] = sq; } } }
    }
};
struct EpiResF32 {
    static constexpr bool PERM = false, AFTER_DRAIN = false, HAS_MID = false;
    __device__ __forceinline__ void mid(Acc&, const Unit&, int, int, int, int) const {}
    const float* base; float* out; int ldc;
    __device__ __forceinline__ void operator()(const Acc& acc, const Unit& u, int wr, int wc, int fr, int fq) const {
        const int row0 = u.r0 + wr * 64 + fr, col0 = u.c0 + wc * 32 + 4 * fq;
#pragma unroll
        for (int ai = 0; ai < 2; ++ai) {
            f32x4 bs[4][2][2];
#pragma unroll
            for (int m = 0; m < 4; ++m) { const size_t off = (size_t)(row0 + ai * 128 + m * 16) * ldc + col0;
#pragma unroll
                for (int bj = 0; bj < 2; ++bj)
#pragma unroll
                    for (int n = 0; n < 2; ++n) bs[m][bj][n] = *(const f32x4*)(base + off + bj * 128 + n * 16); }
#pragma unroll
            for (int m = 0; m < 4; ++m) { const size_t off = (size_t)(row0 + ai * 128 + m * 16) * ldc + col0;
#pragma unroll
                for (int bj = 0; bj < 2; ++bj)
#pragma unroll
                    for (int n = 0; n < 2; ++n) *(f32x4*)(out + off + bj * 128 + n * 16) = bs[m][bj][n] + acc[ai][bj][m][n]; }
        }
    }
};
struct EpiG3 {
    static constexpr bool PERM = false, AFTER_DRAIN = false, HAS_MID = true;
    const float* base; float* out; f16* xh; float* ssq; const LAS f32x2* fac;
    __device__ __forceinline__ void mid(Acc& acc, const Unit& u, int wr, int wc, int fr, int fq) const {
#pragma unroll
        for (int ai = 0; ai < 2; ++ai)
#pragma unroll
            for (int m = 0; m < 4; ++m) { const float r = fac[ai * 128 + wr * 64 + m * 16 + fr][0];
#pragma unroll
                for (int bj = 0; bj < 2; ++bj)
#pragma unroll
                    for (int n = 0; n < 2; ++n) acc[ai][bj][m][n] = acc[ai][bj][m][n] * r; }
    }
    __device__ __forceinline__ void operator()(const Acc& acc, const Unit& u, int wr, int wc, int fr, int fq) const {
        const int row0 = u.r0 + wr * 64 + fr, col0 = u.c0 + wc * 32 + 4 * fq;
#pragma unroll
        for (int ai = 0; ai < 2; ++ai) {
            f32x4 bs[4][2][2];
#pragma unroll
            for (int m = 0; m < 4; ++m) { const size_t off = (size_t)(row0 + ai * 128 + m * 16) * D + col0;
#pragma unroll
                for (int bj = 0; bj < 2; ++bj)
#pragma unroll
                    for (int n = 0; n < 2; ++n) bs[m][bj][n] = *(const f32x4*)(base + off + bj * 128 + n * 16); }
#pragma unroll
            for (int m = 0; m < 4; ++m) { const size_t off = (size_t)(row0 + ai * 128 + m * 16) * D + col0; const float rb = fac[ai * 128 + wr * 64 + m * 16 + fr][1]; float sq = 0.f;
#pragma unroll
                for (int bj = 0; bj < 2; ++bj)
#pragma unroll
                    for (int n = 0; n < 2; ++n) { const f32x4 v = bs[m][bj][n] + acc[ai][bj][m][n] * rb; *(f32x4*)(out + off + bj * 128 + n * 16) = v;
                        sq += v[0] * v[0] + v[1] * v[1] + v[2] * v[2] + v[3] * v[3];
                        u32x2 h; h.x = pk2h(v[0], v[1]); h.y = pk2h(v[2], v[3]); *(u32x2*)(xh + off + bj * 128 + n * 16) = h; }
                sq += __shfl_xor(sq, 16); sq += __shfl_xor(sq, 32); if (fq == 0) ssq[(size_t)(row0 + ai * 128 + m * 16) * 32 + (u.c0 >> 8) * 4 + wc] = sq; }
        }
    }
};
struct EpiSwiGLU {
    static constexpr bool PERM = true, AFTER_DRAIN = false, HAS_MID = false;
    __device__ __forceinline__ void mid(Acc&, const Unit&, int, int, int, int) const {}
    f16* hid;
    __device__ __forceinline__ void operator()(const Acc& acc, const Unit& u, int wr, int wc, int fr, int fq) const {
        const int row0 = u.r0 + wr * 64 + fr, col0 = u.c0 + wc * 32 + 8 * fq;
#pragma unroll
        for (int ai = 0; ai < 2; ++ai) { if (ai == 1 && u.half) break;
#pragma unroll
            for (int m = 0; m < 4; ++m) { f16* rowp = hid + (size_t)(row0 + ai * 128 + m * 16) * DE + col0;
                float h[8];
#pragma unroll
                for (int n = 0; n < 2; ++n)
#pragma unroll
                    for (int j = 0; j < 4; ++j) { const float g = acc[ai][0][m][n][j], up = acc[ai][1][m][n][j]; h[n * 4 + j] = g * fast_sigmoid(g) * up; }
                u32x4 w; w.x = pk2h(h[0], h[1]); w.y = pk2h(h[2], h[3]); w.z = pk2h(h[4], h[5]); w.w = pk2h(h[6], h[7]);
                *(u32x4*)rowp = w; } }
    }
};
struct EpiDown {
    static constexpr bool PERM = true, AFTER_DRAIN = false, HAS_MID = false;
    __device__ __forceinline__ void mid(Acc&, const Unit&, int, int, int, int) const {}
    f16* ys; const float* slot_w;
    __device__ __forceinline__ void operator()(const Acc& acc, const Unit& u, int wr, int wc, int fr, int fq) const {
        const int row0 = u.r0 + wr * 64 + fr, col0 = u.c0 + wc * 32 + 8 * fq;
        float sw[2][4];
#pragma unroll
        for (int ai = 0; ai < 2; ++ai)
#pragma unroll
            for (int m = 0; m < 4; ++m) sw[ai][m] = slot_w[row0 + ai * 128 + m * 16];
#pragma unroll
        for (int ai = 0; ai < 2; ++ai) { if (ai == 1 && u.half) break;
#pragma unroll
            for (int m = 0; m < 4; ++m) { const int row = row0 + ai * 128 + m * 16; f16* rowp = ys + (size_t)row * D + col0;
#pragma unroll
                for (int bj = 0; bj < 2; ++bj) { const f32x4 v0 = acc[ai][bj][m][0] * sw[ai][m], v1 = acc[ai][bj][m][1] * sw[ai][m];
                    u32x4 w; w.x = pk2h(v0[0], v0[1]); w.y = pk2h(v0[2], v0[3]); w.z = pk2h(v1[0], v1[1]); w.w = pk2h(v1[2], v1[3]);
                    *(u32x4*)(rowp + bj * 128) = w; } } }
    }
};
struct EpiSoftmax {
    static constexpr bool PERM = true, AFTER_DRAIN = true, HAS_MID = false;
    __device__ __forceinline__ void mid(Acc&, const Unit&, int, int, int, int) const {}
    f16* P;
    __device__ __forceinline__ void operator()(const Acc&, const Unit&, int, int, int, int) const {}
    __device__ __forceinline__ void fused(Acc& acc, const Unit& u, int wr, int wc, int fr, int fq, LAS unsigned char* lds, int wid, int lane) const {
        LAS f32x2* T = (LAS f32x2*)lds;
        float mloc[2][4], lloc[2][4];
#pragma unroll
        for (int ai = 0; ai < 2; ++ai) { if (ai == 1 && u.half) break;
#pragma unroll
            for (int m = 0; m < 4; ++m) {
                float mx = -3.0e38f;
#pragma unroll
                for (int bj = 0; bj < 2; ++bj)
#pragma unroll
                    for (int n = 0; n < 2; ++n)
#pragma unroll
                        for (int j = 0; j < 4; ++j) mx = fmaxf(mx, acc[ai][bj][m][n][j]);
                mx = fmaxf(mx, __shfl_xor(mx, 16)); mx = fmaxf(mx, __shfl_xor(mx, 32));
                float s = 0.f;
#pragma unroll
                for (int bj = 0; bj < 2; ++bj)
#pragma unroll
                    for (int n = 0; n < 2; ++n)
#pragma unroll
                        for (int j = 0; j < 4; ++j) { const float e = __expf(acc[ai][bj][m][n][j] - mx); acc[ai][bj][m][n][j] = e; s += e; }
                s += __shfl_xor(s, 16); s += __shfl_xor(s, 32);
                mloc[ai][m] = mx; lloc[ai][m] = s;
                if (fq == 0) T[(ai * 128 + wr * 64 + m * 16 + fr) * 4 + wc] = (f32x2){mx, s};
            } }
        LDS_WAIT(); __builtin_amdgcn_s_barrier(); asm volatile("" ::: "memory");
        const int row0 = u.r0 + wr * 64 + fr, col0 = u.c0 + wc * 32 + 8 * fq;
#pragma unroll
        for (int ai = 0; ai < 2; ++ai) { if (ai == 1 && u.half) break;
#pragma unroll
            for (int m = 0; m < 4; ++m) { const int r = ai * 128 + wr * 64 + m * 16 + fr;
                const f32x2 t0 = T[r * 4 + 0], t1 = T[r * 4 + 1], t2 = T[r * 4 + 2], t3 = T[r * 4 + 3];
                const float M = fmaxf(fmaxf(t0.x, t1.x), fmaxf(t2.x, t3.x));
                const float L = t0.y * __expf(t0.x - M) + t1.y * __expf(t1.x - M) + t2.y * __expf(t2.x - M) + t3.y * __expf(t3.x - M);
                const float f = __expf(mloc[ai][m] - M) / L;
                f16* rowp = P + (size_t)(row0 + ai * 128 + m * 16) * 256 + col0;
#pragma unroll
                for (int bj = 0; bj < 2; ++bj) { const f32x4 v0 = acc[ai][bj][m][0] * f, v1 = acc[ai][bj][m][1] * f;
                    u32x4 w; w.x = pk2h(v0[0], v0[1]); w.y = pk2h(v0[2], v0[3]); w.z = pk2h(v1[0], v1[1]); w.w = pk2h(v1[2], v1[3]);
                    *(u32x4*)(rowp + bj * 128) = w; } } }
        (void)lloc;
    }
};

struct Frame {
    LAS unsigned char* lds;
    unsigned char* ws;
    int tid, lane, wave, G, c;
};
struct Args { const float* in[28]; float* out; unsigned char* ws; int ph_lo, ph_hi, li, pad; };

struct SchedP1 {
    int G, c; const char* h16; const char* win; const char* m16; const char* wkv; char* proj; char* k16; char* vt16;
    __device__ __forceinline__ bool next(int i, Unit& u) const {
        if (i > 1) return false;
        const int L = (G == 256) ? (64 * (c & 7) + 32 * i + (c >> 3)) : (i * G + c); if (L >= 400) return false;
        u.nt = 32; u.aux = 0; u.half = 0;
        if (L < 384) { int pm, pn; if (G == 256) pg8::tile_of_w(L, 32, 12, pm, pn); else pg8::tile_of(L, 32, 12, pm, pn); u.a = h16 + (size_t)pm * 256 * D * 2; u.b = win + (size_t)pn * 256 * D * 2; u.r0 = pm * 256; u.c0 = pn * 256; u.kind = 0; u.o = proj; u.ldc = NPROJ; }
        else if (L < 392) { const int pn = L - 384; u.a = m16; u.b = wkv + (size_t)pn * 256 * D * 2; u.r0 = 0; u.c0 = pn * 256; u.kind = 1; u.o = k16; u.ldc = D; }
        else { const int pm = L - 392; u.a = wkv + (size_t)(2048 + pm * 256) * D * 2; u.b = m16; u.r0 = pm * 256; u.c0 = 0; u.kind = 2; u.o = vt16; u.ldc = 256; }
        return true;
    }
};
struct SchedG2 {
    int G, c; const char* dc; const char* wpw; const char* wpool; char* y;
    __device__ __forceinline__ bool next(int i, Unit& u) const {
        const int L = i * G + c; if (L >= 256) return false;
        u.aux = 0; u.half = 0; u.o = y; u.ldc = D;
        if (L < 128) { int pm, pn; pg8::tile_of(L, 32, 4, pm, pn); u.a = dc + ((size_t)pm * 256 * D + 1024) * 2; u.b = wpw + (size_t)pn * 256 * 1024 * 2; u.nt = 16; u.r0 = pm * 256; u.c0 = 1024 + pn * 256; u.kind = 1; }
        else { int pm, g; pg8::tile_of(L - 128, 32, 4, pm, g); u.a = dc + ((size_t)pm * 256 * D + g * 256) * 2; u.b = wpool + (size_t)g * 256 * 1024 * 2; u.nt = 4; u.r0 = pm * 256; u.c0 = g * 256; u.kind = 0; }
        return true;
    }
};
struct SchedDense {
    int G, c; const char* A; const char* B; char* o;
    __device__ __forceinline__ bool next(int i, Unit& u) const {
        const int L = i * G + c; if (L >= 256) return false;
        int pm, pn; pg8::tile_of(L, 32, 8, pm, pn);
        u.a = A + (size_t)pm * 256 * D * 2; u.b = B + (size_t)pn * 256 * D * 2; u.nt = 32; u.r0 = pm * 256; u.c0 = pn * 256; u.kind = 1; u.aux = 0; u.half = 0; u.o = o; u.ldc = D; return true;
    }
};
struct SchedG3 {
    int G, c; const char* A; const char* B;
    __device__ __forceinline__ bool next(int i, Unit& u) const {
        const int L = (i >> 1) * G + c; if (L >= 256) return false;
        int pm, pn; pg8::tile_of(L, 32, 8, pm, pn); const int part = i & 1;
        u.a = A + ((size_t)pm * 256 * D + part * 1024) * 2; u.b = B + ((size_t)pn * 256 * D + part * 1024) * 2; u.nt = 16; u.r0 = pm * 256; u.c0 = pn * 256; u.kind = part ? 1 : 2; u.aux = 0; u.half = 0; u.o = nullptr; u.ldc = D; return true;
    }
};
struct SchedS {
    int G, c; const char* q; const char* k16;
    __device__ __forceinline__ bool next(int i, Unit& u) const {
        const int L = i * G + c; if (L >= 256 || i > 0) return false;
        const int h = L >> 6, pb = L & 63;
        u.a = q + ((size_t)pb * 128 * D + h * HD) * 2; u.b = k16 + (size_t)h * HD * 2; u.nt = 8; u.r0 = h * SEQ + pb * 128; u.c0 = 0; u.kind = 1; u.aux = 0; u.half = 1; u.o = nullptr; u.ldc = 256; return true;
    }
};
struct SchedPV {
    int G, c; const char* p; const char* vt; char* o;
    __device__ __forceinline__ bool next(int i, Unit& u) const {
        const int L = c; if (L >= 256 || i > 1) return false;
        const int h = L >> 6, pb = L & 63, pn = i;
        u.a = p + (size_t)(h * SEQ + pb * 128) * 256 * 2; u.b = vt + (size_t)(h * HD + pn * 256) * 256 * 2; u.nt = 4; u.r0 = pb * 128; u.c0 = h * HD + pn * 256; u.kind = 1; u.aux = 0; u.half = 1; u.o = o; u.ldc = D; return true;
    }
};
struct SchedGU {
    int G, c, mode; const char* xs; const char* wgu; const LAS int* tab;
    __device__ __forceinline__ bool next(int i, Unit& u) const {
        const int NF = __builtin_amdgcn_readfirstlane(tab[0]), NH = __builtin_amdgcn_readfirstlane(tab[1]); const int L = i * G + c; const int n = (mode ? NH : NF) * 4; if (L >= n) return false;
        const int w = pg8::xcd_chunk(L, n); const int j = (mode ? NF : 0) + (w >> 2), pn = w & 3; u.half = mode;
        const int te = __builtin_amdgcn_readfirstlane(tab[2 + j]); const int e = te & 255, r0 = (te >> 8) * 128;
        u.a = xs + (size_t)r0 * D * 2; u.b = wgu + (size_t)(e * 4 + pn) * (32 * 32768); u.nt = 32; u.r0 = r0; u.c0 = pn * 128; u.kind = 1; u.aux = e; u.o = nullptr; u.ldc = DE; return true;
    }
};
struct SchedDN {
    int G, c, mode; const char* hid; const char* wdn; const LAS int* tab;
    __device__ __forceinline__ bool next(int i, Unit& u) const {
        const int NF = __builtin_amdgcn_readfirstlane(tab[0]), NH = __builtin_amdgcn_readfirstlane(tab[1]);
        int j, pn;
        if (mode == 0) { const int HG = (4 * NH < G) ? 4 * NH : G, N0 = G - HG; int k;
            if (c >= HG) k = (i < 2) ? (i * N0 + (c - HG)) : (2 * N0 + (i - 2) * G + c); else k = 2 * N0 + i * G + c;
            if (k >= 8 * NF) return false;
            const int kfull = (NF >> 3) << 6;
            if (k < kfull) { const int blk = k >> 6, r = k & 63; j = 8 * blk + (r & 7); pn = r >> 3; } else { j = k >> 3; pn = k & 7; }
            u.half = 0; }
        else { const int L = i * G + c; if (L >= 8 * NH) return false; const int w = pg8::xcd_chunk(L, 8 * NH); j = NF + (w >> 3); pn = w & 7; u.half = 1; }
        const int te = __builtin_amdgcn_readfirstlane(tab[2 + j]); const int e = te & 255, r0 = (te >> 8) * 128;
        u.a = hid + (size_t)r0 * DE * 2; u.b = wdn + (size_t)(e * 8 + pn) * (8 * 32768); u.nt = 8; u.r0 = r0; u.c0 = pn * 256; u.kind = 1; u.aux = e; u.o = nullptr; u.ldc = D; return true;
    }
};

struct TrItem { const float* src; f16* dst; const float* ks; int N; int pitch; };
__device__ __forceinline__ void tr_load(const TrItem& d, f32x4 (&v)[8]) {
#pragma unroll
    for (int i = 0; i < 8; ++i) v[i] = __builtin_nontemporal_load((const f32x4*)(d.src + (size_t)(8 * i) * d.N));
}
__device__ __forceinline__ void tr_store(const TrItem& d, const f32x4 (&v)[8], LAS float* scr, int lane) {
#pragma unroll
    for (int i = 0; i < 8; ++i) { LAS float* p = scr + ((lane >> 3) + 8 * i) * 33 + 4 * (lane & 7); p[0] = v[i][0]; p[1] = v[i][1]; p[2] = v[i][2]; p[3] = v[i][3]; }
    LDS_WAIT(); asm volatile("" ::: "memory");
    const int c = lane >> 3, nl = lane & 7;
    f32x4 ka = (f32x4){1.f, 1.f, 1.f, 1.f}, kb2 = ka; if (d.ks) { ka = *(const f32x4*)(d.ks + 8 * c); kb2 = *(const f32x4*)(d.ks + 8 * c + 4); }
#pragma unroll
    for (int jj = 0; jj < 4; ++jj) { const int n = nl + 8 * jj; const LAS float* s = scr + (8 * c) * 33 + n;
        u32x4 o; o.x = pk2h(s[0 * 33] * ka[0], s[1 * 33] * ka[1]); o.y = pk2h(s[2 * 33] * ka[2], s[3 * 33] * ka[3]); o.z = pk2h(s[4 * 33] * kb2[0], s[5 * 33] * kb2[1]); o.w = pk2h(s[6 * 33] * kb2[2], s[7 * 33] * kb2[3]);
        __builtin_nontemporal_store(o, (u32x4*)(d.dst + (size_t)n * d.pitch + 8 * c)); }
    LDS_WAIT(); asm volatile("" ::: "memory");
}
__device__ __forceinline__ void rms_row_f32(const float* xrow, const float* g, f16* orow, int lane) {
    f32x4 v[8]; float s = 0.f;
#pragma unroll
    for (int j = 0; j < 4; ++j) { const f32x4* p = (const f32x4*)(xrow + 8 * (lane + 64 * j)); v[2 * j] = p[0]; v[2 * j + 1] = p[1];
        s += v[2 * j][0] * v[2 * j][0] + v[2 * j][1] * v[2 * j][1] + v[2 * j][2] * v[2 * j][2] + v[2 * j][3] * v[2 * j][3];
        s += v[2 * j + 1][0] * v[2 * j + 1][0] + v[2 * j + 1][1] * v[2 * j + 1][1] + v[2 * j + 1][2] * v[2 * j + 1][2] + v[2 * j + 1][3] * v[2 * j + 1][3]; }
    const float rs = rsqrtf(wave_sum(s) * (1.0f / D) + EPS);
#pragma unroll
    for (int j = 0; j < 4; ++j) { const f32x4* gp = (const f32x4*)(g + 8 * (lane + 64 * j)); const f32x4 a = v[2 * j] * rs * gp[0], b = v[2 * j + 1] * rs * gp[1];
        u32x4 o; o.x = pk2h(a[0], a[1]); o.y = pk2h(a[2], a[3]); o.z = pk2h(b[0], b[1]); o.w = pk2h(b[2], b[3]);
        *(u32x4*)(orow + 8 * (lane + 64 * j)) = o; }
}

constexpr int I_IN = 32 * 96, I_POOL = 4 * 4 * 8, I_PW = 16 * 32, I_SQ = 32 * 64, I_KV = 32 * 128, I_G = 32 * 32 * 16, I_D = 32 * 8 * 64;
constexpr int NITEMS = I_IN + I_POOL + I_PW + 3 * I_SQ + I_KV + 2 * I_G + I_D;
__device__ __forceinline__ void blk_order(int r, int NB, int KL, int NL, int& kb, int& nb) {
    const int per = KL * NL, blk = r / per, lo = r % per, nbh = NB / NL; nb = (blk % nbh) * NL + lo % NL; kb = (blk / nbh) * KL + lo / NL;
}
constexpr int SEG_A = I_IN + I_KV, SEG_B = SEG_A + I_POOL + I_PW + 3 * I_SQ, SEG_GU = SEG_B + 2 * I_G;
static_assert(SEG_GU + I_D == NITEMS, "item segments");
__device__ __forceinline__ TrItem tr_decode(int r, const Args& A, unsigned char* ws, int lane) {
    const float* W; int N, k0, n0, pitch, kb, nb; f16* dst; const float* ks = nullptr;
    if (r < I_IN) { blk_order(r, 96, 16, 16, kb, nb); W = A.in[3]; N = NPROJ; k0 = kb * 64; n0 = nb * 32; pitch = D; dst = (f16*)(ws + WS_WIN) + (size_t)n0 * D + k0; }
    else if ((r -= I_IN) < I_KV) { blk_order(r, 128, 16, 16, kb, nb); W = A.in[17]; N = 4096; k0 = kb * 64; n0 = nb * 32; pitch = D; dst = (f16*)(ws + WS_WKV) + (size_t)n0 * D + k0; }
    else if ((r -= I_KV) < I_POOL) { const int g = r / 32, q = r % 32; kb = q / 8; nb = q % 8; W = A.in[4] + (size_t)g * 65536; N = 256; k0 = kb * 64; n0 = nb * 32; pitch = 1024; dst = (f16*)(ws + WS_WPOOL) + (size_t)(g * 256 + n0) * 1024 + k0; }
    else if ((r -= I_POOL) < I_PW) { blk_order(r, 32, 16, 16, kb, nb); W = A.in[10]; N = 1024; k0 = kb * 64; n0 = nb * 32; pitch = 1024; dst = (f16*)(ws + WS_WPW) + (size_t)n0 * 1024 + k0; }
    else if ((r -= I_PW) < I_SQ) { blk_order(r, 64, 16, 16, kb, nb); W = A.in[13]; N = D; k0 = kb * 64; n0 = nb * 32; pitch = D; dst = (f16*)(ws + WS_WOUT) + (size_t)n0 * D + k0; ks = (k0 < 1024) ? (A.in[11] + k0) : (A.in[12] + k0 - 1024); }
    else if ((r -= I_SQ) < I_SQ) { blk_order(r, 64, 16, 16, kb, nb); W = A.in[16]; N = D; k0 = kb * 64; n0 = nb * 32; pitch = D; dst = (f16*)(ws + WS_WQ) + (size_t)n0 * D + k0; ks = A.in[14] + k0; }
    else if ((r -= I_SQ) < I_SQ) { blk_order(r, 64, 16, 16, kb, nb); W = A.in[18]; N = D; k0 = kb * 64; n0 = nb * 32; pitch = D; dst = (f16*)(ws + WS_WO) + (size_t)n0 * D + k0; }
    else if ((r -= I_SQ) < 2 * I_G) { const int up = r >= I_G; if (up) r -= I_G; const int e = r / 512; blk_order(r % 512, 16, 16, 16, kb, nb); n0 = nb * 32; k0 = kb * 64;
        W = (up ? A.in[25] : A.in[24]) + (size_t)e * D * DE; N = DE; pitch = 64;
        dst = (f16*)(ws + WS_WGU) + ((size_t)((e * 4 + (n0 >> 7)) * 32 + kb) * 256 + up * 128 + (n0 & 127)) * 64; k0 = kb * 64; }
    else { r -= 2 * I_G; const int e = r / 512; blk_order(r % 512, 64, 8, 32, kb, nb); W = A.in[26] + (size_t)e * DE * D; N = D; k0 = kb * 64; n0 = nb * 32; pitch = 64;
        dst = (f16*)(ws + WS_WDN) + ((size_t)((e * 8 + (n0 >> 8)) * 8 + kb) * 256 + (n0 & 255)) * 64; }
    TrItem d; d.src = W + (size_t)(k0 + (lane >> 3)) * N + n0 + 4 * (lane & 7); d.dst = dst; d.ks = ks; d.N = N; d.pitch = pitch; return d;
}
constexpr int CW_QHEAD = 64, CW_ARRIVE = 1024;
__device__ __forceinline__ void tr_batch16(const Frame& F, const Args& A, int first) {
    LAS float* scr = (LAS float*)(F.lds + F.wave * 16384);
    const int i0 = first + F.wave, i1 = first + 8 + F.wave; const bool v0 = i0 < NITEMS, v1 = i1 < NITEMS;
    TrItem d0, d1; f32x4 a[8], b[8];
    if (v0) { d0 = tr_decode(i0, A, F.ws, F.lane); tr_load(d0, a); }
    if (v1) { d1 = tr_decode(i1, A, F.ws, F.lane); tr_load(d1, b); }
    if (v0) tr_store(d0, a, scr, F.lane);
    if (v1) tr_store(d1, b, scr, F.lane);
}
__device__ __forceinline__ void tr_batch8(const Frame& F, const Args& A, int first) {
    LAS float* scr = (LAS float*)(F.lds + F.wave * 16384);
    const int i0 = first + F.wave;
    if (i0 < NITEMS) { f32x4 a[8]; const TrItem d0 = tr_decode(i0, A, F.ws, F.lane); tr_load(d0, a); tr_store(d0, a, scr, F.lane); }
}
__device__ __forceinline__ void tr_drain(const Frame& F, const Args& A, int limit) {
    unsigned* head = (unsigned*)(F.ws + WS_CTL) + CW_QHEAD; volatile LAS int* slot = (volatile LAS int*)(F.lds + MISC_OFF) + 16;
    __syncthreads();
    if (F.tid == 0) { int it = NITEMS; if ((int)xb_ld(head) < limit) it = (int)xb_add(head, 16u); slot[0] = it; }
    __syncthreads();
    int it = slot[0];
    while (it < NITEMS) {
        unsigned nx = (unsigned)NITEMS;
        if (F.tid == 0 && it < limit) nx = xb_add(head, 16u);
        tr_batch16(F, A, it);
        __syncthreads();
        if (F.tid == 0) slot[0] = (int)nx;
        __syncthreads();
        it = slot[0];
    }
}
__device__ __forceinline__ void tr_idle(const Frame& F, const Args& A, int ph) {
    unsigned* head = (unsigned*)(F.ws + WS_CTL) + CW_QHEAD; unsigned* arr = (unsigned*)(F.ws + WS_CTL) + CW_ARRIVE + 64 * ph;
    volatile LAS int* slot = (volatile LAS int*)(F.lds + MISC_OFF) + 16;
    __syncthreads();
    if (F.tid == 0) { (void)xb_add(arr, 1u); int it = NITEMS; if (xb_ld(arr) < (unsigned)F.G) it = (int)xb_add(head, 16u); slot[0] = it; }
    __syncthreads();
    int it = slot[0];
    while (it < NITEMS) {
        unsigned nx = (unsigned)NITEMS, ar = 0u;
        if (F.tid == 0) { ar = xb_ld(arr); nx = xb_add(head, 16u); }
        tr_batch16(F, A, it);
        __syncthreads();
        if (F.tid == 0) slot[0] = (int)nx, slot[1] = (ar >= (unsigned)F.G) ? 1 : 0;
        __syncthreads();
        it = slot[0];
        if (slot[1]) { if (it < NITEMS) tr_batch16(F, A, it); break; }
    }
}
__device__ __forceinline__ void phase_prep(const Frame& F, const Args& A) {
    const int gw = F.c * 8 + F.wave, NGW = F.G * 8;
    unsigned char* ws = F.ws;
    for (int m = gw; m < SEQ; m += NGW) rms_row_f32(A.in[0] + (size_t)m * D, A.in[2], (f16*)(ws + WS_H) + (size_t)m * D, F.lane);
    for (int m = gw; m < MEMLEN; m += NGW) rms_row_f32(A.in[1] + (size_t)m * D, A.in[15], (f16*)(ws + WS_M16) + (size_t)m * D, F.lane);
    tr_drain(F, A, SEG_A);
}

template <int TT> __device__ __forceinline__ void conv_step(f32x2 (&acc)[32], const f32x2 (&w)[CK], const LAS unsigned* yl, const unsigned ycur) {
    unsigned ynext = 0u;
    if constexpr (TT + 1 < 62) ynext = yl[(TT + 1) * 512];
    const f32x2 y = unpk2h(ycur);
#pragma unroll
    for (int r = (TT - 30 > 0 ? TT - 30 : 0); r <= (TT < 31 ? TT : 31); ++r) acc[r] = acc[r] + w[TT - r] * y;
    __builtin_amdgcn_sched_barrier(0);
    if constexpr (TT + 1 < 62) conv_step<TT + 1>(acc, w, yl, ynext);
}
__device__ __forceinline__ void phase_mixpre(const Frame& F, const Args& A) {
    const f16* proj = (const f16*)(F.ws + WS_PROJ);
    f16* dc = (f16*)(F.ws + WS_DC);
    LAS unsigned* ylds = (LAS unsigned*)F.lds;
    LAS float* red = (LAS float*)F.lds;
    LAS float* stat = (LAS float*)(F.lds + TAB_OFF);
    const int tid = F.tid, lane = F.lane;
    for (int blk = F.c; blk < SEQ / 32; blk += F.G) {
        const int t0 = blk * 32;
#pragma unroll 4
        for (int p = 0; p < 12; ++p) { const int rr = p * 4 + (tid >> 7); const int t = t0 - 15 + rr; u32x4 v = (u32x4){0u, 0u, 0u, 0u};
            if (t >= 0 && t < SEQ) v = *(const u32x4*)(proj + (size_t)t * NPROJ + (tid & 127) * 8);
            *(LAS u32x4*)(ylds + rr * 512 + (tid & 127) * 4) = v; }
        __syncthreads();
        { const int g = tid >> 7, wnd = 2 << g; f32x2 S = (f32x2){0.f, 0.f};
          for (int i = 1; i < wnd; ++i) S = S + unpk2h(ylds[(15 - i) * 512 + tid]);
#pragma unroll 4
          for (int r = 0; r < 32; ++r) { const int t = t0 + r; const f32x2 cur = unpk2h(ylds[(15 + r) * 512 + tid]); S = S + cur;
              const int cnt = (t + 1 < wnd) ? (t + 1) : wnd; const float ic = 1.0f / (float)cnt;
              *(unsigned*)(dc + (size_t)t * D + 2 * tid) = pk2h(S[0] * ic - cur[0], S[1] * ic - cur[1]);
              S = S - unpk2h(ylds[(15 + r - wnd + 1) * 512 + tid]); } }
        __syncthreads();
#pragma unroll 4
        for (int p = 0; p < 16; ++p) { const int r = p * 4 + (tid >> 7), c8 = (tid & 127) * 8; const int t = t0 - 30 + r;
            u32x4 o = (u32x4){0u, 0u, 0u, 0u};
            if (t >= 0 && r < 62) { const u32x4 av = *(const u32x4*)(proj + (size_t)t * NPROJ + 1024 + c8), gv = *(const u32x4*)(proj + (size_t)t * NPROJ + 2048 + c8);
#pragma unroll
                for (int q = 0; q < 4; ++q) { const f32x2 a2 = unpk2h(av[q]), g2 = unpk2h(gv[q]); o[q] = pk2h(a2[0] * fast_sigmoid(g2[0]), a2[1] * fast_sigmoid(g2[1])); } }
            if (r < 62) *(LAS u32x4*)(ylds + r * 512 + (tid & 127) * 4) = o; }
        __syncthreads();
        f32x2 acc[32];
        { f32x2 w[CK];
#pragma unroll
          for (int j = 0; j < CK; ++j) w[j] = *(const f32x2*)(A.in[6] + j * 1024 + 2 * tid);
          const f32x2 bdw = *(const f32x2*)(A.in[7] + 2 * tid);
#pragma unroll
          for (int r = 0; r < 32; ++r) acc[r] = bdw;
          conv_step<0>(acc, w, ylds + tid, ylds[tid]); }
        __syncthreads();
#pragma unroll
        for (int r = 0; r < 32; ++r) { red[(2 * r) * 512 + tid] = acc[r][0] + acc[r][1]; red[(2 * r + 1) * 512 + tid] = acc[r][0] * acc[r][0] + acc[r][1] * acc[r][1]; }
        __syncthreads();
        { const int s = tid >> 3, sl = tid & 7; float a = 0.f;
#pragma unroll 8
          for (int i = 0; i < 64; ++i) a += red[s * 512 + sl * 64 + ((i + lane) & 63)];
          a += __shfl_xor(a, 1); a += __shfl_xor(a, 2); a += __shfl_xor(a, 4);
          if (sl == 0) stat[s] = a; }
        __syncthreads();
        { const f32x2 lng = *(const f32x2*)(A.in[8] + 2 * tid), lnb = *(const f32x2*)(A.in[9] + 2 * tid);
#pragma unroll
          for (int r = 0; r < 32; ++r) { const float mean = stat[2 * r] * (1.0f / 1024.f); const float var = stat[2 * r + 1] * (1.0f / 1024.f) - mean * mean; const float rstd = rsqrtf(var + EPS);
              const float y0 = (acc[r][0] - mean) * rstd * lng[0] + lnb[0], y1 = (acc[r][1] - mean) * rstd * lng[1] + lnb[1];
              *(unsigned*)(dc + (size_t)(t0 + r) * D + 1024 + 2 * tid) = pk2h(y0 * fast_sigmoid(y0), y1 * fast_sigmoid(y1)); } }
        __syncthreads();
    }
}

__device__ __forceinline__ void phase_rownorm(const Frame& F, const Args& A) {
    const f16* y = (const f16*)(F.ws + WS_Y); f16* yn = (f16*)(F.ws + WS_YN);
    const int gw = F.c * 8 + F.wave, NGW = F.G * 8, lane = F.lane;
    for (int m = gw; m < SEQ; m += NGW) {
        u32x4 v[4]; float sa = 0.f, sb = 0.f;
#pragma unroll
        for (int j = 0; j < 4; ++j) { v[j] = *(const u32x4*)(y + (size_t)m * D + 8 * (lane + 64 * j)); float s = 0.f;
#pragma unroll
            for (int q = 0; q < 4; ++q) { const f32x2 a = unpk2h(v[j][q]); s += a[0] * a[0] + a[1] * a[1]; }
            if (j < 2) sa += s; else sb += s; }
        const float ra = rsqrtf(wave_sum(sa) * (1.0f / 1024.f) + EPS), rb = rsqrtf(wave_sum(sb) * (1.0f / 1024.f) + EPS);
#pragma unroll
        for (int j = 0; j < 4; ++j) { const int col = 8 * (lane + 64 * j); const float* g = (j < 2) ? (A.in[11] + col) : (A.in[12] + col - 1024); const float rs = (j < 2) ? ra : rb;
            const f32x4 g0 = *(const f32x4*)g, g1 = *(const f32x4*)(g + 4); u32x4 o;
            { const f32x2 a = unpk2h(v[j][0]); o.x = pk2h(a[0] * rs * g0[0], a[1] * rs * g0[1]); }
            { const f32x2 a = unpk2h(v[j][1]); o.y = pk2h(a[0] * rs * g0[2], a[1] * rs * g0[3]); }
            { const f32x2 a = unpk2h(v[j][2]); o.z = pk2h(a[0] * rs * g1[0], a[1] * rs * g1[1]); }
            { const f32x2 a = unpk2h(v[j][3]); o.w = pk2h(a[0] * rs * g1[2], a[1] * rs * g1[3]); }
            *(u32x4*)(yn + (size_t)m * D + col) = o; }
    }
}
__device__ __forceinline__ void phase_norm_x(const Frame& F, const float* x, const float* g) {
    const int gw = F.c * 8 + F.wave, NGW = F.G * 8;
    for (int m = gw; m < SEQ; m += NGW) rms_row_f32(x + (size_t)m * D, g, (f16*)(F.ws + WS_H) + (size_t)m * D, F.lane);
}

typedef float f32x16 __attribute__((ext_vector_type(16)));
__device__ __forceinline__ void phase_router(const Frame& F, const Args& A, const float* x2) {
    const float* gf = A.in[19]; const float* wrg = A.in[20]; const float* brg = A.in[21]; const float* wre = A.in[22]; const float* bre = A.in[23];
    LAS float* xt = (LAS float*)(F.lds) + F.wave * (32 * 68 + 256);
    LAS float* wgt = xt + 32 * 68;
    constexpr int XT_BYTES = 8 * (32 * 68 + 256) * 4;
    LAS float* part = (LAS float*)(F.lds + XT_BYTES);
    LAS float* gpart = (LAS float*)(F.lds + XT_BYTES + 36864);
    LAS float* ssqp = (LAS float*)(F.lds + XT_BYTES + 40960);
    LAS float* lgf = (LAS float*)(F.lds + XT_BYTES + 45056);
    LAS int* hist = (LAS int*)(F.lds + XT_BYTES + 51200);
    int* histg = (int*)(F.ws + WS_HIST); int* toke = (int*)(F.ws + WS_TOKE); float* tokw = (float*)(F.ws + WS_TOKW); float* tokrs = (float*)(F.ws + WS_TOKRS);
    f16* h3 = (f16*)(F.ws + WS_H);
    const int tid = F.tid, lane = F.lane, w = F.wave, tok = lane & 31, h = lane >> 5;
    for (int ch = F.c; ch < SEQ / 32; ch += F.G) {
        if (tid < 32) hist[tid] = 0;
        const int t0 = ch * 32;
        const float* xs0 = x2 + (size_t)(t0 + (lane >> 3)) * D + 256 * w + 8 * (lane & 7);
        f16* ho0 = h3 + (size_t)(t0 + (lane >> 3)) * D + 256 * w + 8 * (lane & 7);
        const float* wre0 = wre + (size_t)(256 * w + h) * 32 + tok;
        const float* wrg0 = wrg + (size_t)(256 * w + lane) * 4;
        f32x4 pre[8], wgn; float bwn[32];
#pragma unroll
        for (int i = 0; i < 4; ++i) { pre[2 * i] = *(const f32x4*)(xs0 + (size_t)(8 * i) * D); pre[2 * i + 1] = *(const f32x4*)(xs0 + (size_t)(8 * i) * D + 4); }
        { const float* p0 = wre0; const float* p1 = wre0 + 1024; asm volatile("" : "+v"(p0)); asm volatile("" : "+v"(p1));
#pragma unroll
          for (int s = 0; s < 16; ++s) { bwn[s] = p0[64 * s]; bwn[16 + s] = p1[64 * s]; } }
        wgn = *(const f32x4*)wrg0;
        f32x16 acc;
#pragma unroll
        for (int i = 0; i < 16; ++i) acc[i] = 0.f;
        float ga0 = 0.f, ga1 = 0.f, ga2 = 0.f, ga3 = 0.f; float sq[4] = {0.f, 0.f, 0.f, 0.f};
#pragma unroll 1
        for (int b = 0; b < 4; ++b) {
            float bw[32];
            { const f32x4 gA = *(const f32x4*)(gf + 256 * w + 64 * b + 8 * (lane & 7)), gB = *(const f32x4*)(gf + 256 * w + 64 * b + 8 * (lane & 7) + 4);
#pragma unroll
              for (int i = 0; i < 4; ++i) { const f32x4 xa = pre[2 * i], xb = pre[2 * i + 1];
                  sq[i] += xa[0] * xa[0] + xa[1] * xa[1] + xa[2] * xa[2] + xa[3] * xa[3] + xb[0] * xb[0] + xb[1] * xb[1] + xb[2] * xb[2] + xb[3] * xb[3];
                  const f32x4 a = xa * gA, c = xb * gB;
                  LAS float* p = xt + (8 * i + (lane >> 3)) * 68 + 8 * (lane & 7); *(LAS f32x4*)p = a; *(LAS f32x4*)(p + 4) = c;
                  u32x4 o; o.x = pk2h(a[0], a[1]); o.y = pk2h(a[2], a[3]); o.z = pk2h(c[0], c[1]); o.w = pk2h(c[2], c[3]);
                  *(u32x4*)(ho0 + (size_t)(8 * i) * D + 64 * b) = o; } }
            *(LAS f32x4*)(wgt + 4 * lane) = wgn;
#pragma unroll
            for (int s = 0; s < 32; ++s) bw[s] = bwn[s];
            if (b < 3) {
#pragma unroll
                for (int i = 0; i < 4; ++i) { pre[2 * i] = *(const f32x4*)(xs0 + (size_t)(8 * i) * D + 64 * (b + 1)); pre[2 * i + 1] = *(const f32x4*)(xs0 + (size_t)(8 * i) * D + 64 * (b + 1) + 4); }
                { const float* p0 = wre0 + 2048 * (b + 1); const float* p1 = p0 + 1024; asm volatile("" : "+v"(p0)); asm volatile("" : "+v"(p1));
#pragma unroll
                  for (int s = 0; s < 16; ++s) { bwn[s] = p0[64 * s]; bwn[16 + s] = p1[64 * s]; } }
                wgn = *(const f32x4*)(wrg0 + 256 * (b + 1)); }
            LDS_WAIT(); asm volatile("" ::: "memory");
#pragma unroll
            for (int q = 0; q < 16; ++q) {
                const f32x4 xv = *(const LAS f32x4*)(xt + tok * 68 + 4 * q);
                const f32x4 wg0 = *(const LAS f32x4*)(wgt + 4 * (4 * q + h)), wg1 = *(const LAS f32x4*)(wgt + 4 * (4 * q + 2 + h));
                const float a0 = h ? xv[1] : xv[0], a1 = h ? xv[3] : xv[2];
                acc = __builtin_amdgcn_mfma_f32_32x32x2f32(a0, bw[2 * q], acc, 0, 0, 0);
                acc = __builtin_amdgcn_mfma_f32_32x32x2f32(a1, bw[2 * q + 1], acc, 0, 0, 0);
                ga0 += a0 * wg0[0] + a1 * wg1[0]; ga1 += a0 * wg0[1] + a1 * wg1[1]; ga2 += a0 * wg0[2] + a1 * wg1[2]; ga3 += a0 * wg0[3] + a1 * wg1[3];
                if ((q & 1) == 1) __builtin_amdgcn_sched_barrier(0); }
            LDS_WAIT(); asm volatile("" ::: "memory");
        }
#pragma unroll
        for (int i = 0; i < 4; ++i) { float s = sq[i]; s += __shfl_xor(s, 1); s += __shfl_xor(s, 2); s += __shfl_xor(s, 4); if ((lane & 7) == 0) ssqp[w * 32 + 8 * i + (lane >> 3)] = s; }
#pragma unroll
        for (int r = 0; r < 16; ++r) part[(w * 32 + (r & 3) + 8 * (r >> 2) + 4 * h) * 33 + tok] = acc[r];
        ga0 += __shfl_xor(ga0, 32); ga1 += __shfl_xor(ga1, 32); ga2 += __shfl_xor(ga2, 32); ga3 += __shfl_xor(ga3, 32);
        if (h == 0) { *(LAS f32x4*)(gpart + (w * 32 + tok) * 4) = (f32x4){ga0, ga1, ga2, ga3}; }
        __syncthreads();
        { const int token = tid >> 4, e2 = tid & 15; float s0 = 0.f, s1 = 0.f;
#pragma unroll
          for (int ww = 0; ww < 8; ++ww) { s0 += part[(ww * 32 + token) * 33 + 2 * e2]; s1 += part[(ww * 32 + token) * 33 + 2 * e2 + 1]; }
          lgf[token * 40 + 4 + 2 * e2] = s0; lgf[token * 40 + 5 + 2 * e2] = s1;
          if (e2 < 4) { float s = 0.f;
#pragma unroll
              for (int ww = 0; ww < 8; ++ww) s += gpart[(ww * 32 + token) * 4 + e2];
              lgf[token * 40 + e2] = s; }
          if (e2 == 4) { float s = 0.f;
#pragma unroll
              for (int ww = 0; ww < 8; ++ww) s += ssqp[ww * 32 + token];
              lgf[token * 40 + 36] = rsqrtf(s * (1.0f / D) + EPS); } }
        __syncthreads();
        if (tid < 32) { const int t = tid; const LAS float* L = lgf + t * 40; const float rs = L[36];
            const float g0 = L[0] * rs + brg[0], g1 = L[1] * rs + brg[1], g2 = L[2] * rs + brg[2], g3 = L[3] * rs + brg[3];
            int gi = 0; float gm = g0; if (g1 > gm) { gm = g1; gi = 1; } if (g2 > gm) { gm = g2; gi = 2; } if (g3 > gm) { gm = g3; gi = 3; }
            const float pg = 1.0f / (__expf(g0 - gm) + __expf(g1 - gm) + __expf(g2 - gm) + __expf(g3 - gm));
            float le[8];
#pragma unroll
            for (int i = 0; i < 8; ++i) le[i] = L[4 + gi * 8 + i] * rs + bre[gi * 8 + i];
            int i1 = 0; float m1 = le[0];
#pragma unroll
            for (int i = 1; i < 8; ++i) if (le[i] > m1) { m1 = le[i]; i1 = i; }
            int i2 = -1; float m2 = -3.0e38f;
#pragma unroll
            for (int i = 0; i < 8; ++i) if (i != i1 && le[i] > m2) { m2 = le[i]; i2 = i; }
            const float ex = __expf(m2 - m1); const float w1 = pg / (1.0f + ex), w2 = pg * ex / (1.0f + ex);
            const int tk = t0 + t; const int e1 = gi * 8 + i1, e2 = gi * 8 + i2;
            tokrs[tk] = rs;
            toke[tk * 2] = e1; toke[tk * 2 + 1] = e2; tokw[tk * 2] = w1; tokw[tk * 2 + 1] = w2;
            atomicAdd((int*)(hist + e1), 1); atomicAdd((int*)(hist + e2), 1); }
        __syncthreads();
        if (tid < 32) histg[ch * 32 + tid] = hist[tid];
        __syncthreads();
    }
}

__device__ __forceinline__ void phase_scatter(const Frame& F) {
    const int* histg = (const int*)(F.ws + WS_HIST); const int* toke = (const int*)(F.ws + WS_TOKE); const float* tokw = (const float*)(F.ws + WS_TOKW);
    int* totg = (int*)(F.ws + WS_TOT); int* tokslot = (int*)(F.ws + WS_TOKSLOT); float* slotw = (float*)(F.ws + WS_SLOTW); const float* tokrs = (const float*)(F.ws + WS_TOKRS);
    const f16* h3 = (const f16*)(F.ws + WS_H); f16* xs = (f16*)(F.ws + WS_XS);
    LAS int* ps = (LAS int*)F.lds;
    LAS int* tot = ps + 1024;
    LAS int* bas = ps + 1056;
    LAS int* sl = ps + 1088;
    const int tid = F.tid, lane = F.lane;
    for (int ch = F.c; ch < SEQ / 32; ch += F.G) {
        { const int e = tid & 31, part = tid >> 5; int s = 0, b = 0;
#pragma unroll
          for (int q = 0; q < 16; ++q) { const int cq = part * 16 + q; const int h = histg[cq * 32 + e]; s += h; b += (cq < ch) ? h : 0; }
          ps[part * 32 + e] = s; ps[512 + part * 32 + e] = b; }
        __syncthreads();
        if (tid < 32) { int s = 0, b = 0;
#pragma unroll
            for (int p = 0; p < 16; ++p) { s += ps[p * 32 + tid]; b += ps[512 + p * 32 + tid]; }
            tot[tid] = s; bas[tid] = b; }
        __syncthreads();
        if (tid < 32) { int pst = 0; for (int e = 0; e < tid; ++e) pst += (tot[e] + 127) >> 7; pst <<= 7;
            bas[tid] = pst + bas[tid];
            if (ch == 0) totg[tid] = tot[tid]; }
        __syncthreads();
        if (ch < 32) { int pst = 0; for (int e = 0; e < ch; ++e) pst += (tot[e] + 127) >> 7; pst <<= 7; const int n = tot[ch]; const int end = pst + (((n + 127) >> 7) << 7);
            for (int s = pst + n + tid; s < end; s += 512) slotw[s] = 0.f; }
        if (F.wave == 0) { const int a = lane; const int tok = ch * 32 + (a >> 1); const int e = toke[tok * 2 + (a & 1)]; const float wv = tokw[tok * 2 + (a & 1)];
            int rank = 0;
            for (int ee = 0; ee < 32; ++ee) { const unsigned long long mk = __ballot(e == ee); if (e == ee) rank = __popcll(mk & ((1ull << lane) - 1ull)); }
            const int slot = bas[e] + rank; sl[a] = slot; slotw[slot] = wv; tokslot[tok * 2 + (a & 1)] = slot; }
        __syncthreads();
#pragma unroll
        for (int r = 0; r < 8; ++r) { const int a = F.wave * 8 + r; const int tok = ch * 32 + (a >> 1); const int slot = sl[a]; const float rs = tokrs[tok];
            const u32x4* src = (const u32x4*)(h3 + (size_t)tok * D); u32x4* dst = (u32x4*)(xs + (size_t)slot * D);
#pragma unroll
            for (int j = 0; j < 4; ++j) { const u32x4 v = src[lane + 64 * j]; u32x4 o;
                { const f32x2 q = unpk2h(v.x); o.x = pk2h(q[0] * rs, q[1] * rs); } { const f32x2 q = unpk2h(v.y); o.y = pk2h(q[0] * rs, q[1] * rs); }
                { const f32x2 q = unpk2h(v.z); o.z = pk2h(q[0] * rs, q[1] * rs); } { const f32x2 q = unpk2h(v.w); o.w = pk2h(q[0] * rs, q[1] * rs); }
                dst[lane + 64 * j] = o; } }
        __syncthreads();
    }
}
__device__ __forceinline__ void moe_table(const Frame& F) {
    const int* totg = (const int*)(F.ws + WS_TOT); LAS int* tab = (LAS int*)(F.lds + TAB_OFF);
    __syncthreads();
    if (F.tid == 0) { int NF = 0, NH = 0, row = 0;
        for (int e = 0; e < NE; ++e) { const int n128 = (totg[e] + 127) >> 7; NF += n128 >> 1; NH += n128 & 1; }
        int jf = 0, jh = NF;
        for (int e = 0; e < NE; ++e) { const int n128 = (totg[e] + 127) >> 7; const int nf = n128 >> 1;
            for (int q = 0; q < nf; ++q) tab[2 + jf++] = e | ((row / 128 + 2 * q) << 8);
            if (n128 & 1) tab[2 + jh++] = e | ((row / 128 + 2 * nf) << 8);
            row += n128 * 128; }
        tab[0] = NF; tab[1] = NH; }
    __syncthreads();
}

__device__ __forceinline__ void rowfac_y(const Frame& F, int pm) {
    const float* ssq = (const float*)(F.ws + WS_SSQY); LAS f32x2* fac = (LAS f32x2*)(F.lds + TAB_OFF);
    __syncthreads();
    if (F.tid < 256) { const f32x4* p = (const f32x4*)(ssq + (size_t)(pm * 256 + F.tid) * 32); float sa = 0.f, sb = 0.f;
#pragma unroll
        for (int q = 0; q < 4; ++q) { const f32x4 a = p[q], b = p[4 + q]; sa += (a[0] + a[1]) + (a[2] + a[3]); sb += (b[0] + b[1]) + (b[2] + b[3]); }
        const float ra = rsqrtf(sa * (1.0f / 1024.f) + EPS), rb = rsqrtf(sb * (1.0f / 1024.f) + EPS);
        fac[F.tid] = (f32x2){ra / rb, rb}; }
    __syncthreads();
}
__device__ __forceinline__ void rowfac_x(const Frame& F, int pm) {
    const float* ssq = (const float*)(F.ws + WS_SSQX); LAS float* fac = (LAS float*)(F.lds + TAB_OFF);
    __syncthreads();
    if (F.tid < 256) { const f32x4* p = (const f32x4*)(ssq + (size_t)(pm * 256 + F.tid) * 32); float s = 0.f;
#pragma unroll
        for (int q = 0; q < 8; ++q) { const f32x4 a = p[q]; s += (a[0] + a[1]) + (a[2] + a[3]); }
        fac[F.tid] = rsqrtf(s * (1.0f / D) + EPS); }
    __syncthreads();
}

__device__ __forceinline__ void phase_final(const Frame& F, const Args& A, float* out) {
    const int* tokslot = (const int*)(F.ws + WS_TOKSLOT); const f16* ys = (const f16*)(F.ws + WS_YS); const float* g = A.in[27];
    const int gw = F.c * 8 + F.wave, NGW = F.G * 8, lane = F.lane;
    for (int m = gw; m < SEQ; m += NGW) {
        const int s0 = tokslot[m * 2], s1 = tokslot[m * 2 + 1];
        f32x4 v[8]; float s = 0.f;
#pragma unroll
        for (int j = 0; j < 4; ++j) { const int col = 8 * (lane + 64 * j); const f32x4* p = (const f32x4*)(out + (size_t)m * D + col);
            const u32x4 y0 = *(const u32x4*)(ys + (size_t)s0 * D + col), y1 = *(const u32x4*)(ys + (size_t)s1 * D + col);
            f32x4 a = p[0], b = p[1];
            { const f32x2 q0 = unpk2h(y0.x), q1 = unpk2h(y1.x); a[0] += q0[0] + q1[0]; a[1] += q0[1] + q1[1]; }
            { const f32x2 q0 = unpk2h(y0.y), q1 = unpk2h(y1.y); a[2] += q0[0] + q1[0]; a[3] += q0[1] + q1[1]; }
            { const f32x2 q0 = unpk2h(y0.z), q1 = unpk2h(y1.z); b[0] += q0[0] + q1[0]; b[1] += q0[1] + q1[1]; }
            { const f32x2 q0 = unpk2h(y0.w), q1 = unpk2h(y1.w); b[2] += q0[0] + q1[0]; b[3] += q0[1] + q1[1]; }
            v[2 * j] = a; v[2 * j + 1] = b;
            s += a[0] * a[0] + a[1] * a[1] + a[2] * a[2] + a[3] * a[3] + b[0] * b[0] + b[1] * b[1] + b[2] * b[2] + b[3] * b[3]; }
        const float rs = rsqrtf(wave_sum(s) * (1.0f / D) + EPS);
#pragma unroll
        for (int j = 0; j < 4; ++j) { const int col = 8 * (lane + 64 * j); f32x4* p = (f32x4*)(out + (size_t)m * D + col);
            p[0] = v[2 * j] * rs * *(const f32x4*)(g + col); p[1] = v[2 * j + 1] * rs * *(const f32x4*)(g + col + 4); }
    }
}

#if FAST_GEMM
#define RUN_GEMM(EpiT, SchedT, lda, ldb, S, E) pg8::gemm_phase<EpiT, SchedT, !EpiT::AFTER_DRAIN, true>(F.lds, lda, ldb, (size_t)128, S, E)
#define RUN_GEMM_KT(EpiT, SchedT, lda, S, E) pg8::gemm_phase<EpiT, SchedT, !EpiT::AFTER_DRAIN, true>(F.lds, lda, 64, (size_t)32768, S, E)
#else
#define RUN_GEMM(EpiT, SchedT, lda, ldb, S, E) pg8::gemm_phase_simple<EpiT, SchedT>(F.lds, lda, ldb, S, E)
#endif

__global__ void __launch_bounds__(512, 2) fwd(Args args) {
    extern __shared__ __attribute__((aligned(16))) unsigned char lds_raw[];
    Frame F;
    F.lds = (LAS unsigned char*)lds_raw; F.ws = args.ws;
    F.tid = threadIdx.x; F.lane = F.tid & 63; F.wave = __builtin_amdgcn_readfirstlane(F.tid >> 6);
    F.G = gridDim.x; F.c = blockIdx.x;
    volatile LAS unsigned* MISC = (volatile LAS unsigned*)(F.lds + MISC_OFF);
    if (F.tid < 64) MISC[F.tid] = 0u;
    __syncthreads();
    XcdBarrier bar; bar.bar = (unsigned*)(args.ws + WS_CTL) + CW_BAR; bar.x = 0; bar.st = nullptr;
    if (MK_N_LAUNCHES == 1) bar = xcd_barrier_post((unsigned*)(args.ws + WS_CTL) + CW_BAR, MISC + 8);
    const int lo = args.ph_lo, hi = args.ph_hi;
    volatile LAS unsigned* TS = (volatile LAS unsigned*)(F.lds + TAB_OFF + 2048);
#ifndef ONLY_PHASE
#define ONLY_PHASE -1
#endif
#define IN(k) ((ONLY_PHASE < 0 || (k) == ONLY_PHASE) && lo <= (k) && (k) < hi)
#ifndef REP_PHASE
#define REP_PHASE -1
#endif
#ifndef REP_N
#define REP_N 1
#endif
#define REPS(k) _Pragma("unroll 1") for (int rep_ = 0; rep_ < (((k) == REP_PHASE) ? args.pad : 1); ++rep_)
#ifndef PROF_PHASE
#define PROF_PHASE -1
#endif
#ifndef PROF_MULT
#define PROF_MULT 4
#endif
#define STAMP(k) do { if (PROF_PHASE >= 0 && F.c == 0 && F.tid == 0) { const unsigned long long t_ = __builtin_amdgcn_s_memrealtime(); TS[2 * (k)] = (unsigned)t_; TS[2 * (k) + 1] = (unsigned)(t_ >> 32); } } while (0)
#define SEAM(k) do { if (IN(k) && IN((k) + 1)) xcd_barrier(bar); STAMP((k) + 1); } while (0)
    unsigned char* ws = args.ws; float* out = args.out;
    const char* wsc = (const char*)ws;

    STAMP(0);
    if (IN(0)) REPS(0) { phase_prep(F, args); } SEAM(0);
    if (IN(1)) REPS(1) { SchedP1 S{F.G, F.c, wsc + WS_H, wsc + WS_WIN, wsc + WS_M16, wsc + WS_WKV, (char*)(ws + WS_PROJ), (char*)(ws + WS_K16), (char*)(ws + WS_VT16)};
        EpiF16 E{nullptr, 1.0f};
        RUN_GEMM(EpiF16, SchedP1, D, D, S, E); tr_idle(F, args, 1); } SEAM(1);
#ifndef DUP2
#define DUP2 0
#endif
    if (IN(2)) { phase_mixpre(F, args); tr_drain(F, args, SEG_B); } SEAM(2);
    if (IN(3)) REPS(3) { SchedG2 S{F.G, F.c, wsc + WS_DC, wsc + WS_WPW, wsc + WS_WPOOL, (char*)(ws + WS_Y)};
        EpiF16 E{args.in[5], 1.0f, (float*)(ws + WS_SSQY), nullptr};
        RUN_GEMM(EpiF16, SchedG2, D, 1024, S, E); } SEAM(3);
    if (IN(5)) REPS(5) { int pm, pn; pg8::tile_of(F.c, 32, 8, pm, pn); rowfac_y(F, pm);
        SchedG3 S{F.G, F.c, wsc + WS_Y, wsc + WS_WOUT}; EpiG3 E{args.in[0], out, (f16*)(ws + WS_H), (float*)(ws + WS_SSQX), (const LAS f32x2*)(F.lds + TAB_OFF)};
        RUN_GEMM(EpiG3, SchedG3, D, D, S, E); } SEAM(5);
    if (IN(7)) REPS(7) { int pm, pn; pg8::tile_of(F.c, 32, 8, pm, pn); rowfac_x(F, pm);
        SchedDense S{F.G, F.c, wsc + WS_H, wsc + WS_WQ, (char*)(ws + WS_Q)};
        EpiF16 E{nullptr, 0.044194173824159216f, nullptr, (const LAS float*)(F.lds + TAB_OFF)};
        RUN_GEMM(EpiF16, SchedDense, D, D, S, E); } SEAM(7);
    if (IN(8)) REPS(8) { { SchedS S{F.G, F.c, wsc + WS_Q, wsc + WS_K16}; EpiSoftmax E{(f16*)(ws + WS_P)};
          RUN_GEMM(EpiSoftmax, SchedS, D, D, S, E); }
        VM_WAIT(); __syncthreads();
        { SchedPV S{F.G, F.c, wsc + WS_P, wsc + WS_VT16, (char*)(ws + WS_O)};
          EpiF16 E{nullptr, 1.0f};
          RUN_GEMM(EpiF16, SchedPV, 256, 256, S, E); } }
    if (IN(8) && IN(10)) { xcd_barrier(bar); STAMP(9); STAMP(10); }
    if (IN(10)) REPS(10) { SchedDense S{F.G, F.c, wsc + WS_O, wsc + WS_WO, nullptr}; EpiResF32 E{out, out, D};
        RUN_GEMM(EpiResF32, SchedDense, D, D, S, E); } SEAM(10);
    if (IN(11)) REPS(11) { phase_router(F, args, out); } SEAM(11);
    if (IN(12)) REPS(12) { phase_scatter(F); tr_drain(F, args, NITEMS); } SEAM(12);
    if (IN(13)) { moe_table(F); const LAS int* tab = (const LAS int*)(F.lds + TAB_OFF);
        { SchedGU S{F.G, F.c, 0, wsc + WS_XS, wsc + WS_WGU, tab}; EpiSwiGLU E{(f16*)(ws + WS_HID)}; RUN_GEMM_KT(EpiSwiGLU, SchedGU, D, S, E); }
        xcd_barrier(bar); STAMP(14);
        { SchedGU S{F.G, F.c, 1, wsc + WS_XS, wsc + WS_WGU, tab}; EpiSwiGLU E{(f16*)(ws + WS_HID)}; RUN_GEMM_KT(EpiSwiGLU, SchedGU, D, S, E); }
        { SchedDN S{F.G, F.c, 0, wsc + WS_HID, wsc + WS_WDN, tab}; EpiDown E{(f16*)(ws + WS_YS), (const float*)(ws + WS_SLOTW)}; RUN_GEMM_KT(EpiDown, SchedDN, DE, S, E); }
        xcd_barrier(bar); STAMP(15);
        { SchedDN S{F.G, F.c, 1, wsc + WS_HID, wsc + WS_WDN, tab}; EpiDown E{(f16*)(ws + WS_YS), (const float*)(ws + WS_SLOTW)}; RUN_GEMM_KT(EpiDown, SchedDN, DE, S, E); }
        xcd_barrier(bar); STAMP(16); }
    if (IN(15)) REPS(15) { phase_final(F, args, out); }
    if (PROF_PHASE >= 0 && F.c == 0 && F.tid == 0 && lo == 0) {
        STAMP(17);
        const unsigned long long t0 = ((unsigned long long)TS[2 * PROF_PHASE + 1] << 32) | TS[2 * PROF_PHASE], t1 = ((unsigned long long)TS[2 * PROF_PHASE + 3] << 32) | TS[2 * PROF_PHASE + 2];
        const unsigned long long until = __builtin_amdgcn_s_memrealtime() + (unsigned long long)PROF_MULT * (t1 - t0);
        while (__builtin_amdgcn_s_memrealtime() < until) __builtin_amdgcn_s_sleep(8);
    }
#undef IN
#undef SEAM
}

extern "C" void kernel_launch(void* const* d_in, const int* in_sizes, int n_in, void* d_out, int out_size, void* d_ws, size_t ws_size, hipStream_t stream) {
    static int grid = 0;
    if (grid == 0) {
        if (n_in != 28 || out_size != SEQ * D || ws_size < WS_END) { fprintf(stderr, "kernel_launch: unexpected sizes n_in %d out %d ws %zu\n", n_in, out_size, ws_size); grid = -1; return; }
        int dev = 0, cus = 0;
        if (hipGetDevice(&dev) != hipSuccess || hipDeviceGetAttribute(&cus, hipDeviceAttributeMultiprocessorCount, dev) != hipSuccess) { grid = -1; return; }
        if (hipFuncSetAttribute((const void*)fwd, hipFuncAttributeMaxDynamicSharedMemorySize, LDS_BYTES) != hipSuccess) { grid = -1; return; }
        int per_cu = 0;
        (void)hipOccupancyMaxActiveBlocksPerMultiprocessor(&per_cu, (const void*)fwd, 512, LDS_BYTES);
        (void)hipGetLastError();
        grid = cus;
    }
    if (grid < 0) return;
    (void)hipMemsetAsync((char*)d_ws + WS_CTL, 0, CTL_ZERO_BYTES, stream);
    Args a{};
    for (int i = 0; i < 28; ++i) a.in[i] = (const float*)d_in[i];
    a.out = (float*)d_out; a.ws = (unsigned char*)d_ws; a.pad = REP_N;
    if (MK_N_LAUNCHES == 1) { a.ph_lo = 0; a.ph_hi = NPHASE; a.li = 0; hipLaunchKernelGGL(fwd, dim3(grid), dim3(512), LDS_BYTES, stream, a);
#if EXTRA_PHASE >= 0
        for (int r = 0; r < EXTRA_N; ++r) { a.ph_lo = EXTRA_PHASE; a.ph_hi = EXTRA_PHASE + 1; a.li = 1 + r;
#if EXTRA_REQUEUE
            { static const unsigned hv = SEG_B; (void)hipMemsetAsync((char*)d_ws + WS_CTL + (CW_ARRIVE + 64 * EXTRA_PHASE) * 4, 0, 4, stream);
              (void)hipMemsetD32Async((hipDeviceptr_t)((char*)d_ws + WS_CTL + CW_QHEAD * 4), (int)hv, 1, stream); }
#endif
            hipLaunchKernelGGL(fwd, dim3(grid), dim3(512), LDS_BYTES, stream, a); }
#endif
    }
    else { for (int p = 0; p < NPHASE; ++p) { a.ph_lo = p; a.ph_hi = p + 1; a.li = p; hipLaunchKernelGGL(fwd, dim3(grid), dim3(512), LDS_BYTES, stream, a); } }
}
```

```cpp
#include <hip/hip_runtime.h>
#include <cstdio>
#include <cstdint>

#ifndef MK_N_LAUNCHES
#define MK_N_LAUNCHES 1
#endif
#ifndef EXTRA_PHASE
#define EXTRA_PHASE -1
#endif
#ifndef EXTRA_REQUEUE
#define EXTRA_REQUEUE 0
#endif
#ifndef EXTRA_N
#define EXTRA_N 2
#endif
#ifndef FAST_GEMM
#define FAST_GEMM 1
#endif

#define LAS __attribute__((address_space(3)))
#define GAS __attribute__((address_space(1)))
typedef _Float16 f16;
typedef _Float16 f16x8 __attribute__((ext_vector_type(8)));
typedef _Float16 f16x2 __attribute__((ext_vector_type(2)));
typedef float f32x4 __attribute__((ext_vector_type(4)));
typedef float f32x2 __attribute__((ext_vector_type(2)));
typedef unsigned u32x4 __attribute__((ext_vector_type(4)));
typedef unsigned u32x2 __attribute__((ext_vector_type(2)));

constexpr int SEQ = 8192, D = 2048, NPROJ = 3072, MEMLEN = 256, NHEAD = 4, HD = 512, NE = 32, DE = 512, CK = 31;
constexpr float EPS = 1e-6f;
constexpr int NPHASE = 16;

constexpr size_t MiB = 1u << 20;
constexpr size_t WS_CTL = 0, CTL_ZERO_BYTES = 65536;
constexpr size_t WS_HIST = 65536;
constexpr size_t WS_TOT = 98304;
constexpr size_t WS_TOKE = 131072;
constexpr size_t WS_TOKW = 196608;
constexpr size_t WS_TOKSLOT = 262144;
constexpr size_t WS_SLOTW = 327680;
constexpr size_t WS_TOKRS = 458752;
constexpr size_t WS_M16 = 1 * MiB, WS_K16 = 2 * MiB, WS_VT16 = 3 * MiB;
constexpr size_t WS_SSQY = 4 * MiB, WS_SSQX = 5 * MiB;
constexpr size_t WS_WIN = 8 * MiB, WS_WPOOL = 20 * MiB, WS_WPW = 22 * MiB, WS_WOUT = 24 * MiB, WS_WQ = 32 * MiB, WS_WKV = 40 * MiB, WS_WO = 56 * MiB,
                 WS_WGU = 64 * MiB, WS_WDN = 192 * MiB;
constexpr size_t WS_PROJ = 256 * MiB, WS_DC = 304 * MiB, WS_XS = 256 * MiB;
constexpr size_t WS_H = 352 * MiB, WS_Y = 384 * MiB, WS_YN = 416 * MiB, WS_YS = 352 * MiB;
constexpr size_t WS_Q = 448 * MiB, WS_P = 480 * MiB, WS_O = 496 * MiB, WS_HID = 480 * MiB, WS_X2H = 448 * MiB;
constexpr size_t WS_END = 528 * MiB;
constexpr int CW_BAR = 4096;

constexpr int RING_BYTES = 131072;
constexpr int MISC_OFF = RING_BYTES;
constexpr int TAB_OFF = RING_BYTES + 256;
constexpr int LDS_BYTES = 147456;

#define LDS_WAIT() asm volatile("s_waitcnt lgkmcnt(0)" ::: "memory")
#define VM_WAIT() asm volatile("s_waitcnt vmcnt(0)" ::: "memory")

__device__ __forceinline__ unsigned pk2h(float lo, float hi) { f32x2 v = {lo, hi}; f16x2 h = __builtin_convertvector(v, f16x2); return __builtin_bit_cast(unsigned, h); }
__device__ __forceinline__ f32x2 unpk2h(unsigned u) { f16x2 h = __builtin_bit_cast(f16x2, u); return __builtin_convertvector(h, f32x2); }
__device__ __forceinline__ float wave_sum(float v) {
#pragma unroll
    for (int o = 1; o < 64; o <<= 1) v += __shfl_xor(v, o);
    return v;
}
__device__ __forceinline__ float fast_sigmoid(float x) { return __builtin_amdgcn_rcpf(1.0f + __expf(-x)); }

#define XB_TMO      128
#define XB_XCNT(j)  (256  + 64 * (j))
#define XB_XSUB(j)  (1280 + 64 * (j))
#define XB_XGEN(j)  (2304 + 64 * (j))
#define XB_TOP      3328
#define XB_TOPGEN   3392
#define XCD_BAR_WORDS 3456
#define XB_SPIN_CAP (1u << 18)
__device__ __forceinline__ unsigned xb_ld(unsigned* p)              { return __hip_atomic_load(p, __ATOMIC_RELAXED, __HIP_MEMORY_SCOPE_AGENT); }
__device__ __forceinline__ unsigned xb_add(unsigned* p, unsigned v) { return __hip_atomic_fetch_add(p, v, __ATOMIC_RELAXED, __HIP_MEMORY_SCOPE_AGENT); }
__device__ __forceinline__ unsigned xb_xcc_id() { return (unsigned)__builtin_amdgcn_s_getreg((3 << 11) | 20) & 0xFu; }
#define XB_SPIN(cond, bar) do { unsigned _sp = 0; while (cond) { __builtin_amdgcn_s_sleep(1); \
    if ((++_sp & 255u) == 0u) { if (xb_ld(&(bar)[XB_TMO])) break; if (_sp > XB_SPIN_CAP) { atomicAdd(&(bar)[XB_TMO], 1u); break; } } } } while (0)
struct XcdBarrier { unsigned* bar; unsigned x; volatile LAS unsigned* st; };
__device__ __forceinline__ XcdBarrier xcd_barrier_post(unsigned* bar, volatile LAS unsigned* st) {
    XcdBarrier b; b.bar = bar; b.x = xb_xcc_id(); b.st = st;
    if (threadIdx.x == 0) (void)xb_add(&bar[XB_XCNT(b.x)], 1u);
    return b;
}
__device__ __forceinline__ void xcd_barrier_complete(unsigned* bar, unsigned x, unsigned& nloc, unsigned& nx) {
    const unsigned G = gridDim.x * gridDim.y * gridDim.z;
    unsigned sum, cnt, mine, sp = 0u;
    for (;;) {
        sum = 0u; cnt = 0u; mine = 0u;
#pragma unroll
        for (unsigned j = 0; j < 16; ++j) { const unsigned c = xb_ld(&bar[XB_XCNT(j)]); sum += c; cnt += (c > 0u) ? 1u : 0u; mine = (j == x) ? c : mine; }
        if (sum == G) break;
        __builtin_amdgcn_s_sleep(1);
        if ((++sp & 255u) == 0u) { if (xb_ld(&bar[XB_TMO])) break; if (sp > XB_SPIN_CAP) { atomicAdd(&bar[XB_TMO], 1u); break; } }
    }
    nloc = mine > 0u ? mine : 1u; nx = cnt > 0u ? cnt : 1u;
}
__device__ __forceinline__ void xcd_barrier(const XcdBarrier& b) {
    asm volatile("s_waitcnt vmcnt(0)" ::: "memory");
    __syncthreads();
    if (threadIdx.x == 0) {
        unsigned* bar = b.bar;
        __builtin_amdgcn_s_waitcnt(0);
        unsigned nloc = b.st[0], nx = b.st[1];
        if (nloc == 0u) { xcd_barrier_complete(bar, b.x, nloc, nx); b.st[0] = nloc; b.st[1] = nx; }
        const unsigned old = xb_add(&bar[XB_XSUB(b.x)], 1u);
        const unsigned gen = old / nloc;
        if (old + 1u == (gen + 1u) * nloc) {
            __builtin_amdgcn_fence(__ATOMIC_RELEASE, "agent");
            asm volatile("s_waitcnt vmcnt(0)" ::: "memory");
            const unsigned og = xb_add(&bar[XB_TOP], 1u);
            const unsigned tg = og / nx;
            if (og + 1u == (tg + 1u) * nx) xb_add(&bar[XB_TOPGEN], 1u);
            else XB_SPIN(xb_ld(&bar[XB_TOPGEN]) == tg, bar);
            __builtin_amdgcn_fence(__ATOMIC_ACQUIRE, "agent");
            xb_add(&bar[XB_XGEN(b.x)], 1u);
            asm volatile("s_waitcnt vmcnt(0)" ::: "memory");
        } else {
            XB_SPIN(xb_ld(&bar[XB_XGEN(b.x)]) == gen, bar);
            __builtin_amdgcn_fence(__ATOMIC_ACQUIRE, "agent");
            asm volatile("s_waitcnt vmcnt(0)" ::: "memory");
        }
    }
    __syncthreads();
}

namespace pg8 {
constexpr int BM = 256, BK = 64, HALF = 128, HTB = HALF * BK * 2, STAGE_BYTES = 8 * HTB, NXCD = 8, WGM = 8;
__host__ __device__ __forceinline__ int lds_byte(int r, int c) { const int st = (r >> 4) * 2 + (c >> 5), rr = r & 15, cc = c & 31, ob = rr * 64 + cc * 2; return st * 1024 + (ob ^ (((ob >> 9) & 1) << 5)); }
__host__ __device__ __forceinline__ void stage_rc(int b, int& R, int& C) { const int st = b / 1024, sb = b % 1024, swz = sb ^ (((sb >> 9) & 1) << 5); R = (st >> 1) * 16 + swz / 64; C = (st & 1) * 32 + (swz % 64) / 2; }
__host__ __device__ __forceinline__ int perm32(int rho) { const int n = rho >> 4, i = rho & 15; return 8 * (i >> 2) + 4 * n + (i & 3); }

struct Unit { const char* a; const char* b; char* o; int ldc; int nt; int r0, c0, kind, aux, half; };

__device__ __forceinline__ void tile_of(int L, int nM, int nN, int& pm, int& pn) {
    const int nwg = nM * nN; int wgid = L;
    { const int q = nwg / NXCD, r = nwg % NXCD, xcd = wgid % NXCD, off = wgid / NXCD; wgid = (xcd < r ? xcd * (q + 1) : r * (q + 1) + (xcd - r) * q) + off; }
    const int nig = WGM * nN, gid = wgid / nig, fm = gid * WGM, gsz = (nM - fm) < WGM ? (nM - fm) : WGM;
    pm = fm + ((wgid % nig) % gsz); pn = (wgid % nig) / gsz;
}
__device__ __forceinline__ void tile_of_w(int wgid, int nM, int nN, int& pm, int& pn) {
    const int nig = WGM * nN, gid = wgid / nig, fm = gid * WGM, gsz = (nM - fm) < WGM ? (nM - fm) : WGM;
    pm = fm + ((wgid % nig) % gsz); pn = (wgid % nig) / gsz;
}
__device__ __forceinline__ int xcd_chunk(int L, int nwg) {
    const int q = nwg / NXCD, r = nwg % NXCD, xcd = L % NXCD, off = L / NXCD; return (xcd < r ? xcd * (q + 1) : r * (q + 1) + (xcd - r) * q) + off;
}

typedef f32x4 Acc[2][2][4][2];

template <class Epi, class Sched>
__device__ __forceinline__ void gemm_phase_simple(LAS unsigned char* lds, int lda, int ldb, const Sched& S, const Epi& E) {
    const int tid = threadIdx.x, wid = __builtin_amdgcn_readfirstlane(tid >> 6), lane = tid & 63, wr = wid >> 2, wc = wid & 3, fr = lane & 15, fq = lane >> 4;
    Unit u;
    for (int ui = 0; S.next(ui, u); ++ui) {
        Acc acc;
#pragma unroll
        for (int a = 0; a < 2; ++a)
#pragma unroll
            for (int b = 0; b < 2; ++b)
#pragma unroll
                for (int m = 0; m < 4; ++m)
#pragma unroll
                    for (int n = 0; n < 2; ++n) acc[a][b][m][n] = (f32x4){0.f, 0.f, 0.f, 0.f};
        for (int ks = 0; ks < u.nt * 2; ++ks) {
            f16x8 Af[2][4], Bf[2][2];
            const size_t kb = (size_t)(ks * 32 + fq * 8) * 2;
#pragma unroll
            for (int ai = 0; ai < 2; ++ai)
#pragma unroll
                for (int m = 0; m < 4; ++m) Af[ai][m] = *(const f16x8*)(u.a + (size_t)(ai * 128 + wr * 64 + m * 16 + fr) * lda * 2 + kb);
#pragma unroll
            for (int bj = 0; bj < 2; ++bj)
#pragma unroll
                for (int n = 0; n < 2; ++n) { const int rr = Epi::PERM ? (8 * (fr >> 2) + 4 * n + (fr & 3)) : (n * 16 + fr);
                    Bf[bj][n] = *(const f16x8*)(u.b + (size_t)(bj * 128 + wc * 32 + rr) * ldb * 2 + kb); }
#pragma unroll
            for (int ai = 0; ai < 2; ++ai)
#pragma unroll
                for (int bj = 0; bj < 2; ++bj)
#pragma unroll
                    for (int m = 0; m < 4; ++m)
#pragma unroll
                        for (int n = 0; n < 2; ++n) acc[ai][bj][m][n] = __builtin_amdgcn_mfma_f32_16x16x32_f16(Bf[bj][n], Af[ai][m], acc[ai][bj][m][n], 0, 0, 0);
        }
        if constexpr (Epi::AFTER_DRAIN) { __syncthreads(); E.fused(acc, u, wr, wc, fr, fq, lds, wid, lane); __syncthreads(); }
        else E(acc, u, wr, wc, fr, fq);
    }
}
#define PG8_LAS LAS
template <class Epi, class Sched, bool ALIGN_EPI = false, bool SP2 = false>
__device__ __forceinline__ void gemm_phase(PG8_LAS unsigned char* lds, const int lda, const int ldb, const size_t kstepB, const Sched& S, const Epi& E) {
    const int tid = threadIdx.x, wid = __builtin_amdgcn_readfirstlane(tid >> 6), lane = tid & 63, wr = wid >> 2, wc = wid & 3, fr = lane & 15, fq = lane >> 4;
    unsigned voffA[2], voffB[2];
#pragma unroll
    for (int i = 0; i < 2; ++i) { int R, C; stage_rc(tid * 16 + i * 8192, R, C); const int Rb = Epi::PERM ? ((R & ~31) + perm32(R & 31)) : R;
        voffA[i] = (unsigned)(R * lda + C) * 2u; voffB[i] = (unsigned)(Rb * ldb + C) * 2u; }
    const size_t kstep = (size_t)(BK * 2);
    const size_t hstepA = (size_t)HALF * lda * 2, hstepB = (size_t)HALF * ldb * 2;
    const unsigned ldsw = (unsigned)wid * 1024u;
    const int aoff = lds_byte(wr * 64 + fr, fq * 8), boff = lds_byte(wc * 32 + fr, fq * 8);
#define PG8_SA(b, h) (((b) * 2 + (h)) * HTB)
#define PG8_SB(b, h) ((4 + (b) * 2 + (h)) * HTB)
#define PG8_STAGE(bufoff, gbase, voff) do { _Pragma("unroll") for (int _i = 0; _i < 2; ++_i) \
        __builtin_amdgcn_global_load_lds((const unsigned*)((const char*)(gbase) + (voff)[_i]), (PG8_LAS unsigned*)(lds + (bufoff) + ldsw + _i * 8192), 16, 0, 0); } while (0)
#define PG8_LDA(dst, b, h) do { _Pragma("unroll") for (int m = 0; m < 4; ++m) _Pragma("unroll") for (int k = 0; k < 2; ++k) dst[m][k] = *(const PG8_LAS f16x8*)(lds + PG8_SA(b, h) + aoff + m * 2048 + k * 1024); } while (0)
#define PG8_LDB(dst, b, h) do { _Pragma("unroll") for (int n = 0; n < 2; ++n) _Pragma("unroll") for (int k = 0; k < 2; ++k) dst[n][k] = *(const PG8_LAS f16x8*)(lds + PG8_SB(b, h) + boff + n * 2048 + k * 1024); } while (0)
#define PG8_MMA(ai, bj, At, Bt) do { __builtin_amdgcn_s_setprio(1); _Pragma("unroll") for (int m = 0; m < 4; ++m) _Pragma("unroll") for (int n = 0; n < 2; ++n) _Pragma("unroll") for (int k = 0; k < 2; ++k) \
        acc[ai][bj][m][n] = __builtin_amdgcn_mfma_f32_16x16x32_f16(Bt[n][k], At[m][k], acc[ai][bj][m][n], 0, 0, 0); __builtin_amdgcn_s_setprio(0); } while (0)
#define PG8_WAIT_V(n) asm volatile("s_waitcnt vmcnt(" #n ")" ::: "memory")
#define PG8_WAIT_L(n) asm volatile("s_waitcnt lgkmcnt(" #n ")" ::: "memory")
#define PG8_BAR __builtin_amdgcn_s_barrier()
#define PG8_SCHED __builtin_amdgcn_sched_barrier(0)
    Unit cur, nxt; int ui = 0;
    if (!S.next(0, cur)) return;
    f32x4 acc[2][2][4][2];
#pragma unroll
    for (int a = 0; a < 2; ++a)
#pragma unroll
        for (int b = 0; b < 2; ++b)
#pragma unroll
            for (int m = 0; m < 4; ++m)
#pragma unroll
                for (int n = 0; n < 2; ++n) acc[a][b][m][n] = (f32x4){0.f, 0.f, 0.f, 0.f};
    f16x8 At[4][2], B0[2][2], B1[2][2];
    const char* cA = cur.a; const char* cB = cur.b;
    if constexpr (SP2) {
        PG8_STAGE(PG8_SB(0, 0), cB, voffB); PG8_STAGE(PG8_SB(0, 1), cB + hstepB, voffB); PG8_STAGE(PG8_SA(0, 0), cA, voffA); PG8_STAGE(PG8_SA(0, 1), cA + hstepA, voffA);
        if (wr == 1) PG8_BAR;
        PG8_WAIT_V(2); PG8_BAR;
        PG8_STAGE(PG8_SB(1, 0), cB + kstepB, voffB); PG8_STAGE(PG8_SA(1, 0), cA + kstep, voffA); PG8_STAGE(PG8_SB(1, 1), cB + hstepB + kstepB, voffB);
        PG8_WAIT_V(6); PG8_BAR;
    } else {
        PG8_STAGE(PG8_SB(0, 0), cB, voffB); PG8_STAGE(PG8_SA(0, 0), cA, voffA); PG8_STAGE(PG8_SB(0, 1), cB + hstepB, voffB); PG8_STAGE(PG8_SA(0, 1), cA + hstepA, voffA);
        if (wr == 1) PG8_BAR;
        PG8_WAIT_V(4); PG8_BAR;
        PG8_STAGE(PG8_SB(1, 0), cB + kstepB, voffB); PG8_STAGE(PG8_SA(1, 0), cA + kstep, voffA); PG8_STAGE(PG8_SB(1, 1), cB + hstepB + kstepB, voffB);
        PG8_WAIT_V(6); PG8_BAR;
    }
    for (;;) {
        const bool has_next = S.next(ui + 1, nxt);
        const char* nA = has_next ? nxt.a : cA; const char* nB = has_next ? nxt.b : cB; int nt = __builtin_amdgcn_readfirstlane(cur.nt); asm volatile("" : "+s"(nt)); int fullu = __builtin_amdgcn_readfirstlane(cur.half ? 0 : 1); asm volatile("" : "+s"(fullu));
#pragma unroll 1
        for (int t = 0; t < nt; t += 2) {
            const bool last = (t == nt - 2);
            const char* a1 = cA + (size_t)(t + 1) * kstep;
            const char* a2 = last ? nA : cA + (size_t)(t + 2) * kstep; const char* b2 = last ? nB : cB + (size_t)(t + 2) * kstepB;
            const char* a3 = a2 + kstep; const char* b3 = b2 + kstepB;
            if constexpr (SP2) {
            PG8_LDB(B0, 0, 0); PG8_LDB(B1, 0, 1); PG8_SCHED; PG8_LDA(At, 0, 0); PG8_STAGE(PG8_SA(1, 1), a1 + hstepA, voffA);
            PG8_WAIT_V(8); PG8_WAIT_L(0); PG8_BAR; PG8_MMA(0, 0, At, B0); PG8_MMA(0, 1, At, B1); PG8_BAR; PG8_SCHED;
            PG8_LDA(At, 0, 1); PG8_STAGE(PG8_SB(0, 0), b2, voffB); PG8_STAGE(PG8_SB(0, 1), b2 + hstepB, voffB); PG8_STAGE(PG8_SA(0, 0), a2, voffA);
            PG8_WAIT_V(8); PG8_WAIT_L(0); PG8_BAR; if (fullu) { PG8_MMA(1, 0, At, B0); PG8_MMA(1, 1, At, B1); } PG8_BAR; PG8_SCHED;
            PG8_LDB(B0, 1, 0); PG8_LDB(B1, 1, 1); PG8_SCHED; PG8_LDA(At, 1, 0); PG8_STAGE(PG8_SA(0, 1), a2 + hstepA, voffA);
            PG8_WAIT_V(8); PG8_WAIT_L(0); PG8_BAR; PG8_MMA(0, 0, At, B0); PG8_MMA(0, 1, At, B1); PG8_BAR; PG8_SCHED;
            PG8_LDA(At, 1, 1); PG8_STAGE(PG8_SB(1, 0), b3, voffB); PG8_STAGE(PG8_SB(1, 1), b3 + hstepB, voffB); PG8_STAGE(PG8_SA(1, 0), a3, voffA);
            PG8_WAIT_V(8); PG8_WAIT_L(0); PG8_BAR; if (fullu) { PG8_MMA(1, 0, At, B0); PG8_MMA(1, 1, At, B1); } PG8_BAR; PG8_SCHED;
            } else {
            PG8_LDB(B0, 0, 0); PG8_SCHED; PG8_LDA(At, 0, 0); PG8_STAGE(PG8_SA(1, 1), a1 + hstepA, voffA);
            PG8_WAIT_L(8); PG8_BAR; PG8_WAIT_L(0); PG8_MMA(0, 0, At, B0); PG8_BAR; PG8_SCHED;
            PG8_LDB(B1, 0, 1); PG8_STAGE(PG8_SB(0, 0), b2, voffB);
            PG8_BAR; PG8_WAIT_L(0); PG8_MMA(0, 1, At, B1); PG8_BAR;
            PG8_LDA(At, 0, 1); PG8_STAGE(PG8_SA(0, 0), a2, voffA);
            PG8_BAR; PG8_WAIT_L(0); PG8_MMA(1, 0, At, B0); PG8_BAR; PG8_SCHED;
            PG8_STAGE(PG8_SB(0, 1), b2 + hstepB, voffB);
            PG8_WAIT_V(6); PG8_BAR; PG8_MMA(1, 1, At, B1); PG8_BAR;
            PG8_LDB(B0, 1, 0); PG8_SCHED; PG8_LDA(At, 1, 0); PG8_STAGE(PG8_SA(0, 1), a2 + hstepA, voffA);
            PG8_WAIT_L(8); PG8_BAR; PG8_WAIT_L(0); PG8_MMA(0, 0, At, B0); PG8_BAR; PG8_SCHED;
            PG8_LDB(B1, 1, 1); PG8_STAGE(PG8_SB(1, 0), b3, voffB);
            PG8_BAR; PG8_WAIT_L(0); PG8_MMA(0, 1, At, B1); PG8_BAR;
            PG8_LDA(At, 1, 1); PG8_STAGE(PG8_SA(1, 0), a3, voffA);
            PG8_BAR; PG8_WAIT_L(0); PG8_MMA(1, 0, At, B0); PG8_BAR; PG8_SCHED;
            PG8_STAGE(PG8_SB(1, 1), b3 + hstepB, voffB);
            PG8_WAIT_V(6); PG8_BAR; PG8_MMA(1, 1, At, B1); PG8_BAR;
            }
        }
        if constexpr (ALIGN_EPI) { if (wr == 0) PG8_BAR; }
        bool keep_acc = false;
        if constexpr (Epi::HAS_MID) { if (cur.kind == 2) { E.mid(acc, cur, wr, wc, fr, fq); keep_acc = true; } }
        if constexpr (!Epi::AFTER_DRAIN) { if (!keep_acc) E(acc, cur, wr, wc, fr, fq); }
        if (!has_next) break;
        if (!keep_acc) {
#pragma unroll
        for (int a = 0; a < 2; ++a)
#pragma unroll
            for (int b = 0; b < 2; ++b)
#pragma unroll
                for (int m = 0; m < 4; ++m)
#pragma unroll
                    for (int n = 0; n < 2; ++n) acc[a][b][m][n] = (f32x4){0.f, 0.f, 0.f, 0.f};
        }
        cur = nxt; cA = nA; cB = nB; ++ui;
        if constexpr (ALIGN_EPI) { if (wr == 1) PG8_BAR; }
    }
    PG8_WAIT_V(0);
    if constexpr (!ALIGN_EPI) { if (wr == 0) PG8_BAR; }
    PG8_BAR;
    if constexpr (Epi::AFTER_DRAIN) { E.fused(acc, cur, wr, wc, fr, fq, lds, wid, lane); }
#undef PG8_SA
#undef PG8_SB
#undef PG8_STAGE
#undef PG8_LDA
#undef PG8_LDB
#undef PG8_MMA
#undef PG8_WAIT_V
#undef PG8_WAIT_L
#undef PG8_BAR
#undef PG8_SCHED
}
}
using pg8::Unit; using pg8::Acc;

struct EpiF16 {
    static constexpr bool PERM = true, AFTER_DRAIN = false, HAS_MID = false;
    const float* cs0; float scale;
    float* ssq = nullptr;
    const LAS float* rowscale = nullptr;
    __device__ __forceinline__ void mid(Acc&, const Unit&, int, int, int, int) const {}
    __device__ __forceinline__ void operator()(const Acc& acc, const Unit& u, int wr, int wc, int fr, int fq) const {
        f16* base = (f16*)u.o; const int ldc = u.ldc;
        const int row0 = u.r0 + wr * 64 + fr, col0 = u.c0 + wc * 32 + 8 * fq;
        if (u.kind == 3) {
#pragma unroll
            for (int ai = 0; ai < 2; ++ai)
#pragma unroll
                for (int m = 0; m < 4; ++m) { const f32x4 a0 = acc[ai][0][m][0], a1 = acc[ai][0][m][1], g0 = acc[ai][1][m][0], g1 = acc[ai][1][m][1];
                    u32x4 w; w.x = pk2h(a0[0] * fast_sigmoid(g0[0]), a0[1] * fast_sigmoid(g0[1])); w.y = pk2h(a0[2] * fast_sigmoid(g0[2]), a0[3] * fast_sigmoid(g0[3]));
                    w.z = pk2h(a1[0] * fast_sigmoid(g1[0]), a1[1] * fast_sigmoid(g1[1])); w.w = pk2h(a1[2] * fast_sigmoid(g1[2]), a1[3] * fast_sigmoid(g1[3]));
                    *(u32x4*)(base + (size_t)(row0 + ai * 128 + m * 16) * ldc + col0) = w; }
            return; }
        const bool has_cs = (u.kind == 0) && (cs0 != nullptr);
        f32x4 c00, c01, c10, c11;
        if (has_cs) { c00 = *(const f32x4*)(cs0 + col0); c01 = *(const f32x4*)(cs0 + col0 + 4); c10 = *(const f32x4*)(cs0 + col0 + 128); c11 = *(const f32x4*)(cs0 + col0 + 132); }
#pragma unroll
        for (int ai = 0; ai < 2; ++ai) { if (ai == 1 && u.half) break;
#pragma unroll
            for (int m = 0; m < 4; ++m) { f16* rowp = base + (size_t)(row0 + ai * 128 + m * 16) * ldc + col0;
                float rsc = scale; if (rowscale) rsc *= rowscale[ai * 128 + wr * 64 + m * 16 + fr];
                float sq = 0.f;
#pragma unroll
                for (int bj = 0; bj < 2; ++bj) { f32x4 v0 = acc[ai][bj][m][0] * rsc, v1 = acc[ai][bj][m][1] * rsc;
                    if (has_cs) { v0 = v0 * (bj ? c10 : c00); v1 = v1 * (bj ? c11 : c01); }
                    sq += v0[0] * v0[0] + v0[1] * v0[1] + v0[2] * v0[2] + v0[3] * v0[3] + v1[0] * v1[0] + v1[1] * v1[1] + v1[2] * v1[2] + v1[3] * v1[3];
                    u32x4 w; w.x = pk2h(v0[0], v0[1]); w.y = pk2h(v0[2], v0[3]); w.z = pk2h(v1[0], v1[1]); w.w = pk2h(v1[2], v1[3]);
                    *(u32x4*)(rowp + bj * 128) = w; }
                if (ssq) { sq += __shfl_xor(sq, 16); sq += __shfl_xor(sq, 32); if (fq == 0) ssq[(size_t)(row0 + ai * 128 + m * 16) * 32 + (u.c0 >> 8) * 4 + wc] = sq; } } }
    }
};
struct EpiResF32 {
    static constexpr bool PERM = false, AFTER_DRAIN = false, HAS_MID = false;
    __device__ __forceinline__ void mid(Acc&, const Unit&, int, int, int, int) const {}
    const f16* base; float* out; int ldc;
    __device__ __forceinline__ void operator()(const Acc& acc, const Unit& u, int wr, int wc, int fr, int fq) const {
        const int row0 = u.r0 + wr * 64 + fr, col0 = u.c0 + wc * 32 + 4 * fq;
#pragma unroll
        for (int ai = 0; ai < 2; ++ai) {
            u32x2 bs[4][2][2];
#pragma unroll
            for (int m = 0; m < 4; ++m) { const size_t off = (size_t)(row0 + ai * 128 + m * 16) * ldc + col0;
#pragma unroll
                for (int bj = 0; bj < 2; ++bj)
#pragma unroll
                    for (int n = 0; n < 2; ++n) bs[m][bj][n] = *(const u32x2*)(base + off + bj * 128 + n * 16); }
#pragma unroll
            for (int m = 0; m < 4; ++m) { const size_t off = (size_t)(row0 + ai * 128 + m * 16) * ldc + col0;
#pragma unroll
                for (int bj = 0; bj < 2; ++bj)
#pragma unroll
                    for (int n = 0; n < 2; ++n) { const f32x2 b0 = unpk2h(bs[m][bj][n].x), b1 = unpk2h(bs[m][bj][n].y);
                        *(f32x4*)(out + off + bj * 128 + n * 16) = (f32x4){b0[0], b0[1], b1[0], b1[1]} + acc[ai][bj][m][n]; } }
        }
    }
};
struct EpiResH {
    static constexpr bool PERM = true, AFTER_DRAIN = false, HAS_MID = false;
    __device__ __forceinline__ void mid(Acc&, const Unit&, int, int, int, int) const {}
    const f16* base; f16* out; int ldc;
    __device__ __forceinline__ void operator()(const Acc& acc, const Unit& u, int wr, int wc, int fr, int fq) const {
        const int row0 = u.r0 + wr * 64 + fr, col0 = u.c0 + wc * 32 + 8 * fq;
#pragma unroll
        for (int ai = 0; ai < 2; ++ai) {
            u32x4 bs[4][2];
#pragma unroll
            for (int m = 0; m < 4; ++m)
#pragma unroll
                for (int bj = 0; bj < 2; ++bj) bs[m][bj] = *(const u32x4*)(base + (size_t)(row0 + ai * 128 + m * 16) * ldc + col0 + bj * 128);
#pragma unroll
            for (int m = 0; m < 4; ++m)
#pragma unroll
                for (int bj = 0; bj < 2; ++bj) { const f32x4 a0 = acc[ai][bj][m][0], a1 = acc[ai][bj][m][1]; const u32x4 b = bs[m][bj];
                    const f32x2 b0 = unpk2h(b.x), b1 = unpk2h(b.y), b2 = unpk2h(b.z), b3 = unpk2h(b.w);
                    u32x4 w; w.x = pk2h(b0[0] + a0[0], b0[1] + a0[1]); w.y = pk2h(b1[0] + a0[2], b1[1] + a0[3]); w.z = pk2h(b2[0] + a1[0], b2[1] + a1[1]); w.w = pk2h(b3[0] + a1[2], b3[1] + a1[3]);
                    *(u32x4*)(out + (size_t)(row0 + ai * 128 + m * 16) * ldc + col0 + bj * 128) = w; }
        }
    }
};
struct EpiG3 {
    static constexpr bool PERM = false, AFTER_DRAIN = false, HAS_MID = true;
    const float* base; float* out; f16* xh; float* ssq; const LAS f32x2* fac;
    __device__ __forceinline__ void mid(Acc& acc, const Unit& u, int wr, int wc, int fr, int fq) const {
#pragma unroll
        for (int ai = 0; ai < 2; ++ai)
#pragma unroll
            for (int m = 0; m < 4; ++m) { const float r = fac[ai * 128 + wr * 64 + m * 16 + fr][0];
#pragma unroll
                for (int bj = 0; bj < 2; ++bj)
#pragma unroll
                    for (int n = 0; n < 2; ++n) acc[ai][bj][m][n] = acc[ai][bj][m][n] * r; }
    }
    __device__ __forceinline__ void operator()(const Acc& acc, const Unit& u, int wr, int wc, int fr, int fq) const {
        const int row0 = u.r0 + wr * 64 + fr, col0 = u.c0 + wc * 32 + 4 * fq;
#pragma unroll
        for (int ai = 0; ai < 2; ++ai) {
            f32x4 bs[4][2][2];
#pragma unroll
            for (int m = 0; m < 4; ++m) { const size_t off = (size_t)(row0 + ai * 128 + m * 16) * D + col0;
#pragma unroll
                for (int bj = 0; bj < 2; ++bj)
#pragma unroll
                    for (int n = 0; n < 2; ++n) bs[m][bj][n] = *(const f32x4*)(base + off + bj * 128 + n * 16); }
#pragma unroll
            for (int m = 0; m < 4; ++m) { const size_t off = (size_t)(row0 + ai * 128 + m * 16) * D + col0; const float rb = fac[ai * 128 + wr * 64 + m * 16 + fr][1]; float sq = 0.f;
#pragma unroll
                for (int bj = 0; bj < 2; ++bj)
#pragma unroll
                    for (int n = 0; n < 2; ++n) { const f32x4 v = bs[m][bj][n] + acc[ai][bj][m][n] * rb;
                        sq += v[0] * v[0] + v[1] * v[1] + v[2] * v[2] + v[3] * v[3];
                        u32x2 h; h.x = pk2h(v[0], v[1]); h.y = pk2h(v[2], v[3]); *(u32x2*)(xh + off + bj * 128 + n * 16) = h; }
                sq += __shfl_xor(sq, 16); sq += __shfl_xor(sq, 32); if (fq == 0) ssq[(size_t)(row0 + ai * 128 + m * 16) * 32 + (u.c0 >> 8) * 4 + wc] = sq; }
        }
    }
};
struct EpiSwiGLU {
    static constexpr bool PERM = true, AFTER_DRAIN = false, HAS_MID = false;
    __device__ __forceinline__ void mid(Acc&, const Unit&, int, int, int, int) const {}
    f16* hid;
    __device__ __forceinline__ void operator()(const Acc& acc, const Unit& u, int wr, int wc, int fr, int fq) const {
        const int row0 = u.r0 + wr * 64 + fr, col0 = u.c0 + wc * 32 + 8 * fq;
#pragma unroll
        for (int ai = 0; ai < 2; ++ai) { if (ai == 1 && u.half) break;
#pragma unroll
            for (int m = 0; m < 4; ++m) { f16* rowp = hid + (size_t)(row0 + ai * 128 + m * 16) * DE + col0;
                float h[8];
#pragma unroll
                for (int n = 0; n < 2; ++n)
#pragma unroll
                    for (int j = 0; j < 4; ++j) { const float g = acc[ai][0][m][n][j], up = acc[ai][1][m][n][j]; h[n * 4 + j] = g * fast_sigmoid(g) * up; }
                u32x4 w; w.x = pk2h(h[0], h[1]); w.y = pk2h(h[2], h[3]); w.z = pk2h(h[4], h[5]); w.w = pk2h(h[6], h[7]);
                *(u32x4*)rowp = w; } }
    }
};
struct EpiDown {
    static constexpr bool PERM = true, AFTER_DRAIN = false, HAS_MID = false;
    __device__ __forceinline__ void mid(Acc&, const Unit&, int, int, int, int) const {}
    f16* ys; const float* slot_w;
    __device__ __forceinline__ void operator()(const Acc& acc, const Unit& u, int wr, int wc, int fr, int fq) const {
        const int row0 = u.r0 + wr * 64 + fr, col0 = u.c0 + wc * 32 + 8 * fq;
        float sw[2][4];
#pragma unroll
        for (int ai = 0; ai < 2; ++ai)
#pragma unroll
            for (int m = 0; m < 4; ++m) sw[ai][m] = slot_w[row0 + ai * 128 + m * 16];
#pragma unroll
        for (int ai = 0; ai < 2; ++ai) { if (ai == 1 && u.half) break;
#pragma unroll
            for (int m = 0; m < 4; ++m) { const int row = row0 + ai * 128 + m * 16; f16* rowp = ys + (size_t)row * D + col0;
#pragma unroll
                for (int bj = 0; bj < 2; ++bj) { const f32x4 v0 = acc[ai][bj][m][0] * sw[ai][m], v1 = acc[ai][bj][m][1] * sw[ai][m];
                    u32x4 w; w.x = pk2h(v0[0], v0[1]); w.y = pk2h(v0[2], v0[3]); w.z = pk2h(v1[0], v1[1]); w.w = pk2h(v1[2], v1[3]);
                    *(u32x4*)(rowp + bj * 128) = w; } } }
    }
};
struct EpiSoftmax {
    static constexpr bool PERM = true, AFTER_DRAIN = true, HAS_MID = false;
    __device__ __forceinline__ void mid(Acc&, const Unit&, int, int, int, int) const {}
    f16* P;
    __device__ __forceinline__ void operator()(const Acc&, const Unit&, int, int, int, int) const {}
    __device__ __forceinline__ void fused(Acc& acc, const Unit& u, int wr, int wc, int fr, int fq, LAS unsigned char* lds, int wid, int lane) const {
        LAS f32x2* T = (LAS f32x2*)lds;
        float mloc[2][4], lloc[2][4];
#pragma unroll
        for (int ai = 0; ai < 2; ++ai) { if (ai == 1 && u.half) break;
#pragma unroll
            for (int m = 0; m < 4; ++m) {
                float mx = -3.0e38f;
#pragma unroll
                for (int bj = 0; bj < 2; ++bj)
#pragma unroll
                    for (int n = 0; n < 2; ++n)
#pragma unroll
                        for (int j = 0; j < 4; ++j) mx = fmaxf(mx, acc[ai][bj][m][n][j]);
                mx = fmaxf(mx, __shfl_xor(mx, 16)); mx = fmaxf(mx, __shfl_xor(mx, 32));
                float s = 0.f;
#pragma unroll
                for (int bj = 0; bj < 2; ++bj)
#pragma unroll
                    for (int n = 0; n < 2; ++n)
#pragma unroll
                        for (int j = 0; j < 4; ++j) { const float e = __expf(acc[ai][bj][m][n][j] - mx); acc[ai][bj][m][n][j] = e; s += e; }
                s += __shfl_xor(s, 16); s += __shfl_xor(s, 32);
                mloc[ai][m] = mx; lloc[ai][m] = s;
                if (fq == 0) T[(ai * 128 + wr * 64 + m * 16 + fr) * 4 + wc] = (f32x2){mx, s};
            } }
        LDS_WAIT(); __builtin_amdgcn_s_barrier(); asm volatile("" ::: "memory");
        const int row0 = u.r0 + wr * 64 + fr, col0 = u.c0 + wc * 32 + 8 * fq;
#pragma unroll
        for (int ai = 0; ai < 2; ++ai) { if (ai == 1 && u.half) break;
#pragma unroll
            for (int m = 0; m < 4; ++m) { const int r = ai * 128 + wr * 64 + m * 16 + fr;
                const f32x2 t0 = T[r * 4 + 0], t1 = T[r * 4 + 1], t2 = T[r * 4 + 2], t3 = T[r * 4 + 3];
                const float M = fmaxf(fmaxf(t0.x, t1.x), fmaxf(t2.x, t3.x));
                const float L = t0.y * __expf(t0.x - M) + t1.y * __expf(t1.x - M) + t2.y * __expf(t2.x - M) + t3.y * __expf(t3.x - M);
                const float f = __expf(mloc[ai][m] - M) / L;
                f16* rowp = P + (size_t)(row0 + ai * 128 + m * 16) * 256 + col0;
#pragma unroll
                for (int bj = 0; bj < 2; ++bj) { const f32x4 v0 = acc[ai][bj][m][0] * f, v1 = acc[ai][bj][m][1] * f;
                    u32x4 w; w.x = pk2h(v0[0], v0[1]); w.y = pk2h(v0[2], v0[3]); w.z = pk2h(v1[0], v1[1]); w.w = pk2h(v1[2], v1[3]);
                    *(u32x4*)(rowp + bj * 128) = w; } } }
        (void)lloc;
    }
};

#define F_LANE ((int)(threadIdx.x & 63u))
struct Frame {
    LAS unsigned char* lds;
    unsigned char* ws;
    int tid, wave, G, c;
};
struct Args { const float* in[28]; float* out; unsigned char* ws; int ph_lo, ph_hi, li, pad; };

struct SchedP1 {
    int G, c; char* wsb;
    __device__ __forceinline__ bool next(int i, Unit& u) const {
        if (i > 1) return false;
        const int L = (G == 256) ? (64 * (c & 7) + 32 * i + (c >> 3)) : (i * G + c); if (L >= 400) return false;
        int pm = 0, pn = 0; if (L < 384) { if (G == 256) pg8::tile_of_w(L, 32, 12, pm, pn); else pg8::tile_of(L, 32, 12, pm, pn); }
        const size_t p = (L < 384) ? 1 : 0, k = (L >= 384 && L < 392) ? 1 : 0, v = (L >= 392) ? 1 : 0; const size_t q = (size_t)(L - 384) & 7; const size_t lt = (pn < 4) ? 1 : 0;
        const size_t offA = p * (WS_H + (size_t)pm * 256 * D * 2) + k * WS_M16 + v * (WS_WKV + (2048 + q * 256) * D * 2);
        const size_t offB = p * (WS_WIN + (size_t)pn * 256 * D * 2) + k * (WS_WKV + q * 256 * D * 2) + v * WS_M16;
        const size_t offO = p * WS_PROJ + k * WS_K16 + v * WS_VT16;
        u.a = wsb + offA; u.b = wsb + offB; u.o = wsb + offO; u.nt = 32; u.aux = 0; u.half = 0;
        u.ldc = (int)(p * D + k * D + v * 256);
        u.r0 = (int)(p * pm * 256 + v * q * 256);
        u.c0 = (int)(p * (lt * pn * 256 + (1 - lt) * (1024 + (pn - 4) * 128)) + k * q * 256);
        u.kind = (int)(p * (3 - 3 * lt) + k + 2 * v);
        return true;
    }
};
struct SchedG2 {
    int G, c; const char* dc; const char* wpw; const char* wpool; char* y;
    __device__ __forceinline__ bool next(int i, Unit& u) const {
        const int L = i * G + c; if (L >= 256) return false;
        u.aux = 0; u.half = 0; u.o = y; u.ldc = D;
        if (L < 128) { int pm, pn; pg8::tile_of(L, 32, 4, pm, pn); u.a = dc + ((size_t)pm * 256 * D + 1024) * 2; u.b = wpw + (size_t)pn * 256 * 1024 * 2; u.nt = 16; u.r0 = pm * 256; u.c0 = 1024 + pn * 256; u.kind = 1; }
        else { int pm, g; pg8::tile_of(L - 128, 32, 4, pm, g); u.a = dc + ((size_t)pm * 256 * D + g * 256) * 2; u.b = wpool + (size_t)g * 256 * 1024 * 2; u.nt = 4; u.r0 = pm * 256; u.c0 = g * 256; u.kind = 0; }
        return true;
    }
};
struct SchedDense {
    int G, c; const char* A; const char* B; char* o;
    __device__ __forceinline__ bool next(int i, Unit& u) const {
        const int L = i * G + c; if (L >= 256) return false;
        int pm, pn; pg8::tile_of(L, 32, 8, pm, pn);
        u.a = A + (size_t)pm * 256 * D * 2; u.b = B + (size_t)pn * 256 * D * 2; u.nt = 32; u.r0 = pm * 256; u.c0 = pn * 256; u.kind = 1; u.aux = 0; u.half = 0; u.o = o; u.ldc = D; return true;
    }
};
struct SchedG3 {
    int G, c; const char* A; const char* B;
    __device__ __forceinline__ bool next(int i, Unit& u) const {
        const int L = (i >> 1) * G + c; if (L >= 256) return false;
        int pm, pn; pg8::tile_of(L, 32, 8, pm, pn); const int part = i & 1;
        u.a = A + ((size_t)pm * 256 * D + part * 1024) * 2; u.b = B + ((size_t)pn * 256 * D + part * 1024) * 2; u.nt = 16; u.r0 = pm * 256; u.c0 = pn * 256; u.kind = part ? 1 : 2; u.aux = 0; u.half = 0; u.o = nullptr; u.ldc = D; return true;
    }
};
struct SchedS {
    int G, c; const char* q; const char* k16;
    __device__ __forceinline__ bool next(int i, Unit& u) const {
        const int L = i * G + c; if (L >= 256 || i > 0) return false;
        const int h = L >> 6, pb = L & 63;
        u.a = q + ((size_t)pb * 128 * D + h * HD) * 2; u.b = k16 + (size_t)h * HD * 2; u.nt = 8; u.r0 = h * SEQ + pb * 128; u.c0 = 0; u.kind = 1; u.aux = 0; u.half = 1; u.o = nullptr; u.ldc = 256; return true;
    }
};
struct SchedPV {
    int G, c; const char* p; const char* vt; char* o;
    __device__ __forceinline__ bool next(int i, Unit& u) const {
        const int L = c; if (L >= 256 || i > 1) return false;
        const int h = L >> 6, pb = L & 63, pn = i;
        u.a = p + (size_t)(h * SEQ + pb * 128) * 256 * 2; u.b = vt + (size_t)(h * HD + pn * 256) * 256 * 2; u.nt = 4; u.r0 = pb * 128; u.c0 = h * HD + pn * 256; u.kind = 1; u.aux = 0; u.half = 1; u.o = o; u.ldc = D; return true;
    }
};
struct SchedGU {
    int G, c, mode; const char* xs; const char* wgu; const LAS int* tab;
    __device__ __forceinline__ bool next(int i, Unit& u) const {
        const int NF = __builtin_amdgcn_readfirstlane(tab[0]), NH = __builtin_amdgcn_readfirstlane(tab[1]); const int L = i * G + c; const int n = (mode ? NH : NF) * 4; if (L >= n) return false;
        const int w = pg8::xcd_chunk(L, n); const int j = (mode ? NF : 0) + (w >> 2), pn = w & 3; u.half = mode;
        const int te = __builtin_amdgcn_readfirstlane(tab[2 + j]); const int e = te & 255, r0 = (te >> 8) * 128;
        u.a = xs + (size_t)r0 * D * 2; u.b = wgu + (size_t)(e * 4 + pn) * (32 * 32768); u.nt = 32; u.r0 = r0; u.c0 = pn * 128; u.kind = 1; u.aux = e; u.o = nullptr; u.ldc = DE; return true;
    }
};
struct SchedDN {
    int G, c, mode; const char* hid; const char* wdn; const LAS int* tab;
    __device__ __forceinline__ bool next(int i, Unit& u) const {
        const int NF = __builtin_amdgcn_readfirstlane(tab[0]), NH = __builtin_amdgcn_readfirstlane(tab[1]);
        int j, pn;
        if (mode == 0) { const int HG = (4 * NH < G) ? 4 * NH : G, N0 = G - HG; int k;
            if (c >= HG) k = (i < 2) ? (i * N0 + (c - HG)) : (2 * N0 + (i - 2) * G + c); else k = 2 * N0 + i * G + c;
            if (k >= 8 * NF) return false;
            const int kfull = (NF >> 3) << 6;
            if (k < kfull) { const int blk = k >> 6, r = k & 63; j = 8 * blk + (r & 7); pn = r >> 3; } else { j = k >> 3; pn = k & 7; }
            u.half = 0; }
        else { const int L = i * G + c; if (L >= 8 * NH) return false; const int w = pg8::xcd_chunk(L, 8 * NH); j = NF + (w >> 3); pn = w & 7; u.half = 1; }
        const int te = __builtin_amdgcn_readfirstlane(tab[2 + j]); const int e = te & 255, r0 = (te >> 8) * 128;
        u.a = hid + (size_t)r0 * DE * 2; u.b = wdn + (size_t)(e * 8 + pn) * (8 * 32768); u.nt = 8; u.r0 = r0; u.c0 = pn * 256; u.kind = 1; u.aux = e; u.o = nullptr; u.ldc = D; return true;
    }
};

struct TrItem { const float* src; f16* dst; const float* ks; int N; int pitch; };
__device__ __forceinline__ void tr_load(const TrItem& d, f32x4 (&v)[8]) {
#pragma unroll
    for (int i = 0; i < 8; ++i) v[i] = __builtin_nontemporal_load((const f32x4*)(d.src + (size_t)(8 * i) * d.N));
}
__device__ __forceinline__ void tr_store(const TrItem& d, const f32x4 (&v)[8], LAS float* scr, int lane) {
#pragma unroll
    for (int i = 0; i < 8; ++i) { LAS float* p = scr + ((lane >> 3) + 8 * i) * 33 + 4 * (lane & 7); p[0] = v[i][0]; p[1] = v[i][1]; p[2] = v[i][2]; p[3] = v[i][3]; }
    LDS_WAIT(); asm volatile("" ::: "memory");
    const int c = lane >> 3, nl = lane & 7;
    f32x4 ka = (f32x4){1.f, 1.f, 1.f, 1.f}, kb2 = ka; if (d.ks) { ka = *(const f32x4*)(d.ks + 8 * c); kb2 = *(const f32x4*)(d.ks + 8 * c + 4); }
#pragma unroll
    for (int jj = 0; jj < 4; ++jj) { const int n = nl + 8 * jj; const LAS float* s = scr + (8 * c) * 33 + n;
        u32x4 o; o.x = pk2h(s[0 * 33] * ka[0], s[1 * 33] * ka[1]); o.y = pk2h(s[2 * 33] * ka[2], s[3 * 33] * ka[3]); o.z = pk2h(s[4 * 33] * kb2[0], s[5 * 33] * kb2[1]); o.w = pk2h(s[6 * 33] * kb2[2], s[7 * 33] * kb2[3]);
        __builtin_nontemporal_store(o, (u32x4*)(d.dst + (size_t)n * d.pitch + 8 * c)); }
    LDS_WAIT(); asm volatile("" ::: "memory");
}
__device__ __forceinline__ void rms_row_f32(const float* xrow, const float* g, f16* orow, int lane) {
    f32x4 v[8]; float s = 0.f;
#pragma unroll
    for (int j = 0; j < 4; ++j) { const f32x4* p = (const f32x4*)(xrow + 8 * (lane + 64 * j)); v[2 * j] = p[0]; v[2 * j + 1] = p[1];
        s += v[2 * j][0] * v[2 * j][0] + v[2 * j][1] * v[2 * j][1] + v[2 * j][2] * v[2 * j][2] + v[2 * j][3] * v[2 * j][3];
        s += v[2 * j + 1][0] * v[2 * j + 1][0] + v[2 * j + 1][1] * v[2 * j + 1][1] + v[2 * j + 1][2] * v[2 * j + 1][2] + v[2 * j + 1][3] * v[2 * j + 1][3]; }
    const float rs = rsqrtf(wave_sum(s) * (1.0f / D) + EPS);
#pragma unroll
    for (int j = 0; j < 4; ++j) { const f32x4* gp = (const f32x4*)(g + 8 * (lane + 64 * j)); const f32x4 a = v[2 * j] * rs * gp[0], b = v[2 * j + 1] * rs * gp[1];
        u32x4 o; o.x = pk2h(a[0], a[1]); o.y = pk2h(a[2], a[3]); o.z = pk2h(b[0], b[1]); o.w = pk2h(b[2], b[3]);
        *(u32x4*)(orow + 8 * (lane + 64 * j)) = o; }
}

constexpr int I_IN = 32 * 96, I_POOL = 4 * 4 * 8, I_PW = 16 * 32, I_SQ = 32 * 64, I_KV = 32 * 128, I_G = 32 * 32 * 16, I_D = 32 * 8 * 64;
constexpr int NITEMS = I_IN + I_POOL + I_PW + 3 * I_SQ + I_KV + 2 * I_G + I_D;
__device__ __forceinline__ void blk_order(int r, int NB, int KL, int NL, int& kb, int& nb) {
    const int per = KL * NL, blk = r / per, lo = r % per, nbh = NB / NL; nb = (blk % nbh) * NL + lo % NL; kb = (blk / nbh) * KL + lo / NL;
}
constexpr int SEG_A = I_IN + I_KV, SEG_B = SEG_A + I_POOL + I_PW + 3 * I_SQ, SEG_GU = SEG_B + 2 * I_G;
static_assert(SEG_GU + I_D == NITEMS, "item segments");
__device__ __forceinline__ TrItem tr_decode(int r, const Args& A, unsigned char* ws, int lane) {
    const float* W; int N, k0, n0, pitch, kb, nb; f16* dst; const float* ks = nullptr;
    if (r < I_IN) { blk_order(r, 96, 16, 16, kb, nb); W = A.in[3]; N = NPROJ; k0 = kb * 64; n0 = nb * 32; pitch = D;
        int drow = n0; if (n0 >= 2048) { const int cc = n0 - 2048; drow = 1024 + (cc >> 7) * 256 + 128 + (cc & 127); } else if (n0 >= 1024) { const int cc = n0 - 1024; drow = 1024 + (cc >> 7) * 256 + (cc & 127); }
        dst = (f16*)(ws + WS_WIN) + (size_t)drow * D + k0; }
    else if ((r -= I_IN) < I_KV) { blk_order(r, 128, 16, 16, kb, nb); W = A.in[17]; N = 4096; k0 = kb * 64; n0 = nb * 32; pitch = D; dst = (f16*)(ws + WS_WKV) + (size_t)n0 * D + k0; }
    else if ((r -= I_KV) < I_POOL) { const int g = r / 32, q = r % 32; kb = q / 8; nb = q % 8; W = A.in[4] + (size_t)g * 65536; N = 256; k0 = kb * 64; n0 = nb * 32; pitch = 1024; dst = (f16*)(ws + WS_WPOOL) + (size_t)(g * 256 + n0) * 1024 + k0; }
    else if ((r -= I_POOL) < I_PW) { blk_order(r, 32, 16, 16, kb, nb); W = A.in[10]; N = 1024; k0 = kb * 64; n0 = nb * 32; pitch = 1024; dst = (f16*)(ws + WS_WPW) + (size_t)n0 * 1024 + k0; }
    else if ((r -= I_PW) < I_SQ) { blk_order(r, 64, 16, 16, kb, nb); W = A.in[13]; N = D; k0 = kb * 64; n0 = nb * 32; pitch = D; dst = (f16*)(ws + WS_WOUT) + (size_t)n0 * D + k0; ks = (k0 < 1024) ? (A.in[11] + k0) : (A.in[12] + k0 - 1024); }
    else if ((r -= I_SQ) < I_SQ) { blk_order(r, 64, 16, 16, kb, nb); W = A.in[16]; N = D; k0 = kb * 64; n0 = nb * 32; pitch = D; dst = (f16*)(ws + WS_WQ) + (size_t)n0 * D + k0; ks = A.in[14] + k0; }
    else if ((r -= I_SQ) < I_SQ) { blk_order(r, 64, 16, 16, kb, nb); W = A.in[18]; N = D; k0 = kb * 64; n0 = nb * 32; pitch = D; dst = (f16*)(ws + WS_WO) + (size_t)n0 * D + k0; }
    else if ((r -= I_SQ) < 2 * I_G) { const int up = r >= I_G; if (up) r -= I_G; const int e = r / 512; blk_order(r % 512, 16, 16, 16, kb, nb); n0 = nb * 32; k0 = kb * 64;
        W = (up ? A.in[25] : A.in[24]) + (size_t)e * D * DE; N = DE; pitch = 64;
        dst = (f16*)(ws + WS_WGU) + ((size_t)((e * 4 + (n0 >> 7)) * 32 + kb) * 256 + up * 128 + (n0 & 127)) * 64; k0 = kb * 64; }
    else { r -= 2 * I_G; const int e = r / 512; blk_order(r % 512, 64, 8, 32, kb, nb); W = A.in[26] + (size_t)e * DE * D; N = D; k0 = kb * 64; n0 = nb * 32; pitch = 64;
        dst = (f16*)(ws + WS_WDN) + ((size_t)((e * 8 + (n0 >> 8)) * 8 + kb) * 256 + (n0 & 255)) * 64; }
    TrItem d; d.src = W + (size_t)(k0 + (lane >> 3)) * N + n0 + 4 * (lane & 7); d.dst = dst; d.ks = ks; d.N = N; d.pitch = pitch; return d;
}
constexpr int CW_QHEAD = 64, CW_ARRIVE = 1024;
__device__ __forceinline__ void tr_batch16(const Frame& F, const Args& A, int first) {
    LAS float* scr = (LAS float*)(F.lds + F.wave * 16384);
    const int i0 = first + F.wave, i1 = first + 8 + F.wave; const bool v0 = i0 < NITEMS, v1 = i1 < NITEMS;
    TrItem d0, d1; f32x4 a[8], b[8];
    if (v0) { d0 = tr_decode(i0, A, F.ws, F_LANE); tr_load(d0, a); }
    if (v1) { d1 = tr_decode(i1, A, F.ws, F_LANE); tr_load(d1, b); }
    if (v0) tr_store(d0, a, scr, F_LANE);
    if (v1) tr_store(d1, b, scr, F_LANE);
}
__device__ __forceinline__ void tr_batch8(const Frame& F, const Args& A, int first) {
    LAS float* scr = (LAS float*)(F.lds + F.wave * 16384);
    const int i0 = first + F.wave;
    if (i0 < NITEMS) { f32x4 a[8]; const TrItem d0 = tr_decode(i0, A, F.ws, F_LANE); tr_load(d0, a); tr_store(d0, a, scr, F_LANE); }
}
__device__ __forceinline__ void tr_drain(const Frame& F, const Args& A, int limit) {
    unsigned* head = (unsigned*)(F.ws + WS_CTL) + CW_QHEAD; volatile LAS int* slot = (volatile LAS int*)(F.lds + MISC_OFF) + 16;
    __syncthreads();
    if (F.tid == 0) { int it = NITEMS; if ((int)xb_ld(head) < limit) it = (int)xb_add(head, 16u); slot[0] = it; }
    __syncthreads();
    int it = slot[0];
    while (it < NITEMS) {
        unsigned nx = (unsigned)NITEMS;
        if (F.tid == 0 && it < limit) nx = xb_add(head, 16u);
        tr_batch16(F, A, it);
        __syncthreads();
        if (F.tid == 0) slot[0] = (int)nx;
        __syncthreads();
        it = slot[0];
    }
}
__device__ __forceinline__ void tr_idle(const Frame& F, const Args& A, int ph) {
    unsigned* head = (unsigned*)(F.ws + WS_CTL) + CW_QHEAD; unsigned* arr = (unsigned*)(F.ws + WS_CTL) + CW_ARRIVE + 64 * ph;
    volatile LAS int* slot = (volatile LAS int*)(F.lds + MISC_OFF) + 16;
    __syncthreads();
    if (F.tid == 0) { (void)xb_add(arr, 1u); int it = NITEMS; if (xb_ld(arr) < (unsigned)F.G) it = (int)xb_add(head, 16u); slot[0] = it; }
    __syncthreads();
    int it = slot[0];
    while (it < NITEMS) {
        unsigned nx = (unsigned)NITEMS, ar = 0u;
        if (F.tid == 0) { ar = xb_ld(arr); nx = xb_add(head, 16u); }
        tr_batch16(F, A, it);
        __syncthreads();
        if (F.tid == 0) slot[0] = (int)nx, slot[1] = (ar >= (unsigned)F.G) ? 1 : 0;
        __syncthreads();
        it = slot[0];
        if (slot[1]) { if (it < NITEMS) tr_batch16(F, A, it); break; }
    }
}
__device__ __forceinline__ void phase_prep(const Frame& F, const Args& A) {
    const int gw = F.c * 8 + F.wave, NGW = F.G * 8;
    unsigned char* ws = F.ws;
    for (int m = gw; m < SEQ; m += NGW) rms_row_f32(A.in[0] + (size_t)m * D, A.in[2], (f16*)(ws + WS_H) + (size_t)m * D, F_LANE);
    for (int m = gw; m < MEMLEN; m += NGW) rms_row_f32(A.in[1] + (size_t)m * D, A.in[15], (f16*)(ws + WS_M16) + (size_t)m * D, F_LANE);
    tr_drain(F, A, SEG_A);
}

template <int TT> __device__ __forceinline__ void conv_step(f32x2 (&acc)[32], const f32x2 (&w)[CK], const LAS unsigned* yl, const unsigned ycur) {
    unsigned ynext = 0u;
    if constexpr (TT + 1 < 62) ynext = yl[(TT + 1) * 512];
    const f32x2 y = unpk2h(ycur);
#pragma unroll
    for (int r = (TT - 30 > 0 ? TT - 30 : 0); r <= (TT < 31 ? TT : 31); ++r) acc[r] = acc[r] + w[TT - r] * y;
    __builtin_amdgcn_sched_barrier(0);
    if constexpr (TT + 1 < 62) conv_step<TT + 1>(acc, w, yl, ynext);
}
__device__ __forceinline__ void phase_mixpre(const Frame& F, const Args& A) {
    const f16* proj = (const f16*)(F.ws + WS_PROJ);
    f16* dc = (f16*)(F.ws + WS_DC);
    LAS unsigned* ylds = (LAS unsigned*)F.lds;
    LAS float* red = (LAS float*)F.lds;
    LAS float* stat = (LAS float*)(F.lds + TAB_OFF);
    const int tid = F.tid, lane = F_LANE;
    for (int blk = F.c; blk < SEQ / 32; blk += F.G) {
        const int t0 = blk * 32;
#pragma unroll 2
        for (int p = 0; p < 12; ++p) { const int rr = p * 4 + (tid >> 7); const int t = t0 - 15 + rr; u32x4 v = (u32x4){0u, 0u, 0u, 0u};
            if (t >= 0 && t < SEQ) v = *(const u32x4*)(proj + (size_t)t * D + (tid & 127) * 8);
            *(LAS u32x4*)(ylds + rr * 512 + (tid & 127) * 4) = v; }
        __syncthreads();
        { const int g = tid >> 7, wnd = 2 << g; f32x2 S = (f32x2){0.f, 0.f};
          for (int i = 1; i < wnd; ++i) S = S + unpk2h(ylds[(15 - i) * 512 + tid]);
#pragma unroll 4
          for (int r = 0; r < 32; ++r) { const int t = t0 + r; const f32x2 cur = unpk2h(ylds[(15 + r) * 512 + tid]); S = S + cur;
              const int cnt = (t + 1 < wnd) ? (t + 1) : wnd; const float ic = 1.0f / (float)cnt;
              *(unsigned*)(dc + (size_t)t * D + 2 * tid) = pk2h(S[0] * ic - cur[0], S[1] * ic - cur[1]);
              S = S - unpk2h(ylds[(15 + r - wnd + 1) * 512 + tid]); } }
        __syncthreads();
#pragma unroll 2
        for (int p = 0; p < 16; ++p) { const int r = p * 4 + (tid >> 7), c8 = (tid & 127) * 8; const int t = t0 - 30 + r;
            u32x4 o = (u32x4){0u, 0u, 0u, 0u};
            if (t >= 0 && r < 62) o = *(const u32x4*)(proj + (size_t)t * D + 1024 + c8);
            if (r < 62) *(LAS u32x4*)(ylds + r * 512 + (tid & 127) * 4) = o; }
        __syncthreads();
        f32x2 acc[32];
        { f32x2 w[CK];
#pragma unroll
          for (int j = 0; j < CK; ++j) w[j] = *(const f32x2*)(A.in[6] + j * 1024 + 2 * tid);
          const f32x2 bdw = *(const f32x2*)(A.in[7] + 2 * tid);
#pragma unroll
          for (int r = 0; r < 32; ++r) acc[r] = bdw;
          conv_step<0>(acc, w, ylds + tid, ylds[tid]); }
        __syncthreads();
#pragma unroll
        for (int r = 0; r < 32; ++r) { red[(2 * r) * 512 + tid] = acc[r][0] + acc[r][1]; red[(2 * r + 1) * 512 + tid] = acc[r][0] * acc[r][0] + acc[r][1] * acc[r][1]; }
        __syncthreads();
        { const int s = tid >> 3, sl = tid & 7; float a = 0.f;
#pragma unroll 8
          for (int i = 0; i < 64; ++i) a += red[s * 512 + sl * 64 + ((i + lane) & 63)];
          a += __shfl_xor(a, 1); a += __shfl_xor(a, 2); a += __shfl_xor(a, 4);
          if (sl == 0) stat[s] = a; }
        __syncthreads();
        { const f32x2 lng = *(const f32x2*)(A.in[8] + 2 * tid), lnb = *(const f32x2*)(A.in[9] + 2 * tid);
#pragma unroll
          for (int r = 0; r < 32; ++r) { const float mean = stat[2 * r] * (1.0f / 1024.f); const float var = stat[2 * r + 1] * (1.0f / 1024.f) - mean * mean; const float rstd = rsqrtf(var + EPS);
              const float y0 = (acc[r][0] - mean) * rstd * lng[0] + lnb[0], y1 = (acc[r][1] - mean) * rstd * lng[1] + lnb[1];
              *(unsigned*)(dc + (size_t)(t0 + r) * D + 1024 + 2 * tid) = pk2h(y0 * fast_sigmoid(y0), y1 * fast_sigmoid(y1)); } }
        __syncthreads();
    }
}

__device__ __forceinline__ void phase_rownorm(const Frame& F, const Args& A) {
    const f16* y = (const f16*)(F.ws + WS_Y); f16* yn = (f16*)(F.ws + WS_YN);
    const int gw = F.c * 8 + F.wave, NGW = F.G * 8, lane = F_LANE;
    for (int m = gw; m < SEQ; m += NGW) {
        u32x4 v[4]; float sa = 0.f, sb = 0.f;
#pragma unroll
        for (int j = 0; j < 4; ++j) { v[j] = *(const u32x4*)(y + (size_t)m * D + 8 * (lane + 64 * j)); float s = 0.f;
#pragma unroll
            for (int q = 0; q < 4; ++q) { const f32x2 a = unpk2h(v[j][q]); s += a[0] * a[0] + a[1] * a[1]; }
            if (j < 2) sa += s; else sb += s; }
        const float ra = rsqrtf(wave_sum(sa) * (1.0f / 1024.f) + EPS), rb = rsqrtf(wave_sum(sb) * (1.0f / 1024.f) + EPS);
#pragma unroll
        for (int j = 0; j < 4; ++j) { const int col = 8 * (lane + 64 * j); const float* g = (j < 2) ? (A.in[11] + col) : (A.in[12] + col - 1024); const float rs = (j < 2) ? ra : rb;
            const f32x4 g0 = *(const f32x4*)g, g1 = *(const f32x4*)(g + 4); u32x4 o;
            { const f32x2 a = unpk2h(v[j][0]); o.x = pk2h(a[0] * rs * g0[0], a[1] * rs * g0[1]); }
            { const f32x2 a = unpk2h(v[j][1]); o.y = pk2h(a[0] * rs * g0[2], a[1] * rs * g0[3]); }
            { const f32x2 a = unpk2h(v[j][2]); o.z = pk2h(a[0] * rs * g1[0], a[1] * rs * g1[1]); }
            { const f32x2 a = unpk2h(v[j][3]); o.w = pk2h(a[0] * rs * g1[2], a[1] * rs * g1[3]); }
            *(u32x4*)(yn + (size_t)m * D + col) = o; }
    }
}
__device__ __forceinline__ void phase_norm_x(const Frame& F, const float* x, const float* g) {
    const int gw = F.c * 8 + F.wave, NGW = F.G * 8;
    for (int m = gw; m < SEQ; m += NGW) rms_row_f32(x + (size_t)m * D, g, (f16*)(F.ws + WS_H) + (size_t)m * D, F_LANE);
}

typedef float f32x16 __attribute__((ext_vector_type(16)));
__device__ __forceinline__ void phase_router(const Frame& F, const Args& A, const f16* x2) {
    const float* gf = A.in[19]; const float* wrg = A.in[20]; const float* brg = A.in[21]; const float* wre = A.in[22]; const float* bre = A.in[23];
    LAS float* xt = (LAS float*)(F.lds) + F.wave * (32 * 68 + 256);
    LAS float* wgt = xt + 32 * 68;
    constexpr int XT_BYTES = 8 * (32 * 68 + 256) * 4;
    LAS float* part = (LAS float*)(F.lds + XT_BYTES);
    LAS float* gpart = (LAS float*)(F.lds + XT_BYTES + 36864);
    LAS float* ssqp = (LAS float*)(F.lds + XT_BYTES + 40960);
    LAS float* lgf = (LAS float*)(F.lds + XT_BYTES + 45056);
    LAS int* hist = (LAS int*)(F.lds + XT_BYTES + 51200);
    int* histg = (int*)(F.ws + WS_HIST); int* toke = (int*)(F.ws + WS_TOKE); float* tokw = (float*)(F.ws + WS_TOKW); float* tokrs = (float*)(F.ws + WS_TOKRS);
    f16* h3 = (f16*)(F.ws + WS_H);
    const int tid = F.tid, lane = F_LANE, w = F.wave, tok = lane & 31, h = lane >> 5;
    for (int ch = F.c; ch < SEQ / 32; ch += F.G) {
        if (tid < 32) hist[tid] = 0;
        const int t0 = ch * 32;
        const f16* xs0 = x2 + (size_t)(t0 + (lane >> 3)) * D + 256 * w + 8 * (lane & 7);
#define LDX8(dst0, dst1, p) do { const u32x4 v_ = *(const u32x4*)(p); const f32x2 e0 = unpk2h(v_.x), e1 = unpk2h(v_.y), e2 = unpk2h(v_.z), e3 = unpk2h(v_.w); dst0 = (f32x4){e0[0], e0[1], e1[0], e1[1]}; dst1 = (f32x4){e2[0], e2[1], e3[0], e3[1]}; } while (0)
        f16* ho0 = h3 + (size_t)(t0 + (lane >> 3)) * D + 256 * w + 8 * (lane & 7);
        const float* wre0 = wre + (size_t)(256 * w + h) * 32 + tok;
        const float* wrg0 = wrg + (size_t)(256 * w + lane) * 4;
        f32x4 pre[8], wgn; float bwn[32];
#pragma unroll
        for (int i = 0; i < 4; ++i) LDX8(pre[2 * i], pre[2 * i + 1], xs0 + (size_t)(8 * i) * D);
        { const float* p0 = wre0; const float* p1 = wre0 + 1024; asm volatile("" : "+v"(p0)); asm volatile("" : "+v"(p1));
#pragma unroll
          for (int s = 0; s < 16; ++s) { bwn[s] = p0[64 * s]; bwn[16 + s] = p1[64 * s]; } }
        wgn = *(const f32x4*)wrg0;
        f32x16 acc;
#pragma unroll
        for (int i = 0; i < 16; ++i) acc[i] = 0.f;
        float ga0 = 0.f, ga1 = 0.f, ga2 = 0.f, ga3 = 0.f; float sq[4] = {0.f, 0.f, 0.f, 0.f};
#pragma unroll 1
        for (int b = 0; b < 4; ++b) {
            float bw[32];
            { const f32x4 gA = *(const f32x4*)(gf + 256 * w + 64 * b + 8 * (lane & 7)), gB = *(const f32x4*)(gf + 256 * w + 64 * b + 8 * (lane & 7) + 4);
#pragma unroll
              for (int i = 0; i < 4; ++i) { const f32x4 xa = pre[2 * i], xb = pre[2 * i + 1];
                  sq[i] += xa[0] * xa[0] + xa[1] * xa[1] + xa[2] * xa[2] + xa[3] * xa[3] + xb[0] * xb[0] + xb[1] * xb[1] + xb[2] * xb[2] + xb[3] * xb[3];
                  const f32x4 a = xa * gA, c = xb * gB;
                  LAS float* p = xt + (8 * i + (lane >> 3)) * 68 + 8 * (lane & 7); *(LAS f32x4*)p = a; *(LAS f32x4*)(p + 4) = c;
                  u32x4 o; o.x = pk2h(a[0], a[1]); o.y = pk2h(a[2], a[3]); o.z = pk2h(c[0], c[1]); o.w = pk2h(c[2], c[3]);
                  *(u32x4*)(ho0 + (size_t)(8 * i) * D + 64 * b) = o; } }
            *(LAS f32x4*)(wgt + 4 * lane) = wgn;
#pragma unroll
            for (int s = 0; s < 32; ++s) bw[s] = bwn[s];
            if (b < 3) {
#pragma unroll
                for (int i = 0; i < 4; ++i) LDX8(pre[2 * i], pre[2 * i + 1], xs0 + (size_t)(8 * i) * D + 64 * (b + 1));
                { const float* p0 = wre0 + 2048 * (b + 1); const float* p1 = p0 + 1024; asm volatile("" : "+v"(p0)); asm volatile("" : "+v"(p1));
#pragma unroll
                  for (int s = 0; s < 16; ++s) { bwn[s] = p0[64 * s]; bwn[16 + s] = p1[64 * s]; } }
                wgn = *(const f32x4*)(wrg0 + 256 * (b + 1)); }
            LDS_WAIT(); asm volatile("" ::: "memory");
#pragma unroll
            for (int q = 0; q < 16; ++q) {
                const f32x4 xv = *(const LAS f32x4*)(xt + tok * 68 + 4 * q);
                const f32x4 wg0 = *(const LAS f32x4*)(wgt + 4 * (4 * q + h)), wg1 = *(const LAS f32x4*)(wgt + 4 * (4 * q + 2 + h));
                const float a0 = h ? xv[1] : xv[0], a1 = h ? xv[3] : xv[2];
                acc = __builtin_amdgcn_mfma_f32_32x32x2f32(a0, bw[2 * q], acc, 0, 0, 0);
                acc = __builtin_amdgcn_mfma_f32_32x32x2f32(a1, bw[2 * q + 1], acc, 0, 0, 0);
                ga0 += a0 * wg0[0] + a1 * wg1[0]; ga1 += a0 * wg0[1] + a1 * wg1[1]; ga2 += a0 * wg0[2] + a1 * wg1[2]; ga3 += a0 * wg0[3] + a1 * wg1[3];
                if ((q & 1) == 1) __builtin_amdgcn_sched_barrier(0); }
            LDS_WAIT(); asm volatile("" ::: "memory");
        }
#pragma unroll
        for (int i = 0; i < 4; ++i) { float s = sq[i]; s += __shfl_xor(s, 1); s += __shfl_xor(s, 2); s += __shfl_xor(s, 4); if ((lane & 7) == 0) ssqp[w * 32 + 8 * i + (lane >> 3)] = s; }
#pragma unroll
        for (int r = 0; r < 16; ++r) part[(w * 32 + (r & 3) + 8 * (r >> 2) + 4 * h) * 33 + tok] = acc[r];
        ga0 += __shfl_xor(ga0, 32); ga1 += __shfl_xor(ga1, 32); ga2 += __shfl_xor(ga2, 32); ga3 += __shfl_xor(ga3, 32);
        if (h == 0) { *(LAS f32x4*)(gpart + (w * 32 + tok) * 4) = (f32x4){ga0, ga1, ga2, ga3}; }
        __syncthreads();
        { const int token = tid >> 4, e2 = tid & 15; float s0 = 0.f, s1 = 0.f;
#pragma unroll
          for (int ww = 0; ww < 8; ++ww) { s0 += part[(ww * 32 + token) * 33 + 2 * e2]; s1 += part[(ww * 32 + token) * 33 + 2 * e2 + 1]; }
          lgf[token * 40 + 4 + 2 * e2] = s0; lgf[token * 40 + 5 + 2 * e2] = s1;
          if (e2 < 4) { float s = 0.f;
#pragma unroll
              for (int ww = 0; ww < 8; ++ww) s += gpart[(ww * 32 + token) * 4 + e2];
              lgf[token * 40 + e2] = s; }
          if (e2 == 4) { float s = 0.f;
#pragma unroll
              for (int ww = 0; ww < 8; ++ww) s += ssqp[ww * 32 + token];
              lgf[token * 40 + 36] = rsqrtf(s * (1.0f / D) + EPS); } }
        __syncthreads();
        if (tid < 32) { const int t = tid; const LAS float* L = lgf + t * 40; const float rs = L[36];
            const float g0 = L[0] * rs + brg[0], g1 = L[1] * rs + brg[1], g2 = L[2] * rs + brg[2], g3 = L[3] * rs + brg[3];
            int gi = 0; float gm = g0; if (g1 > gm) { gm = g1; gi = 1; } if (g2 > gm) { gm = g2; gi = 2; } if (g3 > gm) { gm = g3; gi = 3; }
            const float pg = 1.0f / (__expf(g0 - gm) + __expf(g1 - gm) + __expf(g2 - gm) + __expf(g3 - gm));
            float le[8];
#pragma unroll
            for (int i = 0; i < 8; ++i) le[i] = L[4 + gi * 8 + i] * rs + bre[gi * 8 + i];
            int i1 = 0; float m1 = le[0];
#pragma unroll
            for (int i = 1; i < 8; ++i) if (le[i] > m1) { m1 = le[i]; i1 = i; }
            int i2 = -1; float m2 = -3.0e38f;
#pragma unroll
            for (int i = 0; i < 8; ++i) if (i != i1 && le[i] > m2) { m2 = le[i]; i2 = i; }
            const float ex = __expf(m2 - m1); const float w1 = pg / (1.0f + ex), w2 = pg * ex / (1.0f + ex);
            const int tk = t0 + t; const int e1 = gi * 8 + i1, e2 = gi * 8 + i2;
            tokrs[tk] = rs;
            toke[tk * 2] = e1; toke[tk * 2 + 1] = e2; tokw[tk * 2] = w1; tokw[tk * 2 + 1] = w2;
            atomicAdd((int*)(hist + e1), 1); atomicAdd((int*)(hist + e2), 1); }
        __syncthreads();
        if (tid < 32) histg[ch * 32 + tid] = hist[tid];
        __syncthreads();
    }
}

__device__ __forceinline__ void phase_scatter(const Frame& F) {
    const int* histg = (const int*)(F.ws + WS_HIST); const int* toke = (const int*)(F.ws + WS_TOKE); const float* tokw = (const float*)(F.ws + WS_TOKW);
    int* totg = (int*)(F.ws + WS_TOT); int* tokslot = (int*)(F.ws + WS_TOKSLOT); float* slotw = (float*)(F.ws + WS_SLOTW); const float* tokrs = (const float*)(F.ws + WS_TOKRS);
    const f16* h3 = (const f16*)(F.ws + WS_H); f16* xs = (f16*)(F.ws + WS_XS);
    LAS int* ps = (LAS int*)F.lds;
    LAS int* tot = ps + 1024;
    LAS int* bas = ps + 1056;
    LAS int* sl = ps + 1088;
    const int tid = F.tid, lane = F_LANE;
    for (int ch = F.c; ch < SEQ / 32; ch += F.G) {
        { const int e = tid & 31, part = tid >> 5; int s = 0, b = 0;
#pragma unroll
          for (int q = 0; q < 16; ++q) { const int cq = part * 16 + q; const int h = histg[cq * 32 + e]; s += h; b += (cq < ch) ? h : 0; }
          ps[part * 32 + e] = s; ps[512 + part * 32 + e] = b; }
        __syncthreads();
        if (tid < 32) { int s = 0, b = 0;
#pragma unroll
            for (int p = 0; p < 16; ++p) { s += ps[p * 32 + tid]; b += ps[512 + p * 32 + tid]; }
            tot[tid] = s; bas[tid] = b; }
        __syncthreads();
        if (tid < 32) { int pst = 0; for (int e = 0; e < tid; ++e) pst += (tot[e] + 127) >> 7; pst <<= 7;
            bas[tid] = pst + bas[tid];
            if (ch == 0) totg[tid] = tot[tid]; }
        __syncthreads();
        if (ch < 32) { int pst = 0; for (int e = 0; e < ch; ++e) pst += (tot[e] + 127) >> 7; pst <<= 7; const int n = tot[ch]; const int end = pst + (((n + 127) >> 7) << 7);
            for (int s = pst + n + tid; s < end; s += 512) slotw[s] = 0.f; }
        if (F.wave == 0) { const int a = lane; const int tok = ch * 32 + (a >> 1); const int e = toke[tok * 2 + (a & 1)]; const float wv = tokw[tok * 2 + (a & 1)];
            int rank = 0;
            for (int ee = 0; ee < 32; ++ee) { const unsigned long long mk = __ballot(e == ee); if (e == ee) rank = __popcll(mk & ((1ull << lane) - 1ull)); }
            const int slot = bas[e] + rank; sl[a] = slot; slotw[slot] = wv; tokslot[tok * 2 + (a & 1)] = slot; }
        __syncthreads();
#pragma unroll
        for (int r = 0; r < 8; ++r) { const int a = F.wave * 8 + r; const int tok = ch * 32 + (a >> 1); const int slot = sl[a]; const float rs = tokrs[tok];
            const u32x4* src = (const u32x4*)(h3 + (size_t)tok * D); u32x4* dst = (u32x4*)(xs + (size_t)slot * D);
#pragma unroll
            for (int j = 0; j < 4; ++j) { const u32x4 v = src[lane + 64 * j]; u32x4 o;
                { const f32x2 q = unpk2h(v.x); o.x = pk2h(q[0] * rs, q[1] * rs); } { const f32x2 q = unpk2h(v.y); o.y = pk2h(q[0] * rs, q[1] * rs); }
                { const f32x2 q = unpk2h(v.z); o.z = pk2h(q[0] * rs, q[1] * rs); } { const f32x2 q = unpk2h(v.w); o.w = pk2h(q[0] * rs, q[1] * rs); }
                dst[lane + 64 * j] = o; } }
        __syncthreads();
    }
}
__device__ __forceinline__ void moe_table(const Frame& F) {
    const int* totg = (const int*)(F.ws + WS_TOT); LAS int* tab = (LAS int*)(F.lds + TAB_OFF);
    __syncthreads();
    if (F.tid == 0) { int NF = 0, NH = 0, row = 0;
        for (int e = 0; e < NE; ++e) { const int n128 = (totg[e] + 127) >> 7; NF += n128 >> 1; NH += n128 & 1; }
        int jf = 0, jh = NF;
        for (int e = 0; e < NE; ++e) { const int n128 = (totg[e] + 127) >> 7; const int nf = n128 >> 1;
            for (int q = 0; q < nf; ++q) tab[2 + jf++] = e | ((row / 128 + 2 * q) << 8);
            if (n128 & 1) tab[2 + jh++] = e | ((row / 128 + 2 * nf) << 8);
            row += n128 * 128; }
        tab[0] = NF; tab[1] = NH; }
    __syncthreads();
}

__device__ __forceinline__ void rowfac_y(const Frame& F, int pm) {
    const float* ssq = (const float*)(F.ws + WS_SSQY); LAS f32x2* fac = (LAS f32x2*)(F.lds + TAB_OFF);
    __syncthreads();
    if (F.tid < 256) { const f32x4* p = (const f32x4*)(ssq + (size_t)(pm * 256 + F.tid) * 32); float sa = 0.f, sb = 0.f;
#pragma unroll
        for (int q = 0; q < 4; ++q) { const f32x4 a = p[q], b = p[4 + q]; sa += (a[0] + a[1]) + (a[2] + a[3]); sb += (b[0] + b[1]) + (b[2] + b[3]); }
        const float ra = rsqrtf(sa * (1.0f / 1024.f) + EPS), rb = rsqrtf(sb * (1.0f / 1024.f) + EPS);
        fac[F.tid] = (f32x2){ra / rb, rb}; }
    __syncthreads();
}
__device__ __forceinline__ void rowfac_x(const Frame& F, int pm) {
    const float* ssq = (const float*)(F.ws + WS_SSQX); LAS float* fac = (LAS float*)(F.lds + TAB_OFF);
    __syncthreads();
    if (F.tid < 256) { const f32x4* p = (const f32x4*)(ssq + (size_t)(pm * 256 + F.tid) * 32); float s = 0.f;
#pragma unroll
        for (int q = 0; q < 8; ++q) { const f32x4 a = p[q]; s += (a[0] + a[1]) + (a[2] + a[3]); }
        fac[F.tid] = rsqrtf(s * (1.0f / D) + EPS); }
    __syncthreads();
}

__device__ __forceinline__ void phase_final(const Frame& F, const Args& A, float* out) {
    const f16* x2h = (const f16*)(F.ws + WS_X2H);
    const int* tokslot = (const int*)(F.ws + WS_TOKSLOT); const f16* ys = (const f16*)(F.ws + WS_YS); const float* g = A.in[27];
    const int gw = F.c * 8 + F.wave, NGW = F.G * 8, lane = F_LANE;
    for (int m = gw; m < SEQ; m += NGW) {
        const int s0 = tokslot[m * 2], s1 = tokslot[m * 2 + 1];
        f32x4 v[8]; float s = 0.f;
#pragma unroll
        for (int j = 0; j < 4; ++j) { const int col = 8 * (lane + 64 * j); const u32x4 xv = *(const u32x4*)(x2h + (size_t)m * D + col);
            const u32x4 y0 = *(const u32x4*)(ys + (size_t)s0 * D + col), y1 = *(const u32x4*)(ys + (size_t)s1 * D + col);
            f32x4 a, b; { const f32x2 e0 = unpk2h(xv.x), e1 = unpk2h(xv.y), e2 = unpk2h(xv.z), e3 = unpk2h(xv.w); a = (f32x4){e0[0], e0[1], e1[0], e1[1]}; b = (f32x4){e2[0], e2[1], e3[0], e3[1]}; }
            { const f32x2 q0 = unpk2h(y0.x), q1 = unpk2h(y1.x); a[0] += q0[0] + q1[0]; a[1] += q0[1] + q1[1]; }
            { const f32x2 q0 = unpk2h(y0.y), q1 = unpk2h(y1.y); a[2] += q0[0] + q1[0]; a[3] += q0[1] + q1[1]; }
            { const f32x2 q0 = unpk2h(y0.z), q1 = unpk2h(y1.z); b[0] += q0[0] + q1[0]; b[1] += q0[1] + q1[1]; }
            { const f32x2 q0 = unpk2h(y0.w), q1 = unpk2h(y1.w); b[2] += q0[0] + q1[0]; b[3] += q0[1] + q1[1]; }
            v[2 * j] = a; v[2 * j + 1] = b;
            s += a[0] * a[0] + a[1] * a[1] + a[2] * a[2] + a[3] * a[3] + b[0] * b[0] + b[1] * b[1] + b[2] * b[2] + b[3] * b[3]; }
        const float rs = rsqrtf(wave_sum(s) * (1.0f / D) + EPS);
#pragma unroll
        for (int j = 0; j < 4; ++j) { const int col = 8 * (lane + 64 * j); f32x4* p = (f32x4*)(out + (size_t)m * D + col);
            p[0] = v[2 * j] * rs * *(const f32x4*)(g + col); p[1] = v[2 * j + 1] * rs * *(const f32x4*)(g + col + 4); }
    }
}

#if FAST_GEMM
#define RUN_GEMM(EpiT, SchedT, lda, ldb, S, E) pg8::gemm_phase<EpiT, SchedT, !EpiT::AFTER_DRAIN, true>(F.lds, lda, ldb, (size_t)128, S, E)
#define RUN_GEMM_KT(EpiT, SchedT, lda, S, E) pg8::gemm_phase<EpiT, SchedT, !EpiT::AFTER_DRAIN, true>(F.lds, lda, 64, (size_t)32768, S, E)
#else
#define RUN_GEMM(EpiT, SchedT, lda, ldb, S, E) pg8::gemm_phase_simple<EpiT, SchedT>(F.lds, lda, ldb, S, E)
#endif

__global__ void __launch_bounds__(512, 2) fwd(Args args) {
    extern __shared__ __attribute__((aligned(16))) unsigned char lds_raw[];
    Frame F;
    F.lds = (LAS unsigned char*)lds_raw; F.ws = args.ws;
    F.tid = threadIdx.x; F.wave = __builtin_amdgcn_readfirstlane(F.tid >> 6);
    F.G = gridDim.x; F.c = blockIdx.x;
    volatile LAS unsigned* MISC = (volatile LAS unsigned*)(F.lds + MISC_OFF);
    if (F.tid < 64) MISC[F.tid] = 0u;
    __syncthreads();
    XcdBarrier bar; bar.bar = (unsigned*)(args.ws + WS_CTL) + CW_BAR; bar.x = 0; bar.st = nullptr;
    if (MK_N_LAUNCHES == 1) bar = xcd_barrier_post((unsigned*)(args.ws + WS_CTL) + CW_BAR, MISC + 8);
    const int lo = args.ph_lo, hi = args.ph_hi;
    volatile LAS unsigned* TS = (volatile LAS unsigned*)(F.lds + TAB_OFF + 2048);
#ifndef ONLY_PHASE
#define ONLY_PHASE -1
#endif
#define IN(k) ((ONLY_PHASE < 0 || (k) == ONLY_PHASE) && lo <= (k) && (k) < hi)
#ifndef REP_PHASE
#define REP_PHASE -1
#endif
#ifndef REP_N
#define REP_N 1
#endif
#define REPS(k) _Pragma("unroll 1") for (int rep_ = 0; rep_ < (((k) == REP_PHASE) ? args.pad : 1); ++rep_)
#ifndef PROF_PHASE
#define PROF_PHASE -1
#endif
#ifndef PROF_MULT
#define PROF_MULT 4
#endif
#define STAMP(k) do { if (PROF_PHASE >= 0 && F.c == 0 && F.tid == 0) { const unsigned long long t_ = __builtin_amdgcn_s_memrealtime(); TS[2 * (k)] = (unsigned)t_; TS[2 * (k) + 1] = (unsigned)(t_ >> 32); } } while (0)
#define SEAM(k) do { if (IN(k) && IN((k) + 1)) xcd_barrier(bar); STAMP((k) + 1); } while (0)
    unsigned char* ws = args.ws; float* out = args.out;
    const char* wsc = (const char*)ws;

    STAMP(0);
    if (IN(0)) REPS(0) { phase_prep(F, args); } SEAM(0);
    if (IN(1)) REPS(1) { SchedP1 S{F.G, F.c, (char*)ws};
        EpiF16 E{nullptr, 1.0f};
        RUN_GEMM(EpiF16, SchedP1, D, D, S, E); tr_idle(F, args, 1); } SEAM(1);
#ifndef DUP2
#define DUP2 0
#endif
    if (IN(2)) { phase_mixpre(F, args); tr_drain(F, args, SEG_B); } SEAM(2);
    if (IN(3)) REPS(3) { SchedG2 S{F.G, F.c, wsc + WS_DC, wsc + WS_WPW, wsc + WS_WPOOL, (char*)(ws + WS_Y)};
        EpiF16 E{args.in[5], 1.0f, (float*)(ws + WS_SSQY), nullptr};
        RUN_GEMM(EpiF16, SchedG2, D, 1024, S, E); } SEAM(3); STAMP(5);
    if (IN(5)) REPS(5) { int pm, pn; pg8::tile_of(F.c, 32, 8, pm, pn); rowfac_y(F, pm);
        SchedG3 S{F.G, F.c, wsc + WS_Y, wsc + WS_WOUT}; EpiG3 E{args.in[0], out, (f16*)(ws + WS_H), (float*)(ws + WS_SSQX), (const LAS f32x2*)(F.lds + TAB_OFF)};
        RUN_GEMM(EpiG3, SchedG3, D, D, S, E); } SEAM(5); STAMP(7);
    if (IN(7)) REPS(7) { int pm, pn; pg8::tile_of(F.c, 32, 8, pm, pn); rowfac_x(F, pm);
        SchedDense S{F.G, F.c, wsc + WS_H, wsc + WS_WQ, (char*)(ws + WS_Q)};
        EpiF16 E{nullptr, 0.044194173824159216f, nullptr, (const LAS float*)(F.lds + TAB_OFF)};
        RUN_GEMM(EpiF16, SchedDense, D, D, S, E); } SEAM(7);
    if (IN(8)) REPS(8) { { SchedS S{F.G, F.c, wsc + WS_Q, wsc + WS_K16}; EpiSoftmax E{(f16*)(ws + WS_P)};
          RUN_GEMM(EpiSoftmax, SchedS, D, D, S, E); }
        VM_WAIT(); __syncthreads();
        { SchedPV S{F.G, F.c, wsc + WS_P, wsc + WS_VT16, (char*)(ws + WS_O)};
          EpiF16 E{nullptr, 1.0f};
          RUN_GEMM(EpiF16, SchedPV, 256, 256, S, E); } }
    if (IN(8) && IN(10)) { xcd_barrier(bar); STAMP(9); STAMP(10); }
    if (IN(10)) REPS(10) { SchedDense S{F.G, F.c, wsc + WS_O, wsc + WS_WO, nullptr}; EpiResH E{(const f16*)(ws + WS_H), (f16*)(ws + WS_X2H), D};
        RUN_GEMM(EpiResH, SchedDense, D, D, S, E); } SEAM(10);
    if (IN(11)) REPS(11) { phase_router(F, args, (const f16*)(ws + WS_X2H)); } SEAM(11);
    if (IN(12)) REPS(12) { phase_scatter(F); tr_drain(F, args, NITEMS); } SEAM(12);
    if (IN(13)) { moe_table(F); const LAS int* tab = (const LAS int*)(F.lds + TAB_OFF);
        { SchedGU S{F.G, F.c, 0, wsc + WS_XS, wsc + WS_WGU, tab}; EpiSwiGLU E{(f16*)(ws + WS_HID)}; RUN_GEMM_KT(EpiSwiGLU, SchedGU, D, S, E); }
        xcd_barrier(bar); STAMP(14);
        { SchedGU S{F.G, F.c, 1, wsc + WS_XS, wsc + WS_WGU, tab}; EpiSwiGLU E{(f16*)(ws + WS_HID)}; RUN_GEMM_KT(EpiSwiGLU, SchedGU, D, S, E); }
        { SchedDN S{F.G, F.c, 0, wsc + WS_HID, wsc + WS_WDN, tab}; EpiDown E{(f16*)(ws + WS_YS), (const float*)(ws + WS_SLOTW)}; RUN_GEMM_KT(EpiDown, SchedDN, DE, S, E); }
        xcd_barrier(bar); STAMP(15);
        { SchedDN S{F.G, F.c, 1, wsc + WS_HID, wsc + WS_WDN, tab}; EpiDown E{(f16*)(ws + WS_YS), (const float*)(ws + WS_SLOTW)}; RUN_GEMM_KT(EpiDown, SchedDN, DE, S, E); }
        xcd_barrier(bar); STAMP(16); }
    if (IN(15)) REPS(15) { phase_final(F, args, out); }
    if (PROF_PHASE >= 0 && F.c == 0 && F.tid == 0 && lo == 0) {
        STAMP(17);
        const unsigned long long t0 = ((unsigned long long)TS[2 * PROF_PHASE + 1] << 32) | TS[2 * PROF_PHASE], t1 = ((unsigned long long)TS[2 * PROF_PHASE + 3] << 32) | TS[2 * PROF_PHASE + 2];
        const unsigned long long until = __builtin_amdgcn_s_memrealtime() + (unsigned long long)PROF_MULT * (t1 - t0);
        while (__builtin_amdgcn_s_memrealtime() < until) __builtin_amdgcn_s_sleep(8);
    }
#undef IN
#undef SEAM
}

extern "C" void kernel_launch(void* const* d_in, const int* in_sizes, int n_in, void* d_out, int out_size, void* d_ws, size_t ws_size, hipStream_t stream) {
    static int grid = 0;
    if (grid == 0) {
        if (n_in != 28 || out_size != SEQ * D || ws_size < WS_END) { fprintf(stderr, "kernel_launch: unexpected sizes n_in %d out %d ws %zu\n", n_in, out_size, ws_size); grid = -1; return; }
        int dev = 0, cus = 0;
        if (hipGetDevice(&dev) != hipSuccess || hipDeviceGetAttribute(&cus, hipDeviceAttributeMultiprocessorCount, dev) != hipSuccess) { grid = -1; return; }
        if (hipFuncSetAttribute((const void*)fwd, hipFuncAttributeMaxDynamicSharedMemorySize, LDS_BYTES) != hipSuccess) { grid = -1; return; }
        int per_cu = 0;
        (void)hipOccupancyMaxActiveBlocksPerMultiprocessor(&per_cu, (const void*)fwd, 512, LDS_BYTES);
        (void)hipGetLastError();
        grid = cus;
    }
    if (grid < 0) return;
    (void)hipMemsetAsync((char*)d_ws + WS_CTL, 0, CTL_ZERO_BYTES, stream);
    Args a{};
    for (int i = 0; i < 28; ++i) a.in[i] = (const float*)d_in[i];
    a.out = (float*)d_out; a.ws = (unsigned char*)d_ws; a.pad = REP_N;
    if (MK_N_LAUNCHES == 1) { a.ph_lo = 0; a.ph_hi = NPHASE; a.li = 0; hipLaunchKernelGGL(fwd, dim3(grid), dim3(512), LDS_BYTES, stream, a);
#if EXTRA_PHASE >= 0
        for (int r = 0; r < EXTRA_N; ++r) { a.ph_lo = EXTRA_PHASE; a.ph_hi = EXTRA_PHASE + 1; a.li = 1 + r;
#if EXTRA_REQUEUE
            { static const unsigned hv = SEG_B; (void)hipMemsetAsync((char*)d_ws + WS_CTL + (CW_ARRIVE + 64 * EXTRA_PHASE) * 4, 0, 4, stream);
              (void)hipMemsetD32Async((hipDeviceptr_t)((char*)d_ws + WS_CTL + CW_QHEAD * 4), (int)hv, 1, stream); }
#endif
            hipLaunchKernelGGL(fwd, dim3(grid), dim3(512), LDS_BYTES, stream, a); }
#endif
    }
    else { for (int p = 0; p < NPHASE; ++p) { a.ph_lo = p; a.ph_hi = p + 1; a.li = p; hipLaunchKernelGGL(fwd, dim3(grid), dim3(512), LDS_BYTES, stream, a); } }
}
```

```cpp
#include <hip/hip_runtime.h>
#include <cstdio>
#include <cstdint>

#ifndef MK_N_LAUNCHES
#define MK_N_LAUNCHES 1
#endif
#ifndef EXTRA_PHASE
#define EXTRA_PHASE -1
#endif
#ifndef EXTRA_REQUEUE
#define EXTRA_REQUEUE 0
#endif
#ifndef EXTRA_N
#define EXTRA_N 2
#endif
#ifndef FAST_GEMM
#define FAST_GEMM 1
#endif

#define LAS __attribute__((address_space(3)))
#define GAS __attribute__((address_space(1)))
typedef _Float16 f16;
typedef _Float16 f16x8 __attribute__((ext_vector_type(8)));
typedef _Float16 f16x2 __attribute__((ext_vector_type(2)));
typedef float f32x4 __attribute__((ext_vector_type(4)));
typedef float f32x2 __attribute__((ext_vector_type(2)));
typedef unsigned u32x4 __attribute__((ext_vector_type(4)));
typedef unsigned u32x2 __attribute__((ext_vector_type(2)));

constexpr int SEQ = 8192, D = 2048, NPROJ = 3072, MEMLEN = 256, NHEAD = 4, HD = 512, NE = 32, DE = 512, CK = 31;
constexpr float EPS = 1e-6f;
constexpr int NPHASE = 16;

constexpr size_t MiB = 1u << 20;
constexpr size_t WS_CTL = 0, CTL_ZERO_BYTES = 65536;
constexpr size_t WS_HIST = 65536;
constexpr size_t WS_TOT = 98304;
constexpr size_t WS_TOKE = 131072;
constexpr size_t WS_TOKW = 196608;
constexpr size_t WS_TOKSLOT = 262144;
constexpr size_t WS_SLOTW = 327680;
constexpr size_t WS_TOKRS = 458752;
constexpr size_t WS_SLOTTOK = 524288;
constexpr size_t WS_SLOTRS = 655360;
constexpr size_t WS_M16 = 1 * MiB, WS_K16 = 2 * MiB, WS_VT16 = 3 * MiB;
constexpr size_t WS_SSQY = 4 * MiB, WS_SSQX = 5 * MiB;
constexpr size_t WS_WIN = 8 * MiB, WS_WPOOL = 20 * MiB, WS_WPW = 22 * MiB, WS_WOUT = 24 * MiB, WS_WQ = 32 * MiB, WS_WKV = 40 * MiB, WS_WO = 56 * MiB,
                 WS_WGU = 64 * MiB, WS_WDN = 192 * MiB;
constexpr size_t WS_PROJ = 256 * MiB, WS_DC = 304 * MiB, WS_XS = 256 * MiB;
constexpr size_t WS_H = 352 * MiB, WS_Y = 384 * MiB, WS_YN = 416 * MiB, WS_YS = 256 * MiB;
constexpr size_t WS_Q = 448 * MiB, WS_P = 480 * MiB, WS_O = 496 * MiB, WS_HID = 480 * MiB, WS_X2H = 448 * MiB;
constexpr size_t WS_END = 528 * MiB;
constexpr int CW_BAR = 4096;

constexpr int RING_BYTES = 131072;
constexpr int MISC_OFF = RING_BYTES;
constexpr int TAB_OFF = RING_BYTES + 256;
constexpr int LDS_BYTES = 147456;

#define LDS_WAIT() asm volatile("s_waitcnt lgkmcnt(0)" ::: "memory")
#define VM_WAIT() asm volatile("s_waitcnt vmcnt(0)" ::: "memory")

__device__ __forceinline__ unsigned pk2h(float lo, float hi) { f32x2 v = {lo, hi}; f16x2 h = __builtin_convertvector(v, f16x2); return __builtin_bit_cast(unsigned, h); }
__device__ __forceinline__ f32x2 unpk2h(unsigned u) { f16x2 h = __builtin_bit_cast(f16x2, u); return __builtin_convertvector(h, f32x2); }
__device__ __forceinline__ float wave_sum(float v) {
#pragma unroll
    for (int o = 1; o < 64; o <<= 1) v += __shfl_xor(v, o);
    return v;
}
__device__ __forceinline__ float fast_sigmoid(float x) { return __builtin_amdgcn_rcpf(1.0f + __expf(-x)); }

#define XB_TMO      128
#define XB_XCNT(j)  (256  + 64 * (j))
#define XB_XSUB(j)  (1280 + 64 * (j))
#define XB_XGEN(j)  (2304 + 64 * (j))
#define XB_TOP      3328
#define XB_TOPGEN   3392
#define XCD_BAR_WORDS 3456
#define XB_SPIN_CAP (1u << 18)
__device__ __forceinline__ unsigned xb_ld(unsigned* p)              { return __hip_atomic_load(p, __ATOMIC_RELAXED, __HIP_MEMORY_SCOPE_AGENT); }
__device__ __forceinline__ unsigned xb_add(unsigned* p, unsigned v) { return __hip_atomic_fetch_add(p, v, __ATOMIC_RELAXED, __HIP_MEMORY_SCOPE_AGENT); }
__device__ __forceinline__ unsigned xb_xcc_id() { return (unsigned)__builtin_amdgcn_s_getreg((3 << 11) | 20) & 0xFu; }
#define XB_SPIN(cond, bar) do { unsigned _sp = 0; while (cond) { __builtin_amdgcn_s_sleep(1); \
    if ((++_sp & 255u) == 0u) { if (xb_ld(&(bar)[XB_TMO])) break; if (_sp > XB_SPIN_CAP) { atomicAdd(&(bar)[XB_TMO], 1u); break; } } } } while (0)
struct XcdBarrier { unsigned* bar; unsigned x; volatile LAS unsigned* st; };
__device__ __forceinline__ XcdBarrier xcd_barrier_post(unsigned* bar, volatile LAS unsigned* st) {
    XcdBarrier b; b.bar = bar; b.x = xb_xcc_id(); b.st = st;
    if (threadIdx.x == 0) (void)xb_add(&bar[XB_XCNT(b.x)], 1u);
    return b;
}
__device__ __forceinline__ void xcd_barrier_complete(unsigned* bar, unsigned x, unsigned& nloc, unsigned& nx) {
    const unsigned G = gridDim.x * gridDim.y * gridDim.z;
    unsigned sum, cnt, mine, sp = 0u;
    for (;;) {
        sum = 0u; cnt = 0u; mine = 0u;
#pragma unroll
        for (unsigned j = 0; j < 16; ++j) { const unsigned c = xb_ld(&bar[XB_XCNT(j)]); sum += c; cnt += (c > 0u) ? 1u : 0u; mine = (j == x) ? c : mine; }
        if (sum == G) break;
        __builtin_amdgcn_s_sleep(1);
        if ((++sp & 255u) == 0u) { if (xb_ld(&bar[XB_TMO])) break; if (sp > XB_SPIN_CAP) { atomicAdd(&bar[XB_TMO], 1u); break; } }
    }
    nloc = mine > 0u ? mine : 1u; nx = cnt > 0u ? cnt : 1u;
}
__device__ __forceinline__ void xcd_barrier(const XcdBarrier& b) {
    asm volatile("s_waitcnt vmcnt(0)" ::: "memory");
    __syncthreads();
    if (threadIdx.x == 0) {
        unsigned* bar = b.bar;
        __builtin_amdgcn_s_waitcnt(0);
        unsigned nloc = b.st[0], nx = b.st[1];
        if (nloc == 0u) { xcd_barrier_complete(bar, b.x, nloc, nx); b.st[0] = nloc; b.st[1] = nx; }
        const unsigned old = xb_add(&bar[XB_XSUB(b.x)], 1u);
        const unsigned gen = old / nloc;
        if (old + 1u == (gen + 1u) * nloc) {
            __builtin_amdgcn_fence(__ATOMIC_RELEASE, "agent");
            asm volatile("s_waitcnt vmcnt(0)" ::: "memory");
            const unsigned og = xb_add(&bar[XB_TOP], 1u);
            const unsigned tg = og / nx;
            if (og + 1u == (tg + 1u) * nx) xb_add(&bar[XB_TOPGEN], 1u);
            else XB_SPIN(xb_ld(&bar[XB_TOPGEN]) == tg, bar);
            __builtin_amdgcn_fence(__ATOMIC_ACQUIRE, "agent");
            xb_add(&bar[XB_XGEN(b.x)], 1u);
            asm volatile("s_waitcnt vmcnt(0)" ::: "memory");
        } else {
            XB_SPIN(xb_ld(&bar[XB_XGEN(b.x)]) == gen, bar);
            __builtin_amdgcn_fence(__ATOMIC_ACQUIRE, "agent");
            asm volatile("s_waitcnt vmcnt(0)" ::: "memory");
        }
    }
    __syncthreads();
}

namespace pg8 {
constexpr int BM = 256, BK = 64, HALF = 128, HTB = HALF * BK * 2, STAGE_BYTES = 8 * HTB, NXCD = 8, WGM = 8;
__host__ __device__ __forceinline__ int lds_byte(int r, int c) { const int st = (r >> 4) * 2 + (c >> 5), rr = r & 15, cc = c & 31, ob = rr * 64 + cc * 2; return st * 1024 + (ob ^ (((ob >> 9) & 1) << 5)); }
__host__ __device__ __forceinline__ void stage_rc(int b, int& R, int& C) { const int st = b / 1024, sb = b % 1024, swz = sb ^ (((sb >> 9) & 1) << 5); R = (st >> 1) * 16 + swz / 64; C = (st & 1) * 32 + (swz % 64) / 2; }
__host__ __device__ __forceinline__ int perm32(int rho) { const int n = rho >> 4, i = rho & 15; return 8 * (i >> 2) + 4 * n + (i & 3); }

struct Unit { const char* a; const char* b; char* o; const int* rowtab; int ldc; int nt; int r0, c0, kind, aux, half; };

__device__ __forceinline__ void tile_of(int L, int nM, int nN, int& pm, int& pn) {
    const int nwg = nM * nN; int wgid = L;
    { const int q = nwg / NXCD, r = nwg % NXCD, xcd = wgid % NXCD, off = wgid / NXCD; wgid = (xcd < r ? xcd * (q + 1) : r * (q + 1) + (xcd - r) * q) + off; }
    const int nig = WGM * nN, gid = wgid / nig, fm = gid * WGM, gsz = (nM - fm) < WGM ? (nM - fm) : WGM;
    pm = fm + ((wgid % nig) % gsz); pn = (wgid % nig) / gsz;
}
__device__ __forceinline__ void tile_of_w(int wgid, int nM, int nN, int& pm, int& pn) {
    const int nig = WGM * nN, gid = wgid / nig, fm = gid * WGM, gsz = (nM - fm) < WGM ? (nM - fm) : WGM;
    pm = fm + ((wgid % nig) % gsz); pn = (wgid % nig) / gsz;
}
__device__ __forceinline__ int xcd_chunk(int L, int nwg) {
    const int q = nwg / NXCD, r = nwg % NXCD, xcd = L % NXCD, off = L / NXCD; return (xcd < r ? xcd * (q + 1) : r * (q + 1) + (xcd - r) * q) + off;
}

typedef f32x4 Acc[2][2][4][2];

template <class Epi, class Sched>
__device__ __forceinline__ void gemm_phase_simple(LAS unsigned char* lds, int lda, int ldb, const Sched& S, const Epi& E) {
    const int tid = threadIdx.x, wid = __builtin_amdgcn_readfirstlane(tid >> 6), lane = tid & 63, wr = wid >> 2, wc = wid & 3, fr = lane & 15, fq = lane >> 4;
    Unit u;
    for (int ui = 0; S.next(ui, u); ++ui) {
        Acc acc;
#pragma unroll
        for (int a = 0; a < 2; ++a)
#pragma unroll
            for (int b = 0; b < 2; ++b)
#pragma unroll
                for (int m = 0; m < 4; ++m)
#pragma unroll
                    for (int n = 0; n < 2; ++n) acc[a][b][m][n] = (f32x4){0.f, 0.f, 0.f, 0.f};
        for (int ks = 0; ks < u.nt * 2; ++ks) {
            f16x8 Af[2][4], Bf[2][2];
            const size_t kb = (size_t)(ks * 32 + fq * 8) * 2;
#pragma unroll
            for (int ai = 0; ai < 2; ++ai)
#pragma unroll
                for (int m = 0; m < 4; ++m) Af[ai][m] = *(const f16x8*)(u.a + (size_t)(ai * 128 + wr * 64 + m * 16 + fr) * lda * 2 + kb);
#pragma unroll
            for (int bj = 0; bj < 2; ++bj)
#pragma unroll
                for (int n = 0; n < 2; ++n) { const int rr = Epi::PERM ? (8 * (fr >> 2) + 4 * n + (fr & 3)) : (n * 16 + fr);
                    Bf[bj][n] = *(const f16x8*)(u.b + (size_t)(bj * 128 + wc * 32 + rr) * ldb * 2 + kb); }
#pragma unroll
            for (int ai = 0; ai < 2; ++ai)
#pragma unroll
                for (int bj = 0; bj < 2; ++bj)
#pragma unroll
                    for (int m = 0; m < 4; ++m)
#pragma unroll
                        for (int n = 0; n < 2; ++n) acc[ai][bj][m][n] = __builtin_amdgcn_mfma_f32_16x16x32_f16(Bf[bj][n], Af[ai][m], acc[ai][bj][m][n], 0, 0, 0);
        }
        if constexpr (Epi::AFTER_DRAIN) { __syncthreads(); E.fused(acc, u, wr, wc, fr, fq, lds, wid, lane); __syncthreads(); }
        else E(acc, u, wr, wc, fr, fq);
    }
}
#define PG8_LAS LAS
template <class Epi, class Sched, bool ALIGN_EPI = false, bool SP2 = false, bool GATHER = false>
__device__ __forceinline__ void gemm_phase(PG8_LAS unsigned char* lds, const int lda, const int ldb, const size_t kstepB, const Sched& S, const Epi& E) {
    const int tid = threadIdx.x, wid = __builtin_amdgcn_readfirstlane(tid >> 6), lane = tid & 63, wr = wid >> 2, wc = wid & 3, fr = lane & 15, fq = lane >> 4;
    unsigned voffA[2], voffB[2]; int rowA[2];
#pragma unroll
    for (int i = 0; i < 2; ++i) { int R, C; stage_rc(tid * 16 + i * 8192, R, C); const int Rb = Epi::PERM ? ((R & ~31) + perm32(R & 31)) : R;
        voffA[i] = (unsigned)(GATHER ? C : (R * lda + C)) * 2u; voffB[i] = (unsigned)(Rb * ldb + C) * 2u; rowA[i] = R; }
    static_assert(!GATHER || SP2, "GATHER is written for the SP2 loop");
    unsigned vc0[2] = {0u, 0u}, vc1[2] = {0u, 0u}, vn0[2] = {0u, 0u}, vn1[2] = {0u, 0u};
#define PG8_GOFF(U, V0, V1) do { _Pragma("unroll") for (int _i = 0; _i < 2; ++_i) { V0[_i] = (unsigned)(U).rowtab[rowA[_i]] * (unsigned)(lda * 2) + voffA[_i]; V1[_i] = (unsigned)(U).rowtab[rowA[_i] + 128] * (unsigned)(lda * 2) + voffA[_i]; } } while (0)
    const size_t kstep = (size_t)(BK * 2);
    const size_t hstepA = (size_t)HALF * lda * 2, hstepB = (size_t)HALF * ldb * 2;
    const unsigned ldsw = (unsigned)wid * 1024u;
    const int aoff = lds_byte(wr * 64 + fr, fq * 8), boff = lds_byte(wc * 32 + fr, fq * 8);
#define PG8_SA(b, h) (((b) * 2 + (h)) * HTB)
#define PG8_SB(b, h) ((4 + (b) * 2 + (h)) * HTB)
#define PG8_STAGE(bufoff, gbase, voff) do { _Pragma("unroll") for (int _i = 0; _i < 2; ++_i) \
        __builtin_amdgcn_global_load_lds((const unsigned*)((const char*)(gbase) + (voff)[_i]), (PG8_LAS unsigned*)(lds + (bufoff) + ldsw + _i * 8192), 16, 0, 0); } while (0)
#define PG8_LDA(dst, b, h) do { _Pragma("unroll") for (int m = 0; m < 4; ++m) _Pragma("unroll") for (int k = 0; k < 2; ++k) dst[m][k] = *(const PG8_LAS f16x8*)(lds + PG8_SA(b, h) + aoff + m * 2048 + k * 1024); } while (0)
#define PG8_LDB(dst, b, h) do { _Pragma("unroll") for (int n = 0; n < 2; ++n) _Pragma("unroll") for (int k = 0; k < 2; ++k) dst[n][k] = *(const PG8_LAS f16x8*)(lds + PG8_SB(b, h) + boff + n * 2048 + k * 1024); } while (0)
#define PG8_MMA(ai, bj, At, Bt) do { __builtin_amdgcn_s_setprio(1); _Pragma("unroll") for (int m = 0; m < 4; ++m) _Pragma("unroll") for (int n = 0; n < 2; ++n) _Pragma("unroll") for (int k = 0; k < 2; ++k) \
        acc[ai][bj][m][n] = __builtin_amdgcn_mfma_f32_16x16x32_f16(Bt[n][k], At[m][k], acc[ai][bj][m][n], 0, 0, 0); __builtin_amdgcn_s_setprio(0); } while (0)
#define PG8_WAIT_V(n) asm volatile("s_waitcnt vmcnt(" #n ")" ::: "memory")
#define PG8_WAIT_L(n) asm volatile("s_waitcnt lgkmcnt(" #n ")" ::: "memory")
#define PG8_BAR __builtin_amdgcn_s_barrier()
#define PG8_SCHED __builtin_amdgcn_sched_barrier(0)
    Unit cur, nxt; int ui = 0;
    if (!S.next(0, cur)) return;
    f32x4 acc[2][2][4][2];
#pragma unroll
    for (int a = 0; a < 2; ++a)
#pragma unroll
        for (int b = 0; b < 2; ++b)
#pragma unroll
            for (int m = 0; m < 4; ++m)
#pragma unroll
                for (int n = 0; n < 2; ++n) acc[a][b][m][n] = (f32x4){0.f, 0.f, 0.f, 0.f};
    f16x8 At[4][2], B0[2][2], B1[2][2];
    const char* cA = cur.a; const char* cB = cur.b;
    if constexpr (SP2) {
        if constexpr (GATHER) { PG8_GOFF(cur, vc0, vc1);
            PG8_STAGE(PG8_SB(0, 0), cB, voffB); PG8_STAGE(PG8_SB(0, 1), cB + hstepB, voffB); PG8_STAGE(PG8_SA(0, 0), cA, vc0); PG8_STAGE(PG8_SA(0, 1), cA, vc1);
        } else {
        PG8_STAGE(PG8_SB(0, 0), cB, voffB); PG8_STAGE(PG8_SB(0, 1), cB + hstepB, voffB); PG8_STAGE(PG8_SA(0, 0), cA, voffA); PG8_STAGE(PG8_SA(0, 1), cA + hstepA, voffA); }
        if (wr == 1) PG8_BAR;
        PG8_WAIT_V(2); PG8_BAR;
        if constexpr (GATHER) { PG8_STAGE(PG8_SB(1, 0), cB + kstepB, voffB); PG8_STAGE(PG8_SA(1, 0), cA + kstep, vc0); PG8_STAGE(PG8_SB(1, 1), cB + hstepB + kstepB, voffB); } else {
        PG8_STAGE(PG8_SB(1, 0), cB + kstepB, voffB); PG8_STAGE(PG8_SA(1, 0), cA + kstep, voffA); PG8_STAGE(PG8_SB(1, 1), cB + hstepB + kstepB, voffB); }
        PG8_WAIT_V(6); PG8_BAR;
    } else {
        PG8_STAGE(PG8_SB(0, 0), cB, voffB); PG8_STAGE(PG8_SA(0, 0), cA, voffA); PG8_STAGE(PG8_SB(0, 1), cB + hstepB, voffB); PG8_STAGE(PG8_SA(0, 1), cA + hstepA, voffA);
        if (wr == 1) PG8_BAR;
        PG8_WAIT_V(4); PG8_BAR;
        PG8_STAGE(PG8_SB(1, 0), cB + kstepB, voffB); PG8_STAGE(PG8_SA(1, 0), cA + kstep, voffA); PG8_STAGE(PG8_SB(1, 1), cB + hstepB + kstepB, voffB);
        PG8_WAIT_V(6); PG8_BAR;
    }
    for (;;) {
        const bool has_next = S.next(ui + 1, nxt);
        const char* nA = has_next ? nxt.a : cA; const char* nB = has_next ? nxt.b : cB; int nt = __builtin_amdgcn_readfirstlane(cur.nt); asm volatile("" : "+s"(nt)); int fullu = __builtin_amdgcn_readfirstlane(cur.half ? 0 : 1); asm volatile("" : "+s"(fullu));
        if constexpr (GATHER) { if (has_next) PG8_GOFF(nxt, vn0, vn1); else { vn0[0] = vc0[0]; vn0[1] = vc0[1]; vn1[0] = vc1[0]; vn1[1] = vc1[1]; } }
#pragma unroll 1
        for (int t = 0; t < nt; t += 2) {
            const bool last = (t == nt - 2);
            const char* a1 = cA + (size_t)(t + 1) * kstep;
            const char* a2 = last ? nA : cA + (size_t)(t + 2) * kstep; const char* b2 = last ? nB : cB + (size_t)(t + 2) * kstepB;
            const char* a3 = a2 + kstep; const char* b3 = b2 + kstepB;
            if constexpr (SP2) {
            unsigned s0[2], s1[2]; if constexpr (GATHER) { s0[0] = last ? vn0[0] : vc0[0]; s0[1] = last ? vn0[1] : vc0[1]; s1[0] = last ? vn1[0] : vc1[0]; s1[1] = last ? vn1[1] : vc1[1]; }
            PG8_LDB(B0, 0, 0); PG8_LDB(B1, 0, 1); PG8_SCHED; PG8_LDA(At, 0, 0); if constexpr (GATHER) PG8_STAGE(PG8_SA(1, 1), a1, vc1); else PG8_STAGE(PG8_SA(1, 1), a1 + hstepA, voffA);
            PG8_WAIT_V(8); PG8_WAIT_L(0); PG8_BAR; PG8_MMA(0, 0, At, B0); PG8_MMA(0, 1, At, B1); PG8_BAR; PG8_SCHED;
            PG8_LDA(At, 0, 1); PG8_STAGE(PG8_SB(0, 0), b2, voffB); PG8_STAGE(PG8_SB(0, 1), b2 + hstepB, voffB); if constexpr (GATHER) PG8_STAGE(PG8_SA(0, 0), a2, s0); else PG8_STAGE(PG8_SA(0, 0), a2, voffA);
            PG8_WAIT_V(8); PG8_WAIT_L(0); PG8_BAR; if (fullu) { PG8_MMA(1, 0, At, B0); PG8_MMA(1, 1, At, B1); } PG8_BAR; PG8_SCHED;
            PG8_LDB(B0, 1, 0); PG8_LDB(B1, 1, 1); PG8_SCHED; PG8_LDA(At, 1, 0); if constexpr (GATHER) PG8_STAGE(PG8_SA(0, 1), a2, s1); else PG8_STAGE(PG8_SA(0, 1), a2 + hstepA, voffA);
            PG8_WAIT_V(8); PG8_WAIT_L(0); PG8_BAR; PG8_MMA(0, 0, At, B0); PG8_MMA(0, 1, At, B1); PG8_BAR; PG8_SCHED;
            PG8_LDA(At, 1, 1); PG8_STAGE(PG8_SB(1, 0), b3, voffB); PG8_STAGE(PG8_SB(1, 1), b3 + hstepB, voffB); if constexpr (GATHER) PG8_STAGE(PG8_SA(1, 0), a3, s0); else PG8_STAGE(PG8_SA(1, 0), a3, voffA);
            PG8_WAIT_V(8); PG8_WAIT_L(0); PG8_BAR; if (fullu) { PG8_MMA(1, 0, At, B0); PG8_MMA(1, 1, At, B1); } PG8_BAR; PG8_SCHED;
            } else {
            PG8_LDB(B0, 0, 0); PG8_SCHED; PG8_LDA(At, 0, 0); PG8_STAGE(PG8_SA(1, 1), a1 + hstepA, voffA);
            PG8_WAIT_L(8); PG8_BAR; PG8_WAIT_L(0); PG8_MMA(0, 0, At, B0); PG8_BAR; PG8_SCHED;
            PG8_LDB(B1, 0, 1); PG8_STAGE(PG8_SB(0, 0), b2, voffB);
            PG8_BAR; PG8_WAIT_L(0); PG8_MMA(0, 1, At, B1); PG8_BAR;
            PG8_LDA(At, 0, 1); PG8_STAGE(PG8_SA(0, 0), a2, voffA);
            PG8_BAR; PG8_WAIT_L(0); PG8_MMA(1, 0, At, B0); PG8_BAR; PG8_SCHED;
            PG8_STAGE(PG8_SB(0, 1), b2 + hstepB, voffB);
            PG8_WAIT_V(6); PG8_BAR; PG8_MMA(1, 1, At, B1); PG8_BAR;
            PG8_LDB(B0, 1, 0); PG8_SCHED; PG8_LDA(At, 1, 0); PG8_STAGE(PG8_SA(0, 1), a2 + hstepA, voffA);
            PG8_WAIT_L(8); PG8_BAR; PG8_WAIT_L(0); PG8_MMA(0, 0, At, B0); PG8_BAR; PG8_SCHED;
            PG8_LDB(B1, 1, 1); PG8_STAGE(PG8_SB(1, 0), b3, voffB);
            PG8_BAR; PG8_WAIT_L(0); PG8_MMA(0, 1, At, B1); PG8_BAR;
            PG8_LDA(At, 1, 1); PG8_STAGE(PG8_SA(1, 0), a3, voffA);
            PG8_BAR; PG8_WAIT_L(0); PG8_MMA(1, 0, At, B0); PG8_BAR; PG8_SCHED;
            PG8_STAGE(PG8_SB(1, 1), b3 + hstepB, voffB);
            PG8_WAIT_V(6); PG8_BAR; PG8_MMA(1, 1, At, B1); PG8_BAR;
            }
        }
        if constexpr (ALIGN_EPI) { if (wr == 0) PG8_BAR; }
        bool keep_acc = false;
        if constexpr (Epi::HAS_MID) { if (cur.kind == 2) { E.mid(acc, cur, wr, wc, fr, fq); keep_acc = true; } }
        if constexpr (!Epi::AFTER_DRAIN) { if (!keep_acc) E(acc, cur, wr, wc, fr, fq); }
        if (!has_next) break;
        if (!keep_acc) {
#pragma unroll
        for (int a = 0; a < 2; ++a)
#pragma unroll
            for (int b = 0; b < 2; ++b)
#pragma unroll
                for (int m = 0; m < 4; ++m)
#pragma unroll
                    for (int n = 0; n < 2; ++n) acc[a][b][m][n] = (f32x4){0.f, 0.f, 0.f, 0.f};
        }
        cur = nxt; cA = nA; cB = nB; ++ui;
        if constexpr (GATHER) { vc0[0] = vn0[0]; vc0[1] = vn0[1]; vc1[0] = vn1[0]; vc1[1] = vn1[1]; }
        if constexpr (ALIGN_EPI) { if (wr == 1) PG8_BAR; }
    }
    PG8_WAIT_V(0);
    if constexpr (!ALIGN_EPI) { if (wr == 0) PG8_BAR; }
    PG8_BAR;
    if constexpr (Epi::AFTER_DRAIN) { E.fused(acc, cur, wr, wc, fr, fq, lds, wid, lane); }
#undef PG8_GOFF
#undef PG8_SA
#undef PG8_SB
#undef PG8_STAGE
#undef PG8_LDA
#undef PG8_LDB
#undef PG8_MMA
#undef PG8_WAIT_V
#undef PG8_WAIT_L
#undef PG8_BAR
#undef PG8_SCHED
}
}
using pg8::Unit; using pg8::Acc;

struct EpiF16 {
    static constexpr bool PERM = true, AFTER_DRAIN = false, HAS_MID = false;
    const float* cs0; float scale;
    float* ssq = nullptr;
    const LAS float* rowscale = nullptr;
    __device__ __forceinline__ void mid(Acc&, const Unit&, int, int, int, int) const {}
    __device__ __forceinline__ void operator()(const Acc& acc, const Unit& u, int wr, int wc, int fr, int fq) const {
        f16* base = (f16*)u.o; const int ldc = u.ldc;
        const int row0 = u.r0 + wr * 64 + fr, col0 = u.c0 + wc * 32 + 8 * fq;
        if (u.kind == 3) {
#pragma unroll
            for (int ai = 0; ai < 2; ++ai)
#pragma unroll
                for (int m = 0; m < 4; ++m) { const f32x4 a0 = acc[ai][0][m][0], a1 = acc[ai][0][m][1], g0 = acc[ai][1][m][0], g1 = acc[ai][1][m][1];
                    u32x4 w; w.x = pk2h(a0[0] * fast_sigmoid(g0[0]), a0[1] * fast_sigmoid(g0[1])); w.y = pk2h(a0[2] * fast_sigmoid(g0[2]), a0[3] * fast_sigmoid(g0[3]));
                    w.z = pk2h(a1[0] * fast_sigmoid(g1[0]), a1[1] * fast_sigmoid(g1[1])); w.w = pk2h(a1[2] * fast_sigmoid(g1[2]), a1[3] * fast_sigmoid(g1[3]));
                    *(u32x4*)(base + (size_t)(row0 + ai * 128 + m * 16) * ldc + col0) = w; }
            return; }
        const bool has_cs = (u.kind == 0) && (cs0 != nullptr);
        f32x4 c00, c01, c10, c11;
        if (has_cs) { c00 = *(const f32x4*)(cs0 + col0); c01 = *(const f32x4*)(cs0 + col0 + 4); c10 = *(const f32x4*)(cs0 + col0 + 128); c11 = *(const f32x4*)(cs0 + col0 + 132); }
#pragma unroll
        for (int ai = 0; ai < 2; ++ai) { if (ai == 1 && u.half) break;
#pragma unroll
            for (int m = 0; m < 4; ++m) { f16* rowp = base + (size_t)(row0 + ai * 128 + m * 16) * ldc + col0;
                float rsc = scale; if (rowscale) rsc *= rowscale[ai * 128 + wr * 64 + m * 16 + fr];
                float sq = 0.f;
#pragma unroll
                for (int bj = 0; bj < 2; ++bj) { f32x4 v0 = acc[ai][bj][m][0] * rsc, v1 = acc[ai][bj][m][1] * rsc;
                    if (has_cs) { v0 = v0 * (bj ? c10 : c00); v1 = v1 * (bj ? c11 : c01); }
                    sq += v0[0] * v0[0] + v0[1] * v0[1] + v0[2] * v0[2] + v0[3] * v0[3] + v1[0] * v1[0] + v1[1] * v1[1] + v1[2] * v1[2] + v1[3] * v1[3];
                    u32x4 w; w.x = pk2h(v0[0], v0[1]); w.y = pk2h(v0[2], v0[3]); w.z = pk2h(v1[0], v1[1]); w.w = pk2h(v1[2], v1[3]);
                    *(u32x4*)(rowp + bj * 128) = w; }
                if (ssq) { sq += __shfl_xor(sq, 16); sq += __shfl_xor(sq, 32); if (fq == 0) ssq[(size_t)(row0 + ai * 128 + m * 16) * 32 + (u.c0 >> 8) * 4 + wc] = sq; } } }
    }
};
struct EpiResF32 {
    static constexpr bool PERM = false, AFTER_DRAIN = false, HAS_MID = false;
    __device__ __forceinline__ void mid(Acc&, const Unit&, int, int, int, int) const {}
    const f16* base; float* out; int ldc;
    __device__ __forceinline__ void operator()(const Acc& acc, const Unit& u, int wr, int wc, int fr, int fq) const {
        const int row0 = u.r0 + wr * 64 + fr, col0 = u.c0 + wc * 32 + 4 * fq;
#pragma unroll
        for (int ai = 0; ai < 2; ++ai) {
            u32x2 bs[4][2][2];
#pragma unroll
            for (int m = 0; m < 4; ++m) { const size_t off = (size_t)(row0 + ai * 128 + m * 16) * ldc + col0;
#pragma unroll
                for (int bj = 0; bj < 2; ++bj)
#pragma unroll
                    for (int n = 0; n < 2; ++n) bs[m][bj][n] = *(const u32x2*)(base + off + bj * 128 + n * 16); }
#pragma unroll
            for (int m = 0; m < 4; ++m) { const size_t off = (size_t)(row0 + ai * 128 + m * 16) * ldc + col0;
#pragma unroll
                for (int bj = 0; bj < 2; ++bj)
#pragma unroll
                    for (int n = 0; n < 2; ++n) { const f32x2 b0 = unpk2h(bs[m][bj][n].x), b1 = unpk2h(bs[m][bj][n].y);
                        *(f32x4*)(out + off + bj * 128 + n * 16) = (f32x4){b0[0], b0[1], b1[0], b1[1]} + acc[ai][bj][m][n]; } }
        }
    }
};
struct EpiResH {
    static constexpr bool PERM = true, AFTER_DRAIN = false, HAS_MID = false;
    __device__ __forceinline__ void mid(Acc&, const Unit&, int, int, int, int) const {}
    const f16* base; f16* out; int ldc;
    __device__ __forceinline__ void operator()(const Acc& acc, const Unit& u, int wr, int wc, int fr, int fq) const {
        const int row0 = u.r0 + wr * 64 + fr, col0 = u.c0 + wc * 32 + 8 * fq;
#pragma unroll
        for (int ai = 0; ai < 2; ++ai) {
            u32x4 bs[4][2];
#pragma unroll
            for (int m = 0; m < 4; ++m)
#pragma unroll
                for (int bj = 0; bj < 2; ++bj) bs[m][bj] = *(const u32x4*)(base + (size_t)(row0 + ai * 128 + m * 16) * ldc + col0 + bj * 128);
#pragma unroll
            for (int m = 0; m < 4; ++m)
#pragma unroll
                for (int bj = 0; bj < 2; ++bj) { const f32x4 a0 = acc[ai][bj][m][0], a1 = acc[ai][bj][m][1]; const u32x4 b = bs[m][bj];
                    const f32x2 b0 = unpk2h(b.x), b1 = unpk2h(b.y), b2 = unpk2h(b.z), b3 = unpk2h(b.w);
                    u32x4 w; w.x = pk2h(b0[0] + a0[0], b0[1] + a0[1]); w.y = pk2h(b1[0] + a0[2], b1[1] + a0[3]); w.z = pk2h(b2[0] + a1[0], b2[1] + a1[1]); w.w = pk2h(b3[0] + a1[2], b3[1] + a1[3]);
                    *(u32x4*)(out + (size_t)(row0 + ai * 128 + m * 16) * ldc + col0 + bj * 128) = w; }
        }
    }
};
struct EpiG3 {
    static constexpr bool PERM = false, AFTER_DRAIN = false, HAS_MID = true;
    const float* base; float* out; f16* xh; float* ssq; const LAS f32x2* fac;
    __device__ __forceinline__ void mid(Acc& acc, const Unit& u, int wr, int wc, int fr, int fq) const {
#pragma unroll
        for (int ai = 0; ai < 2; ++ai)
#pragma unroll
            for (int m = 0; m < 4; ++m) { const float r = fac[ai * 128 + wr * 64 + m * 16 + fr][0];
#pragma unroll
                for (int bj = 0; bj < 2; ++bj)
#pragma unroll
                    for (int n = 0; n < 2; ++n) acc[ai][bj][m][n] = acc[ai][bj][m][n] * r; }
    }
    __device__ __forceinline__ void operator()(const Acc& acc, const Unit& u, int wr, int wc, int fr, int fq) const {
        const int row0 = u.r0 + wr * 64 + fr, col0 = u.c0 + wc * 32 + 4 * fq;
#pragma unroll
        for (int ai = 0; ai < 2; ++ai) {
            f32x4 bs[4][2][2];
#pragma unroll
            for (int m = 0; m < 4; ++m) { const size_t off = (size_t)(row0 + ai * 128 + m * 16) * D + col0;
#pragma unroll
                for (int bj = 0; bj < 2; ++bj)
#pragma unroll
                    for (int n = 0; n < 2; ++n) bs[m][bj][n] = *(const f32x4*)(base + off + bj * 128 + n * 16); }
#pragma unroll
            for (int m = 0; m < 4; ++m) { const size_t off = (size_t)(row0 + ai * 128 + m * 16) * D + col0; const float rb = fac[ai * 128 + wr * 64 + m * 16 + fr][1]; float sq = 0.f;
#pragma unroll
                for (int bj = 0; bj < 2; ++bj)
#pragma unroll
                    for (int n = 0; n < 2; ++n) { const f32x4 v = bs[m][bj][n] + acc[ai][bj][m][n] * rb;
                        sq += v[0] * v[0] + v[1] * v[1] + v[2] * v[2] + v[3] * v[3];
                        u32x2 h; h.x = pk2h(v[0], v[1]); h.y = pk2h(v[2], v[3]); *(u32x2*)(xh + off + bj * 128 + n * 16) = h; }
                sq += __shfl_xor(sq, 16); sq += __shfl_xor(sq, 32); if (fq == 0) ssq[(size_t)(row0 + ai * 128 + m * 16) * 32 + (u.c0 >> 8) * 4 + wc] = sq; }
        }
    }
};
struct EpiSwiGLU {
    static constexpr bool PERM = true, AFTER_DRAIN = false, HAS_MID = false;
    __device__ __forceinline__ void mid(Acc&, const Unit&, int, int, int, int) const {}
    f16* hid; const float* slot_rs;
    __device__ __forceinline__ void operator()(const Acc& acc, const Unit& u, int wr, int wc, int fr, int fq) const {
        const int row0 = u.r0 + wr * 64 + fr, col0 = u.c0 + wc * 32 + 8 * fq;
        float rs[2][4];
#pragma unroll
        for (int ai = 0; ai < 2; ++ai)
#pragma unroll
            for (int m = 0; m < 4; ++m) rs[ai][m] = slot_rs[row0 + ai * 128 + m * 16];
#pragma unroll
        for (int ai = 0; ai < 2; ++ai) { if (ai == 1 && u.half) break;
#pragma unroll
            for (int m = 0; m < 4; ++m) { f16* rowp = hid + (size_t)(row0 + ai * 128 + m * 16) * DE + col0; const float r = rs[ai][m];
                const f32x4 g0 = acc[ai][0][m][0] * r, g1 = acc[ai][0][m][1] * r, u0 = acc[ai][1][m][0] * r, u1 = acc[ai][1][m][1] * r;
                u32x4 w; w.x = pk2h(g0[0] * fast_sigmoid(g0[0]) * u0[0], g0[1] * fast_sigmoid(g0[1]) * u0[1]); w.y = pk2h(g0[2] * fast_sigmoid(g0[2]) * u0[2], g0[3] * fast_sigmoid(g0[3]) * u0[3]);
                w.z = pk2h(g1[0] * fast_sigmoid(g1[0]) * u1[0], g1[1] * fast_sigmoid(g1[1]) * u1[1]); w.w = pk2h(g1[2] * fast_sigmoid(g1[2]) * u1[2], g1[3] * fast_sigmoid(g1[3]) * u1[3]);
                *(u32x4*)rowp = w; } }
    }
};
struct EpiDown {
    static constexpr bool PERM = true, AFTER_DRAIN = false, HAS_MID = false;
    __device__ __forceinline__ void mid(Acc&, const Unit&, int, int, int, int) const {}
    f16* ys; const float* slot_w;
    __device__ __forceinline__ void operator()(const Acc& acc, const Unit& u, int wr, int wc, int fr, int fq) const {
        const int row0 = u.r0 + wr * 64 + fr, col0 = u.c0 + wc * 32 + 8 * fq;
        float sw[2][4];
#pragma unroll
        for (int ai = 0; ai < 2; ++ai)
#pragma unroll
            for (int m = 0; m < 4; ++m) sw[ai][m] = slot_w[row0 + ai * 128 + m * 16];
#pragma unroll
        for (int ai = 0; ai < 2; ++ai) { if (ai == 1 && u.half) break;
#pragma unroll
            for (int m = 0; m < 4; ++m) { const int row = row0 + ai * 128 + m * 16; f16* rowp = ys + (size_t)row * D + col0;
#pragma unroll
                for (int bj = 0; bj < 2; ++bj) { const f32x4 v0 = acc[ai][bj][m][0] * sw[ai][m], v1 = acc[ai][bj][m][1] * sw[ai][m];
                    u32x4 w; w.x = pk2h(v0[0], v0[1]); w.y = pk2h(v0[2], v0[3]); w.z = pk2h(v1[0], v1[1]); w.w = pk2h(v1[2], v1[3]);
                    *(u32x4*)(rowp + bj * 128) = w; } } }
    }
};
struct EpiSoftmax {
    static constexpr bool PERM = true, AFTER_DRAIN = true, HAS_MID = false;
    __device__ __forceinline__ void mid(Acc&, const Unit&, int, int, int, int) const {}
    f16* P;
    __device__ __forceinline__ void operator()(const Acc&, const Unit&, int, int, int, int) const {}
    __device__ __forceinline__ void fused(Acc& acc, const Unit& u, int wr, int wc, int fr, int fq, LAS unsigned char* lds, int wid, int lane) const {
        LAS f32x2* T = (LAS f32x2*)lds;
        float mloc[2][4], lloc[2][4];
#pragma unroll
        for (int ai = 0; ai < 2; ++ai) { if (ai == 1 && u.half) break;
#pragma unroll
            for (int m = 0; m < 4; ++m) {
                float mx = -3.0e38f;
#pragma unroll
                for (int bj = 0; bj < 2; ++bj)
#pragma unroll
                    for (int n = 0; n < 2; ++n)
#pragma unroll
                        for (int j = 0; j < 4; ++j) mx = fmaxf(mx, acc[ai][bj][m][n][j]);
                mx = fmaxf(mx, __shfl_xor(mx, 16)); mx = fmaxf(mx, __shfl_xor(mx, 32));
                float s = 0.f;
#pragma unroll
                for (int bj = 0; bj < 2; ++bj)
#pragma unroll
                    for (int n = 0; n < 2; ++n)
#pragma unroll
                        for (int j = 0; j < 4; ++j) { const float e = __expf(acc[ai][bj][m][n][j] - mx); acc[ai][bj][m][n][j] = e; s += e; }
                s += __shfl_xor(s, 16); s += __shfl_xor(s, 32);
                mloc[ai][m] = mx; lloc[ai][m] = s;
                if (fq == 0) T[(ai * 128 + wr * 64 + m * 16 + fr) * 4 + wc] = (f32x2){mx, s};
            } }
        LDS_WAIT(); __builtin_amdgcn_s_barrier(); asm volatile("" ::: "memory");
        const int row0 = u.r0 + wr * 64 + fr, col0 = u.c0 + wc * 32 + 8 * fq;
#pragma unroll
        for (int ai = 0; ai < 2; ++ai) { if (ai == 1 && u.half) break;
#pragma unroll
            for (int m = 0; m < 4; ++m) { const int r = ai * 128 + wr * 64 + m * 16 + fr;
                const f32x2 t0 = T[r * 4 + 0], t1 = T[r * 4 + 1], t2 = T[r * 4 + 2], t3 = T[r * 4 + 3];
                const float M = fmaxf(fmaxf(t0.x, t1.x), fmaxf(t2.x, t3.x));
                const float L = t0.y * __expf(t0.x - M) + t1.y * __expf(t1.x - M) + t2.y * __expf(t2.x - M) + t3.y * __expf(t3.x - M);
                const float f = __expf(mloc[ai][m] - M) / L;
                f16* rowp = P + (size_t)(row0 + ai * 128 + m * 16) * 256 + col0;
#pragma unroll
                for (int bj = 0; bj < 2; ++bj) { const f32x4 v0 = acc[ai][bj][m][0] * f, v1 = acc[ai][bj][m][1] * f;
                    u32x4 w; w.x = pk2h(v0[0], v0[1]); w.y = pk2h(v0[2], v0[3]); w.z = pk2h(v1[0], v1[1]); w.w = pk2h(v1[2], v1[3]);
                    *(u32x4*)(rowp + bj * 128) = w; } } }
        (void)lloc;
    }
};

#define F_LANE ((int)(threadIdx.x & 63u))
struct Frame {
    LAS unsigned char* lds;
    unsigned char* ws;
    int tid, wave, G, c;
};
struct Args { const float* in[28]; float* out; unsigned char* ws; int ph_lo, ph_hi, li, pad; };

struct SchedP1 {
    int G, c; char* wsb;
    __device__ __forceinline__ bool next(int i, Unit& u) const {
        if (i > 1) return false;
        const int L = (G == 256) ? (64 * (c & 7) + 32 * i + (c >> 3)) : (i * G + c); if (L >= 400) return false;
        int pm = 0, pn = 0; if (L < 384) { if (G == 256) pg8::tile_of_w(L, 32, 12, pm, pn); else pg8::tile_of(L, 32, 12, pm, pn); }
        const size_t p = (L < 384) ? 1 : 0, k = (L >= 384 && L < 392) ? 1 : 0, v = (L >= 392) ? 1 : 0; const size_t q = (size_t)(L - 384) & 7; const size_t lt = (pn < 4) ? 1 : 0;
        const size_t offA = p * (WS_H + (size_t)pm * 256 * D * 2) + k * WS_M16 + v * (WS_WKV + (2048 + q * 256) * D * 2);
        const size_t offB = p * (WS_WIN + (size_t)pn * 256 * D * 2) + k * (WS_WKV + q * 256 * D * 2) + v * WS_M16;
        const size_t offO = p * WS_PROJ + k * WS_K16 + v * WS_VT16;
        u.a = wsb + offA; u.b = wsb + offB; u.o = wsb + offO; u.rowtab = nullptr; u.nt = 32; u.aux = 0; u.half = 0;
        u.ldc = (int)(p * D + k * D + v * 256);
        u.r0 = (int)(p * pm * 256 + v * q * 256);
        u.c0 = (int)(p * (lt * pn * 256 + (1 - lt) * (1024 + (pn - 4) * 128)) + k * q * 256);
        u.kind = (int)(p * (3 - 3 * lt) + k + 2 * v);
        return true;
    }
};
struct SchedG2 {
    int G, c; const char* dc; const char* wpw; const char* wpool; char* y;
    __device__ __forceinline__ bool next(int i, Unit& u) const {
        const int L = i * G + c; if (L >= 256) return false;
        u.aux = 0; u.half = 0; u.o = y; u.ldc = D; u.rowtab = nullptr;
        if (L < 128) { int pm, pn; pg8::tile_of(L, 32, 4, pm, pn); u.a = dc + ((size_t)pm * 256 * D + 1024) * 2; u.b = wpw + (size_t)pn * 256 * 1024 * 2; u.nt = 16; u.r0 = pm * 256; u.c0 = 1024 + pn * 256; u.kind = 1; }
        else { int pm, g; pg8::tile_of(L - 128, 32, 4, pm, g); u.a = dc + ((size_t)pm * 256 * D + g * 256) * 2; u.b = wpool + (size_t)g * 256 * 1024 * 2; u.nt = 4; u.r0 = pm * 256; u.c0 = g * 256; u.kind = 0; }
        return true;
    }
};
struct SchedDense {
    int G, c; const char* A; const char* B; char* o;
    __device__ __forceinline__ bool next(int i, Unit& u) const {
        const int L = i * G + c; if (L >= 256) return false;
        int pm, pn; pg8::tile_of(L, 32, 8, pm, pn);
        u.a = A + (size_t)pm * 256 * D * 2; u.b = B + (size_t)pn * 256 * D * 2; u.nt = 32; u.r0 = pm * 256; u.c0 = pn * 256; u.kind = 1; u.aux = 0; u.half = 0; u.o = o; u.ldc = D; u.rowtab = nullptr; return true;
    }
};
struct SchedG3 {
    int G, c; const char* A; const char* B;
    __device__ __forceinline__ bool next(int i, Unit& u) const {
        const int L = (i >> 1) * G + c; if (L >= 256) return false;
        int pm, pn; pg8::tile_of(L, 32, 8, pm, pn); const int part = i & 1;
        u.a = A + ((size_t)pm * 256 * D + part * 1024) * 2; u.b = B + ((size_t)pn * 256 * D + part * 1024) * 2; u.nt = 16; u.r0 = pm * 256; u.c0 = pn * 256; u.kind = part ? 1 : 2; u.aux = 0; u.half = 0; u.o = nullptr; u.ldc = D; u.rowtab = nullptr; return true;
    }
};
struct SchedS {
    int G, c; const char* q; const char* k16;
    __device__ __forceinline__ bool next(int i, Unit& u) const {
        const int L = i * G + c; if (L >= 256 || i > 0) return false;
        const int h = L >> 6, pb = L & 63;
        u.a = q + ((size_t)pb * 128 * D + h * HD) * 2; u.b = k16 + (size_t)h * HD * 2; u.nt = 8; u.r0 = h * SEQ + pb * 128; u.c0 = 0; u.kind = 1; u.aux = 0; u.half = 1; u.o = nullptr; u.ldc = 256; u.rowtab = nullptr; return true;
    }
};
struct SchedPV {
    int G, c; const char* p; const char* vt; char* o;
    __device__ __forceinline__ bool next(int i, Unit& u) const {
        const int L = c; if (L >= 256 || i > 1) return false;
        const int h = L >> 6, pb = L & 63, pn = i;
        u.a = p + (size_t)(h * SEQ + pb * 128) * 256 * 2; u.b = vt + (size_t)(h * HD + pn * 256) * 256 * 2; u.nt = 4; u.r0 = pb * 128; u.c0 = h * HD + pn * 256; u.kind = 1; u.aux = 0; u.half = 1; u.o = o; u.ldc = D; u.rowtab = nullptr; return true;
    }
};
struct SchedGU {
    int G, c, mode; const char* xs; const char* wgu; const LAS int* tab; const int* slottok;
    __device__ __forceinline__ bool next(int i, Unit& u) const {
        const int NF = __builtin_amdgcn_readfirstlane(tab[0]), NH = __builtin_amdgcn_readfirstlane(tab[1]); const int L = i * G + c; const int n = (mode ? NH : NF) * 4; if (L >= n) return false;
        const int w = pg8::xcd_chunk(L, n); const int j = (mode ? NF : 0) + (w >> 2), pn = w & 3; u.half = mode;
        const int te = __builtin_amdgcn_readfirstlane(tab[2 + j]); const int e = te & 255, r0 = (te >> 8) * 128;
        u.a = xs; u.rowtab = slottok + r0; u.b = wgu + (size_t)(e * 4 + pn) * (32 * 32768); u.nt = 32; u.r0 = r0; u.c0 = pn * 128; u.kind = 1; u.aux = e; u.o = nullptr; u.ldc = DE; return true;
    }
};
struct SchedDN {
    int G, c, mode; const char* hid; const char* wdn; const LAS int* tab;
    __device__ __forceinline__ bool next(int i, Unit& u) const {
        const int NF = __builtin_amdgcn_readfirstlane(tab[0]), NH = __builtin_amdgcn_readfirstlane(tab[1]);
        int j, pn;
        if (mode == 0) { const int HG = (4 * NH < G) ? 4 * NH : G, N0 = G - HG; int k;
            if (c >= HG) k = (i < 2) ? (i * N0 + (c - HG)) : (2 * N0 + (i - 2) * G + c); else k = 2 * N0 + i * G + c;
            if (k >= 8 * NF) return false;
            const int kfull = (NF >> 3) << 6;
            if (k < kfull) { const int blk = k >> 6, r = k & 63; j = 8 * blk + (r & 7); pn = r >> 3; } else { j = k >> 3; pn = k & 7; }
            u.half = 0; }
        else { const int L = i * G + c; if (L >= 8 * NH) return false; const int w = pg8::xcd_chunk(L, 8 * NH); j = NF + (w >> 3); pn = w & 7; u.half = 1; }
        const int te = __builtin_amdgcn_readfirstlane(tab[2 + j]); const int e = te & 255, r0 = (te >> 8) * 128;
        u.a = hid + (size_t)r0 * DE * 2; u.rowtab = nullptr; u.b = wdn + (size_t)(e * 8 + pn) * (8 * 32768); u.nt = 8; u.r0 = r0; u.c0 = pn * 256; u.kind = 1; u.aux = e; u.o = nullptr; u.ldc = D; return true;
    }
};

struct TrItem { const float* src; f16* dst; const float* ks; int N; int pitch; };
__device__ __forceinline__ void tr_load(const TrItem& d, f32x4 (&v)[8]) {
#pragma unroll
    for (int i = 0; i < 8; ++i) v[i] = __builtin_nontemporal_load((const f32x4*)(d.src + (size_t)(8 * i) * d.N));
}
__device__ __forceinline__ void tr_store(const TrItem& d, const f32x4 (&v)[8], LAS float* scr, int lane) {
#pragma unroll
    for (int i = 0; i < 8; ++i) { LAS float* p = scr + ((lane >> 3) + 8 * i) * 33 + 4 * (lane & 7); p[0] = v[i][0]; p[1] = v[i][1]; p[2] = v[i][2]; p[3] = v[i][3]; }
    LDS_WAIT(); asm volatile("" ::: "memory");
    const int c = lane >> 3, nl = lane & 7;
    f32x4 ka = (f32x4){1.f, 1.f, 1.f, 1.f}, kb2 = ka; if (d.ks) { ka = *(const f32x4*)(d.ks + 8 * c); kb2 = *(const f32x4*)(d.ks + 8 * c + 4); }
#pragma unroll
    for (int jj = 0; jj < 4; ++jj) { const int n = nl + 8 * jj; const LAS float* s = scr + (8 * c) * 33 + n;
        u32x4 o; o.x = pk2h(s[0 * 33] * ka[0], s[1 * 33] * ka[1]); o.y = pk2h(s[2 * 33] * ka[2], s[3 * 33] * ka[3]); o.z = pk2h(s[4 * 33] * kb2[0], s[5 * 33] * kb2[1]); o.w = pk2h(s[6 * 33] * kb2[2], s[7 * 33] * kb2[3]);
        __builtin_nontemporal_store(o, (u32x4*)(d.dst + (size_t)n * d.pitch + 8 * c)); }
    LDS_WAIT(); asm volatile("" ::: "memory");
}
__device__ __forceinline__ void rms_row_f32(const float* xrow, const float* g, f16* orow, int lane) {
    f32x4 v[8]; float s = 0.f;
#pragma unroll
    for (int j = 0; j < 4; ++j) { const f32x4* p = (const f32x4*)(xrow + 8 * (lane + 64 * j)); v[2 * j] = p[0]; v[2 * j + 1] = p[1];
        s += v[2 * j][0] * v[2 * j][0] + v[2 * j][1] * v[2 * j][1] + v[2 * j][2] * v[2 * j][2] + v[2 * j][3] * v[2 * j][3];
        s += v[2 * j + 1][0] * v[2 * j + 1][0] + v[2 * j + 1][1] * v[2 * j + 1][1] + v[2 * j + 1][2] * v[2 * j + 1][2] + v[2 * j + 1][3] * v[2 * j + 1][3]; }
    const float rs = rsqrtf(wave_sum(s) * (1.0f / D) + EPS);
#pragma unroll
    for (int j = 0; j < 4; ++j) { const f32x4* gp = (const f32x4*)(g + 8 * (lane + 64 * j)); const f32x4 a = v[2 * j] * rs * gp[0], b = v[2 * j + 1] * rs * gp[1];
        u32x4 o; o.x = pk2h(a[0], a[1]); o.y = pk2h(a[2], a[3]); o.z = pk2h(b[0], b[1]); o.w = pk2h(b[2], b[3]);
        *(u32x4*)(orow + 8 * (lane + 64 * j)) = o; }
}

constexpr int I_IN = 32 * 96, I_POOL = 4 * 4 * 8, I_PW = 16 * 32, I_SQ = 32 * 64, I_KV = 32 * 128, I_G = 32 * 32 * 16, I_D = 32 * 8 * 64;
constexpr int NITEMS = I_IN + I_POOL + I_PW + 3 * I_SQ + I_KV + 2 * I_G + I_D;
__device__ __forceinline__ void blk_order(int r, int NB, int KL, int NL, int& kb, int& nb) {
    const int per = KL * NL, blk = r / per, lo = r % per, nbh = NB / NL; nb = (blk % nbh) * NL + lo % NL; kb = (blk / nbh) * KL + lo / NL;
}
constexpr int SEG_A = I_IN + I_KV, SEG_B = SEG_A + I_POOL + I_PW + 3 * I_SQ, SEG_GU = SEG_B + 2 * I_G;
static_assert(SEG_GU + I_D == NITEMS, "item segments");
__device__ __forceinline__ TrItem tr_decode(int r, const Args& A, unsigned char* ws, int lane) {
    const float* W; int N, k0, n0, pitch, kb, nb; f16* dst; const float* ks = nullptr;
    if (r < I_IN) { blk_order(r, 96, 16, 16, kb, nb); W = A.in[3]; N = NPROJ; k0 = kb * 64; n0 = nb * 32; pitch = D;
        int drow = n0; if (n0 >= 2048) { const int cc = n0 - 2048; drow = 1024 + (cc >> 7) * 256 + 128 + (cc & 127); } else if (n0 >= 1024) { const int cc = n0 - 1024; drow = 1024 + (cc >> 7) * 256 + (cc & 127); }
        dst = (f16*)(ws + WS_WIN) + (size_t)drow * D + k0; }
    else if ((r -= I_IN) < I_KV) { blk_order(r, 128, 16, 16, kb, nb); W = A.in[17]; N = 4096; k0 = kb * 64; n0 = nb * 32; pitch = D; dst = (f16*)(ws + WS_WKV) + (size_t)n0 * D + k0; }
    else if ((r -= I_KV) < I_POOL) { const int g = r / 32, q = r % 32; kb = q / 8; nb = q % 8; W = A.in[4] + (size_t)g * 65536; N = 256; k0 = kb * 64; n0 = nb * 32; pitch = 1024; dst = (f16*)(ws + WS_WPOOL) + (size_t)(g * 256 + n0) * 1024 + k0; }
    else if ((r -= I_POOL) < I_PW) { blk_order(r, 32, 16, 16, kb, nb); W = A.in[10]; N = 1024; k0 = kb * 64; n0 = nb * 32; pitch = 1024; dst = (f16*)(ws + WS_WPW) + (size_t)n0 * 1024 + k0; }
    else if ((r -= I_PW) < I_SQ) { blk_order(r, 64, 16, 16, kb, nb); W = A.in[13]; N = D; k0 = kb * 64; n0 = nb * 32; pitch = D; dst = (f16*)(ws + WS_WOUT) + (size_t)n0 * D + k0; ks = (k0 < 1024) ? (A.in[11] + k0) : (A.in[12] + k0 - 1024); }
    else if ((r -= I_SQ) < I_SQ) { blk_order(r, 64, 16, 16, kb, nb); W = A.in[16]; N = D; k0 = kb * 64; n0 = nb * 32; pitch = D; dst = (f16*)(ws + WS_WQ) + (size_t)n0 * D + k0; ks = A.in[14] + k0; }
    else if ((r -= I_SQ) < I_SQ) { blk_order(r, 64, 16, 16, kb, nb); W = A.in[18]; N = D; k0 = kb * 64; n0 = nb * 32; pitch = D; dst = (f16*)(ws + WS_WO) + (size_t)n0 * D + k0; }
    else if ((r -= I_SQ) < 2 * I_G) { const int up = r >= I_G; if (up) r -= I_G; const int e = r / 512; blk_order(r % 512, 16, 16, 16, kb, nb); n0 = nb * 32; k0 = kb * 64;
        W = (up ? A.in[25] : A.in[24]) + (size_t)e * D * DE; N = DE; pitch = 64;
        dst = (f16*)(ws + WS_WGU) + ((size_t)((e * 4 + (n0 >> 7)) * 32 + kb) * 256 + up * 128 + (n0 & 127)) * 64; k0 = kb * 64; }
    else { r -= 2 * I_G; const int e = r / 512; blk_order(r % 512, 64, 8, 32, kb, nb); W = A.in[26] + (size_t)e * DE * D; N = D; k0 = kb * 64; n0 = nb * 32; pitch = 64;
        dst = (f16*)(ws + WS_WDN) + ((size_t)((e * 8 + (n0 >> 8)) * 8 + kb) * 256 + (n0 & 255)) * 64; }
    TrItem d; d.src = W + (size_t)(k0 + (lane >> 3)) * N + n0 + 4 * (lane & 7); d.dst = dst; d.ks = ks; d.N = N; d.pitch = pitch; return d;
}
constexpr int CW_QHEAD = 64, CW_ARRIVE = 1024;
__device__ __forceinline__ void tr_batch16(const Frame& F, const Args& A, int first) {
    LAS float* scr = (LAS float*)(F.lds + F.wave * 16384);
    const int i0 = first + F.wave, i1 = first + 8 + F.wave; const bool v0 = i0 < NITEMS, v1 = i1 < NITEMS;
    TrItem d0, d1; f32x4 a[8], b[8];
    if (v0) { d0 = tr_decode(i0, A, F.ws, F_LANE); tr_load(d0, a); }
    if (v1) { d1 = tr_decode(i1, A, F.ws, F_LANE); tr_load(d1, b); }
    if (v0) tr_store(d0, a, scr, F_LANE);
    if (v1) tr_store(d1, b, scr, F_LANE);
}
__device__ __forceinline__ void tr_batch8(const Frame& F, const Args& A, int first) {
    LAS float* scr = (LAS float*)(F.lds + F.wave * 16384);
    const int i0 = first + F.wave;
    if (i0 < NITEMS) { f32x4 a[8]; const TrItem d0 = tr_decode(i0, A, F.ws, F_LANE); tr_load(d0, a); tr_store(d0, a, scr, F_LANE); }
}
__device__ __forceinline__ void tr_drain(const Frame& F, const Args& A, int limit) {
    unsigned* head = (unsigned*)(F.ws + WS_CTL) + CW_QHEAD; volatile LAS int* slot = (volatile LAS int*)(F.lds + MISC_OFF) + 16;
    __syncthreads();
    if (F.tid == 0) { int it = NITEMS; if ((int)xb_ld(head) < limit) it = (int)xb_add(head, 16u); slot[0] = it; }
    __syncthreads();
    int it = slot[0];
    while (it < NITEMS) {
        unsigned nx = (unsigned)NITEMS;
        if (F.tid == 0 && it < limit) nx = xb_add(head, 16u);
        tr_batch16(F, A, it);
        __syncthreads();
        if (F.tid == 0) slot[0] = (int)nx;
        __syncthreads();
        it = slot[0];
    }
}
__device__ __forceinline__ void tr_idle(const Frame& F, const Args& A, int ph) {
    unsigned* head = (unsigned*)(F.ws + WS_CTL) + CW_QHEAD; unsigned* arr = (unsigned*)(F.ws + WS_CTL) + CW_ARRIVE + 64 * ph;
    volatile LAS int* slot = (volatile LAS int*)(F.lds + MISC_OFF) + 16;
    __syncthreads();
    if (F.tid == 0) { (void)xb_add(arr, 1u); int it = NITEMS; if (xb_ld(arr) < (unsigned)F.G) it = (int)xb_add(head, 16u); slot[0] = it; }
    __syncthreads();
    int it = slot[0];
    while (it < NITEMS) {
        unsigned nx = (unsigned)NITEMS, ar = 0u;
        if (F.tid == 0) { ar = xb_ld(arr); nx = xb_add(head, 16u); }
        tr_batch16(F, A, it);
        __syncthreads();
        if (F.tid == 0) slot[0] = (int)nx, slot[1] = (ar >= (unsigned)F.G) ? 1 : 0;
        __syncthreads();
        it = slot[0];
        if (slot[1]) { if (it < NITEMS) tr_batch16(F, A, it); break; }
    }
}
__device__ __forceinline__ void phase_prep(const Frame& F, const Args& A) {
    LAS float* scr = (LAS float*)(F.lds + F.wave * 16384);
    const int gw = F.c * 8 + F.wave, NGW = F.G * 8; unsigned char* ws = F.ws;
    if (F.c == 0 && F.tid == 0) (void)xb_add((unsigned*)(F.ws + WS_CTL) + CW_QHEAD, (unsigned)SEG_A);
    int it = gw; int m = gw;
    TrItem cur; f32x4 v[8]; bool have = it < SEG_A;
    if (have) { cur = tr_decode(it, A, ws, F_LANE); tr_load(cur, v); }
    for (;;) {
        const int nx = it + NGW; const bool more = have && nx < SEG_A;
        TrItem nd = cur; f32x4 vn[8];
        if (more) { nd = tr_decode(nx, A, ws, F_LANE); tr_load(nd, vn); }
        if (m < SEQ) { rms_row_f32(A.in[0] + (size_t)m * D, A.in[2], (f16*)(ws + WS_H) + (size_t)m * D, F_LANE); m += NGW; }
        if (have) tr_store(cur, v, scr, F_LANE);
        if (!more && m >= SEQ) break;
        if (more) {
#pragma unroll
            for (int i = 0; i < 8; ++i) v[i] = vn[i];
            cur = nd; it = nx; } else have = false;
    }
    for (int r = gw; r < MEMLEN; r += NGW) rms_row_f32(A.in[1] + (size_t)r * D, A.in[15], (f16*)(ws + WS_M16) + (size_t)r * D, F_LANE);
}

template <int TT> __device__ __forceinline__ void conv_step(f32x2 (&acc)[32], const f32x2 (&w)[CK], const LAS unsigned* yl, const unsigned ycur) {
    unsigned ynext = 0u;
    if constexpr (TT + 1 < 62) ynext = yl[(TT + 1) * 512];
    const f32x2 y = unpk2h(ycur);
#pragma unroll
    for (int r = (TT - 30 > 0 ? TT - 30 : 0); r <= (TT < 31 ? TT : 31); ++r) acc[r] = acc[r] + w[TT - r] * y;
    __builtin_amdgcn_sched_barrier(0);
    if constexpr (TT + 1 < 62) conv_step<TT + 1>(acc, w, yl, ynext);
}
__device__ __forceinline__ void phase_mixpre(const Frame& F, const Args& A) {
    const f16* proj = (const f16*)(F.ws + WS_PROJ);
    f16* dc = (f16*)(F.ws + WS_DC);
    LAS unsigned* ylds = (LAS unsigned*)F.lds;
    LAS float* red = (LAS float*)F.lds;
    LAS float* stat = (LAS float*)(F.lds + TAB_OFF);
    const int tid = F.tid, lane = F_LANE;
    for (int blk = F.c; blk < SEQ / 32; blk += F.G) {
        const int t0 = blk * 32;
#pragma unroll 2
        for (int p = 0; p < 12; ++p) { const int rr = p * 4 + (tid >> 7); const int t = t0 - 15 + rr; u32x4 v = (u32x4){0u, 0u, 0u, 0u};
            if (t >= 0 && t < SEQ) v = *(const u32x4*)(proj + (size_t)t * D + (tid & 127) * 8);
            *(LAS u32x4*)(ylds + rr * 512 + (tid & 127) * 4) = v; }
        __syncthreads();
        { const int g = tid >> 7, wnd = 2 << g; f32x2 S = (f32x2){0.f, 0.f};
          for (int i = 1; i < wnd; ++i) S = S + unpk2h(ylds[(15 - i) * 512 + tid]);
#pragma unroll 4
          for (int r = 0; r < 32; ++r) { const int t = t0 + r; const f32x2 cur = unpk2h(ylds[(15 + r) * 512 + tid]); S = S + cur;
              const int cnt = (t + 1 < wnd) ? (t + 1) : wnd; const float ic = 1.0f / (float)cnt;
              *(unsigned*)(dc + (size_t)t * D + 2 * tid) = pk2h(S[0] * ic - cur[0], S[1] * ic - cur[1]);
              S = S - unpk2h(ylds[(15 + r - wnd + 1) * 512 + tid]); } }
        __syncthreads();
#pragma unroll 2
        for (int p = 0; p < 16; ++p) { const int r = p * 4 + (tid >> 7), c8 = (tid & 127) * 8; const int t = t0 - 30 + r;
            u32x4 o = (u32x4){0u, 0u, 0u, 0u};
            if (t >= 0 && r < 62) o = *(const u32x4*)(proj + (size_t)t * D + 1024 + c8);
            if (r < 62) *(LAS u32x4*)(ylds + r * 512 + (tid & 127) * 4) = o; }
        __syncthreads();
        f32x2 acc[32];
        { f32x2 w[CK];
#pragma unroll
          for (int j = 0; j < CK; ++j) w[j] = *(const f32x2*)(A.in[6] + j * 1024 + 2 * tid);
          const f32x2 bdw = *(const f32x2*)(A.in[7] + 2 * tid);
#pragma unroll
          for (int r = 0; r < 32; ++r) acc[r] = bdw;
          conv_step<0>(acc, w, ylds + tid, ylds[tid]); }
        __syncthreads();
#pragma unroll
        for (int r = 0; r < 32; ++r) { red[(2 * r) * 512 + tid] = acc[r][0] + acc[r][1]; red[(2 * r + 1) * 512 + tid] = acc[r][0] * acc[r][0] + acc[r][1] * acc[r][1]; }
        __syncthreads();
        { const int s = tid >> 3, sl = tid & 7; float a = 0.f;
#pragma unroll 8
          for (int i = 0; i < 64; ++i) a += red[s * 512 + sl * 64 + ((i + lane) & 63)];
          a += __shfl_xor(a, 1); a += __shfl_xor(a, 2); a += __shfl_xor(a, 4);
          if (sl == 0) stat[s] = a; }
        __syncthreads();
        { const f32x2 lng = *(const f32x2*)(A.in[8] + 2 * tid), lnb = *(const f32x2*)(A.in[9] + 2 * tid);
#pragma unroll
          for (int r = 0; r < 32; ++r) { const float mean = stat[2 * r] * (1.0f / 1024.f); const float var = stat[2 * r + 1] * (1.0f / 1024.f) - mean * mean; const float rstd = rsqrtf(var + EPS);
              const float y0 = (acc[r][0] - mean) * rstd * lng[0] + lnb[0], y1 = (acc[r][1] - mean) * rstd * lng[1] + lnb[1];
              *(unsigned*)(dc + (size_t)(t0 + r) * D + 1024 + 2 * tid) = pk2h(y0 * fast_sigmoid(y0), y1 * fast_sigmoid(y1)); } }
        __syncthreads();
    }
}

__device__ __forceinline__ void phase_rownorm(const Frame& F, const Args& A) {
    const f16* y = (const f16*)(F.ws + WS_Y); f16* yn = (f16*)(F.ws + WS_YN);
    const int gw = F.c * 8 + F.wave, NGW = F.G * 8, lane = F_LANE;
    for (int m = gw; m < SEQ; m += NGW) {
        u32x4 v[4]; float sa = 0.f, sb = 0.f;
#pragma unroll
        for (int j = 0; j < 4; ++j) { v[j] = *(const u32x4*)(y + (size_t)m * D + 8 * (lane + 64 * j)); float s = 0.f;
#pragma unroll
            for (int q = 0; q < 4; ++q) { const f32x2 a = unpk2h(v[j][q]); s += a[0] * a[0] + a[1] * a[1]; }
            if (j < 2) sa += s; else sb += s; }
        const float ra = rsqrtf(wave_sum(sa) * (1.0f / 1024.f) + EPS), rb = rsqrtf(wave_sum(sb) * (1.0f / 1024.f) + EPS);
#pragma unroll
        for (int j = 0; j < 4; ++j) { const int col = 8 * (lane + 64 * j); const float* g = (j < 2) ? (A.in[11] + col) : (A.in[12] + col - 1024); const float rs = (j < 2) ? ra : rb;
            const f32x4 g0 = *(const f32x4*)g, g1 = *(const f32x4*)(g + 4); u32x4 o;
            { const f32x2 a = unpk2h(v[j][0]); o.x = pk2h(a[0] * rs * g0[0], a[1] * rs * g0[1]); }
            { const f32x2 a = unpk2h(v[j][1]); o.y = pk2h(a[0] * rs * g0[2], a[1] * rs * g0[3]); }
            { const f32x2 a = unpk2h(v[j][2]); o.z = pk2h(a[0] * rs * g1[0], a[1] * rs * g1[1]); }
            { const f32x2 a = unpk2h(v[j][3]); o.w = pk2h(a[0] * rs * g1[2], a[1] * rs * g1[3]); }
            *(u32x4*)(yn + (size_t)m * D + col) = o; }
    }
}
__device__ __forceinline__ void phase_norm_x(const Frame& F, const float* x, const float* g) {
    const int gw = F.c * 8 + F.wave, NGW = F.G * 8;
    for (int m = gw; m < SEQ; m += NGW) rms_row_f32(x + (size_t)m * D, g, (f16*)(F.ws + WS_H) + (size_t)m * D, F_LANE);
}

typedef float f32x16 __attribute__((ext_vector_type(16)));
__device__ __forceinline__ void phase_router(const Frame& F, const Args& A, const f16* x2) {
    const float* gf = A.in[19]; const float* wrg = A.in[20]; const float* brg = A.in[21]; const float* wre = A.in[22]; const float* bre = A.in[23];
    LAS float* xt = (LAS float*)(F.lds) + F.wave * (32 * 68 + 256);
    LAS float* wgt = xt + 32 * 68;
    constexpr int XT_BYTES = 8 * (32 * 68 + 256) * 4;
    LAS float* part = (LAS float*)(F.lds + XT_BYTES);
    LAS float* gpart = (LAS float*)(F.lds + XT_BYTES + 36864);
    LAS float* ssqp = (LAS float*)(F.lds + XT_BYTES + 40960);
    LAS float* lgf = (LAS float*)(F.lds + XT_BYTES + 45056);
    LAS int* hist = (LAS int*)(F.lds + XT_BYTES + 51200);
    int* histg = (int*)(F.ws + WS_HIST); int* toke = (int*)(F.ws + WS_TOKE); float* tokw = (float*)(F.ws + WS_TOKW); float* tokrs = (float*)(F.ws + WS_TOKRS);
    f16* h3 = (f16*)(F.ws + WS_H);
    const int tid = F.tid, lane = F_LANE, w = F.wave, tok = lane & 31, h = lane >> 5;
    for (int ch = F.c; ch < SEQ / 32; ch += F.G) {
        if (tid < 32) hist[tid] = 0;
        const int t0 = ch * 32;
        const f16* xs0 = x2 + (size_t)(t0 + (lane >> 3)) * D + 256 * w + 8 * (lane & 7);
#define LDX8(dst0, dst1, p) do { const u32x4 v_ = *(const u32x4*)(p); const f32x2 e0 = unpk2h(v_.x), e1 = unpk2h(v_.y), e2 = unpk2h(v_.z), e3 = unpk2h(v_.w); dst0 = (f32x4){e0[0], e0[1], e1[0], e1[1]}; dst1 = (f32x4){e2[0], e2[1], e3[0], e3[1]}; } while (0)
        f16* ho0 = h3 + (size_t)(t0 + (lane >> 3)) * D + 256 * w + 8 * (lane & 7);
        const float* wre0 = wre + (size_t)(256 * w + h) * 32 + tok;
        const float* wrg0 = wrg + (size_t)(256 * w + lane) * 4;
        f32x4 pre[8], wgn; float bwn[32];
#pragma unroll
        for (int i = 0; i < 4; ++i) LDX8(pre[2 * i], pre[2 * i + 1], xs0 + (size_t)(8 * i) * D);
        { const float* p0 = wre0; const float* p1 = wre0 + 1024; asm volatile("" : "+v"(p0)); asm volatile("" : "+v"(p1));
#pragma unroll
          for (int s = 0; s < 16; ++s) { bwn[s] = p0[64 * s]; bwn[16 + s] = p1[64 * s]; } }
        wgn = *(const f32x4*)wrg0;
        f32x16 acc;
#pragma unroll
        for (int i = 0; i < 16; ++i) acc[i] = 0.f;
        float ga0 = 0.f, ga1 = 0.f, ga2 = 0.f, ga3 = 0.f; float sq[4] = {0.f, 0.f, 0.f, 0.f};
#pragma unroll 1
        for (int b = 0; b < 4; ++b) {
            float bw[32];
            { const f32x4 gA = *(const f32x4*)(gf + 256 * w + 64 * b + 8 * (lane & 7)), gB = *(const f32x4*)(gf + 256 * w + 64 * b + 8 * (lane & 7) + 4);
#pragma unroll
              for (int i = 0; i < 4; ++i) { const f32x4 xa = pre[2 * i], xb = pre[2 * i + 1];
                  sq[i] += xa[0] * xa[0] + xa[1] * xa[1] + xa[2] * xa[2] + xa[3] * xa[3] + xb[0] * xb[0] + xb[1] * xb[1] + xb[2] * xb[2] + xb[3] * xb[3];
                  const f32x4 a = xa * gA, c = xb * gB;
                  LAS float* p = xt + (8 * i + (lane >> 3)) * 68 + 8 * (lane & 7); *(LAS f32x4*)p = a; *(LAS f32x4*)(p + 4) = c;
                  u32x4 o; o.x = pk2h(a[0], a[1]); o.y = pk2h(a[2], a[3]); o.z = pk2h(c[0], c[1]); o.w = pk2h(c[2], c[3]);
                  *(u32x4*)(ho0 + (size_t)(8 * i) * D + 64 * b) = o; } }
            *(LAS f32x4*)(wgt + 4 * lane) = wgn;
#pragma unroll
            for (int s = 0; s < 32; ++s) bw[s] = bwn[s];
            if (b < 3) {
#pragma unroll
                for (int i = 0; i < 4; ++i) LDX8(pre[2 * i], pre[2 * i + 1], xs0 + (size_t)(8 * i) * D + 64 * (b + 1));
                { const float* p0 = wre0 + 2048 * (b + 1); const float* p1 = p0 + 1024; asm volatile("" : "+v"(p0)); asm volatile("" : "+v"(p1));
#pragma unroll
                  for (int s = 0; s < 16; ++s) { bwn[s] = p0[64 * s]; bwn[16 + s] = p1[64 * s]; } }
                wgn = *(const f32x4*)(wrg0 + 256 * (b + 1)); }
            LDS_WAIT(); asm volatile("" ::: "memory");
#pragma unroll
            for (int q = 0; q < 16; ++q) {
                const f32x4 xv = *(const LAS f32x4*)(xt + tok * 68 + 4 * q);
                const f32x4 wg0 = *(const LAS f32x4*)(wgt + 4 * (4 * q + h)), wg1 = *(const LAS f32x4*)(wgt + 4 * (4 * q + 2 + h));
                const float a0 = h ? xv[1] : xv[0], a1 = h ? xv[3] : xv[2];
                acc = __builtin_amdgcn_mfma_f32_32x32x2f32(a0, bw[2 * q], acc, 0, 0, 0);
                acc = __builtin_amdgcn_mfma_f32_32x32x2f32(a1, bw[2 * q + 1], acc, 0, 0, 0);
                ga0 += a0 * wg0[0] + a1 * wg1[0]; ga1 += a0 * wg0[1] + a1 * wg1[1]; ga2 += a0 * wg0[2] + a1 * wg1[2]; ga3 += a0 * wg0[3] + a1 * wg1[3];
                if ((q & 1) == 1) __builtin_amdgcn_sched_barrier(0); }
            LDS_WAIT(); asm volatile("" ::: "memory");
        }
#pragma unroll
        for (int i = 0; i < 4; ++i) { float s = sq[i]; s += __shfl_xor(s, 1); s += __shfl_xor(s, 2); s += __shfl_xor(s, 4); if ((lane & 7) == 0) ssqp[w * 32 + 8 * i + (lane >> 3)] = s; }
#pragma unroll
        for (int r = 0; r < 16; ++r) part[(w * 32 + (r & 3) + 8 * (r >> 2) + 4 * h) * 33 + tok] = acc[r];
        ga0 += __shfl_xor(ga0, 32); ga1 += __shfl_xor(ga1, 32); ga2 += __shfl_xor(ga2, 32); ga3 += __shfl_xor(ga3, 32);
        if (h == 0) { *(LAS f32x4*)(gpart + (w * 32 + tok) * 4) = (f32x4){ga0, ga1, ga2, ga3}; }
        __syncthreads();
        { const int token = tid >> 4, e2 = tid & 15; float s0 = 0.f, s1 = 0.f;
#pragma unroll
          for (int ww = 0; ww < 8; ++ww) { s0 += part[(ww * 32 + token) * 33 + 2 * e2]; s1 += part[(ww * 32 + token) * 33 + 2 * e2 + 1]; }
          lgf[token * 40 + 4 + 2 * e2] = s0; lgf[token * 40 + 5 + 2 * e2] = s1;
          if (e2 < 4) { float s = 0.f;
#pragma unroll
              for (int ww = 0; ww < 8; ++ww) s += gpart[(ww * 32 + token) * 4 + e2];
              lgf[token * 40 + e2] = s; }
          if (e2 == 4) { float s = 0.f;
#pragma unroll
              for (int ww = 0; ww < 8; ++ww) s += ssqp[ww * 32 + token];
              lgf[token * 40 + 36] = rsqrtf(s * (1.0f / D) + EPS); } }
        __syncthreads();
        if (tid < 32) { const int t = tid; const LAS float* L = lgf + t * 40; const float rs = L[36];
            const float g0 = L[0] * rs + brg[0], g1 = L[1] * rs + brg[1], g2 = L[2] * rs + brg[2], g3 = L[3] * rs + brg[3];
            int gi = 0; float gm = g0; if (g1 > gm) { gm = g1; gi = 1; } if (g2 > gm) { gm = g2; gi = 2; } if (g3 > gm) { gm = g3; gi = 3; }
            const float pg = 1.0f / (__expf(g0 - gm) + __expf(g1 - gm) + __expf(g2 - gm) + __expf(g3 - gm));
            float le[8];
#pragma unroll
            for (int i = 0; i < 8; ++i) le[i] = L[4 + gi * 8 + i] * rs + bre[gi * 8 + i];
            int i1 = 0; float m1 = le[0];
#pragma unroll
            for (int i = 1; i < 8; ++i) if (le[i] > m1) { m1 = le[i]; i1 = i; }
            int i2 = -1; float m2 = -3.0e38f;
#pragma unroll
            for (int i = 0; i < 8; ++i) if (i != i1 && le[i] > m2) { m2 = le[i]; i2 = i; }
            const float ex = __expf(m2 - m1); const float w1 = pg / (1.0f + ex), w2 = pg * ex / (1.0f + ex);
            const int tk = t0 + t; const int e1 = gi * 8 + i1, e2 = gi * 8 + i2;
            tokrs[tk] = rs;
            toke[tk * 2] = e1; toke[tk * 2 + 1] = e2; tokw[tk * 2] = w1; tokw[tk * 2 + 1] = w2;
            atomicAdd((int*)(hist + e1), 1); atomicAdd((int*)(hist + e2), 1); }
        __syncthreads();
        if (tid < 32) histg[ch * 32 + tid] = hist[tid];
        __syncthreads();
    }
}

__device__ __forceinline__ void phase_scatter(const Frame& F) {
    const int* histg = (const int*)(F.ws + WS_HIST); const int* toke = (const int*)(F.ws + WS_TOKE); const float* tokw = (const float*)(F.ws + WS_TOKW);
    int* totg = (int*)(F.ws + WS_TOT); int* tokslot = (int*)(F.ws + WS_TOKSLOT); float* slotw = (float*)(F.ws + WS_SLOTW); const float* tokrs = (const float*)(F.ws + WS_TOKRS);
    int* slottok = (int*)(F.ws + WS_SLOTTOK); float* slotrs = (float*)(F.ws + WS_SLOTRS);
    LAS int* ps = (LAS int*)F.lds;
    LAS int* tot = ps + 1024;
    LAS int* bas = ps + 1056;
    const int tid = F.tid, lane = F_LANE;
    for (int ch = F.c; ch < SEQ / 32; ch += F.G) {
        { const int e = tid & 31, part = tid >> 5; int s = 0, b = 0;
#pragma unroll
          for (int q = 0; q < 16; ++q) { const int cq = part * 16 + q; const int h = histg[cq * 32 + e]; s += h; b += (cq < ch) ? h : 0; }
          ps[part * 32 + e] = s; ps[512 + part * 32 + e] = b; }
        __syncthreads();
        if (tid < 32) { int s = 0, b = 0;
#pragma unroll
            for (int p = 0; p < 16; ++p) { s += ps[p * 32 + tid]; b += ps[512 + p * 32 + tid]; }
            tot[tid] = s; bas[tid] = b; }
        __syncthreads();
        if (tid < 32) { int pst = 0; for (int e = 0; e < tid; ++e) pst += (tot[e] + 127) >> 7; pst <<= 7;
            bas[tid] = pst + bas[tid];
            if (ch == 0) totg[tid] = tot[tid]; }
        __syncthreads();
        if (ch < 32) { int pst = 0; for (int e = 0; e < ch; ++e) pst += (tot[e] + 127) >> 7; pst <<= 7; const int n = tot[ch]; const int end = pst + (((n + 127) >> 7) << 7);
            for (int s = pst + n + tid; s < end; s += 512) { slotw[s] = 0.f; slotrs[s] = 0.f; slottok[s] = 0; } }
        if (ch == 32) { int pend = 0; for (int e = 0; e < NE; ++e) pend += (tot[e] + 127) >> 7; pend <<= 7; if (tid < 128) { slotw[pend + tid] = 0.f; slotrs[pend + tid] = 0.f; slottok[pend + tid] = 0; } }
        if (F.wave == 0) { const int a = lane; const int tok = ch * 32 + (a >> 1); const int e = toke[tok * 2 + (a & 1)]; const float wv = tokw[tok * 2 + (a & 1)];
            int rank = 0;
            for (int ee = 0; ee < 32; ++ee) { const unsigned long long mk = __ballot(e == ee); if (e == ee) rank = __popcll(mk & ((1ull << lane) - 1ull)); }
            const int slot = bas[e] + rank; slotw[slot] = wv; slotrs[slot] = tokrs[tok]; slottok[slot] = tok; tokslot[tok * 2 + (a & 1)] = slot; }
        __syncthreads();
    }
}
__device__ __forceinline__ void moe_table(const Frame& F) {
    const int* totg = (const int*)(F.ws + WS_TOT); LAS int* tab = (LAS int*)(F.lds + TAB_OFF);
    __syncthreads();
    if (F.tid == 0) { int NF = 0, NH = 0, row = 0;
        for (int e = 0; e < NE; ++e) { const int n128 = (totg[e] + 127) >> 7; NF += n128 >> 1; NH += n128 & 1; }
        int jf = 0, jh = NF;
        for (int e = 0; e < NE; ++e) { const int n128 = (totg[e] + 127) >> 7; const int nf = n128 >> 1;
            for (int q = 0; q < nf; ++q) tab[2 + jf++] = e | ((row / 128 + 2 * q) << 8);
            if (n128 & 1) tab[2 + jh++] = e | ((row / 128 + 2 * nf) << 8);
            row += n128 * 128; }
        tab[0] = NF; tab[1] = NH; }
    __syncthreads();
}

__device__ __forceinline__ void rowfac_y(const Frame& F, int pm) {
    const float* ssq = (const float*)(F.ws + WS_SSQY); LAS f32x2* fac = (LAS f32x2*)(F.lds + TAB_OFF);
    __syncthreads();
    if (F.tid < 256) { const f32x4* p = (const f32x4*)(ssq + (size_t)(pm * 256 + F.tid) * 32); float sa = 0.f, sb = 0.f;
#pragma unroll
        for (int q = 0; q < 4; ++q) { const f32x4 a = p[q], b = p[4 + q]; sa += (a[0] + a[1]) + (a[2] + a[3]); sb += (b[0] + b[1]) + (b[2] + b[3]); }
        const float ra = rsqrtf(sa * (1.0f / 1024.f) + EPS), rb = rsqrtf(sb * (1.0f / 1024.f) + EPS);
        fac[F.tid] = (f32x2){ra / rb, rb}; }
    __syncthreads();
}
__device__ __forceinline__ void rowfac_x(const Frame& F, int pm) {
    const float* ssq = (const float*)(F.ws + WS_SSQX); LAS float* fac = (LAS float*)(F.lds + TAB_OFF);
    __syncthreads();
    if (F.tid < 256) { const f32x4* p = (const f32x4*)(ssq + (size_t)(pm * 256 + F.tid) * 32); float s = 0.f;
#pragma unroll
        for (int q = 0; q < 8; ++q) { const f32x4 a = p[q]; s += (a[0] + a[1]) + (a[2] + a[3]); }
        fac[F.tid] = rsqrtf(s * (1.0f / D) + EPS); }
    __syncthreads();
}

__device__ __forceinline__ void phase_final(const Frame& F, const Args& A, float* out) {
    const f16* x2h = (const f16*)(F.ws + WS_X2H);
    const int* tokslot = (const int*)(F.ws + WS_TOKSLOT); const f16* ys = (const f16*)(F.ws + WS_YS); const float* g = A.in[27];
    const int gw = F.c * 8 + F.wave, NGW = F.G * 8, lane = F_LANE;
    for (int m = gw; m < SEQ; m += NGW) {
        const int s0 = tokslot[m * 2], s1 = tokslot[m * 2 + 1];
        f32x4 v[8]; float s = 0.f;
#pragma unroll
        for (int j = 0; j < 4; ++j) { const int col = 8 * (lane + 64 * j); const u32x4 xv = *(const u32x4*)(x2h + (size_t)m * D + col);
            const u32x4 y0 = *(const u32x4*)(ys + (size_t)s0 * D + col), y1 = *(const u32x4*)(ys + (size_t)s1 * D + col);
            f32x4 a, b; { const f32x2 e0 = unpk2h(xv.x), e1 = unpk2h(xv.y), e2 = unpk2h(xv.z), e3 = unpk2h(xv.w); a = (f32x4){e0[0], e0[1], e1[0], e1[1]}; b = (f32x4){e2[0], e2[1], e3[0], e3[1]}; }
            { const f32x2 q0 = unpk2h(y0.x), q1 = unpk2h(y1.x); a[0] += q0[0] + q1[0]; a[1] += q0[1] + q1[1]; }
            { const f32x2 q0 = unpk2h(y0.y), q1 = unpk2h(y1.y); a[2] += q0[0] + q1[0]; a[3] += q0[1] + q1[1]; }
            { const f32x2 q0 = unpk2h(y0.z), q1 = unpk2h(y1.z); b[0] += q0[0] + q1[0]; b[1] += q0[1] + q1[1]; }
            { const f32x2 q0 = unpk2h(y0.w), q1 = unpk2h(y1.w); b[2] += q0[0] + q1[0]; b[3] += q0[1] + q1[1]; }
            v[2 * j] = a; v[2 * j + 1] = b;
            s += a[0] * a[0] + a[1] * a[1] + a[2] * a[2] + a[3] * a[3] + b[0] * b[0] + b[1] * b[1] + b[2] * b[2] + b[3] * b[3]; }
        const float rs = rsqrtf(wave_sum(s) * (1.0f / D) + EPS);
#pragma unroll
        for (int j = 0; j < 4; ++j) { const int col = 8 * (lane + 64 * j); f32x4* p = (f32x4*)(out + (size_t)m * D + col);
            p[0] = v[2 * j] * rs * *(const f32x4*)(g + col); p[1] = v[2 * j + 1] * rs * *(const f32x4*)(g + col + 4); }
    }
}

#if FAST_GEMM
#define RUN_GEMM(EpiT, SchedT, lda, ldb, S, E) pg8::gemm_phase<EpiT, SchedT, !EpiT::AFTER_DRAIN, true>(F.lds, lda, ldb, (size_t)128, S, E)
#define RUN_GEMM_KTG(EpiT, SchedT, lda, S, E) pg8::gemm_phase<EpiT, SchedT, !EpiT::AFTER_DRAIN, true, true>(F.lds, lda, 64, (size_t)32768, S, E)
#define RUN_GEMM_KT(EpiT, SchedT, lda, S, E) pg8::gemm_phase<EpiT, SchedT, !EpiT::AFTER_DRAIN, true>(F.lds, lda, 64, (size_t)32768, S, E)
#else
#define RUN_GEMM(EpiT, SchedT, lda, ldb, S, E) pg8::gemm_phase_simple<EpiT, SchedT>(F.lds, lda, ldb, S, E)
#endif

__global__ void __launch_bounds__(512, 2) fwd(Args args) {
    extern __shared__ __attribute__((aligned(16))) unsigned char lds_raw[];
    Frame F;
    F.lds = (LAS unsigned char*)lds_raw; F.ws = args.ws;
    F.tid = threadIdx.x; F.wave = __builtin_amdgcn_readfirstlane(F.tid >> 6);
    F.G = gridDim.x; F.c = blockIdx.x;
    volatile LAS unsigned* MISC = (volatile LAS unsigned*)(F.lds + MISC_OFF);
    if (F.tid < 64) MISC[F.tid] = 0u;
    __syncthreads();
    XcdBarrier bar; bar.bar = (unsigned*)(args.ws + WS_CTL) + CW_BAR; bar.x = 0; bar.st = nullptr;
    if (MK_N_LAUNCHES == 1) bar = xcd_barrier_post((unsigned*)(args.ws + WS_CTL) + CW_BAR, MISC + 8);
    const int lo = args.ph_lo, hi = args.ph_hi;
    volatile LAS unsigned* TS = (volatile LAS unsigned*)(F.lds + TAB_OFF + 2048);
#ifndef ONLY_PHASE
#define ONLY_PHASE -1
#endif
#define IN(k) ((ONLY_PHASE < 0 || (k) == ONLY_PHASE) && lo <= (k) && (k) < hi)
#ifndef REP_PHASE
#define REP_PHASE -1
#endif
#ifndef REP_N
#define REP_N 1
#endif
#define REPS(k) _Pragma("unroll 1") for (int rep_ = 0; rep_ < (((k) == REP_PHASE) ? args.pad : 1); ++rep_)
#ifndef PROF_PHASE
#define PROF_PHASE -1
#endif
#ifndef PROF_MULT
#define PROF_MULT 4
#endif
#define STAMP(k) do { if (PROF_PHASE >= 0 && F.c == 0 && F.tid == 0) { const unsigned long long t_ = __builtin_amdgcn_s_memrealtime(); TS[2 * (k)] = (unsigned)t_; TS[2 * (k) + 1] = (unsigned)(t_ >> 32); } } while (0)
#define SEAM(k) do { if (IN(k) && IN((k) + 1)) xcd_barrier(bar); STAMP((k) + 1); } while (0)
    unsigned char* ws = args.ws; float* out = args.out;
    const char* wsc = (const char*)ws;

    STAMP(0);
    if (IN(0)) REPS(0) { phase_prep(F, args); } SEAM(0);
    if (IN(1)) REPS(1) { SchedP1 S{F.G, F.c, (char*)ws};
        EpiF16 E{nullptr, 1.0f};
        RUN_GEMM(EpiF16, SchedP1, D, D, S, E); tr_idle(F, args, 1); } SEAM(1);
#ifndef DUP2
#define DUP2 0
#endif
    if (IN(2)) { phase_mixpre(F, args); tr_drain(F, args, SEG_B); } SEAM(2);
    if (IN(3)) REPS(3) { SchedG2 S{F.G, F.c, wsc + WS_DC, wsc + WS_WPW, wsc + WS_WPOOL, (char*)(ws + WS_Y)};
        EpiF16 E{args.in[5], 1.0f, (float*)(ws + WS_SSQY), nullptr};
        RUN_GEMM(EpiF16, SchedG2, D, 1024, S, E); } SEAM(3); STAMP(5);
    if (IN(5)) REPS(5) { int pm, pn; pg8::tile_of(F.c, 32, 8, pm, pn); rowfac_y(F, pm);
        SchedG3 S{F.G, F.c, wsc + WS_Y, wsc + WS_WOUT}; EpiG3 E{args.in[0], out, (f16*)(ws + WS_H), (float*)(ws + WS_SSQX), (const LAS f32x2*)(F.lds + TAB_OFF)};
        RUN_GEMM(EpiG3, SchedG3, D, D, S, E); } SEAM(5); STAMP(7);
    if (IN(7)) REPS(7) { int pm, pn; pg8::tile_of(F.c, 32, 8, pm, pn); rowfac_x(F, pm);
        SchedDense S{F.G, F.c, wsc + WS_H, wsc + WS_WQ, (char*)(ws + WS_Q)};
        EpiF16 E{nullptr, 0.044194173824159216f, nullptr, (const LAS float*)(F.lds + TAB_OFF)};
        RUN_GEMM(EpiF16, SchedDense, D, D, S, E); } SEAM(7);
    if (IN(8)) REPS(8) { { SchedS S{F.G, F.c, wsc + WS_Q, wsc + WS_K16}; EpiSoftmax E{(f16*)(ws + WS_P)};
          RUN_GEMM(EpiSoftmax, SchedS, D, D, S, E); }
        VM_WAIT(); __syncthreads();
        { SchedPV S{F.G, F.c, wsc + WS_P, wsc + WS_VT16, (char*)(ws + WS_O)};
          EpiF16 E{nullptr, 1.0f};
          RUN_GEMM(EpiF16, SchedPV, 256, 256, S, E); } }
    if (IN(8) && IN(10)) { xcd_barrier(bar); STAMP(9); STAMP(10); }
    if (IN(10)) REPS(10) { SchedDense S{F.G, F.c, wsc + WS_O, wsc + WS_WO, nullptr}; EpiResH E{(const f16*)(ws + WS_H), (f16*)(ws + WS_X2H), D};
        RUN_GEMM(EpiResH, SchedDense, D, D, S, E); } SEAM(10);
    if (IN(11)) REPS(11) { phase_router(F, args, (const f16*)(ws + WS_X2H)); } SEAM(11);
    if (IN(12)) REPS(12) { phase_scatter(F); tr_drain(F, args, NITEMS); } SEAM(12);
    if (IN(13)) { moe_table(F); const LAS int* tab = (const LAS int*)(F.lds + TAB_OFF);
        { SchedGU S{F.G, F.c, 0, wsc + WS_H, wsc + WS_WGU, tab, (const int*)(ws + WS_SLOTTOK)}; EpiSwiGLU E{(f16*)(ws + WS_HID), (const float*)(ws + WS_SLOTRS)}; RUN_GEMM_KTG(EpiSwiGLU, SchedGU, D, S, E); }
        xcd_barrier(bar); STAMP(14);
        { SchedGU S{F.G, F.c, 1, wsc + WS_H, wsc + WS_WGU, tab, (const int*)(ws + WS_SLOTTOK)}; EpiSwiGLU E{(f16*)(ws + WS_HID), (const float*)(ws + WS_SLOTRS)}; RUN_GEMM_KTG(EpiSwiGLU, SchedGU, D, S, E); }
        { SchedDN S{F.G, F.c, 0, wsc + WS_HID, wsc + WS_WDN, tab}; EpiDown E{(f16*)(ws + WS_YS), (const float*)(ws + WS_SLOTW)}; RUN_GEMM_KT(EpiDown, SchedDN, DE, S, E); }
        xcd_barrier(bar); STAMP(15);
        { SchedDN S{F.G, F.c, 1, wsc + WS_HID, wsc + WS_WDN, tab}; EpiDown E{(f16*)(ws + WS_YS), (const float*)(ws + WS_SLOTW)}; RUN_GEMM_KT(EpiDown, SchedDN, DE, S, E); }
        xcd_barrier(bar); STAMP(16); }
    if (IN(15)) REPS(15) { phase_final(F, args, out); }
    if (PROF_PHASE >= 0 && F.c == 0 && F.tid == 0 && lo == 0) {
        STAMP(17);
        const unsigned long long t0 = ((unsigned long long)TS[2 * PROF_PHASE + 1] << 32) | TS[2 * PROF_PHASE], t1 = ((unsigned long long)TS[2 * PROF_PHASE + 3] << 32) | TS[2 * PROF_PHASE + 2];
        const unsigned long long until = __builtin_amdgcn_s_memrealtime() + (unsigned long long)PROF_MULT * (t1 - t0);
        while (__builtin_amdgcn_s_memrealtime() < until) __builtin_amdgcn_s_sleep(8);
    }
#undef IN
#undef SEAM
}

extern "C" void kernel_launch(void* const* d_in, const int* in_sizes, int n_in, void* d_out, int out_size, void* d_ws, size_t ws_size, hipStream_t stream) {
    static int grid = 0;
    if (grid == 0) {
        if (n_in != 28 || out_size != SEQ * D || ws_size < WS_END) { fprintf(stderr, "kernel_launch: unexpected sizes n_in %d out %d ws %zu\n", n_in, out_size, ws_size); grid = -1; return; }
        int dev = 0, cus = 0;
        if (hipGetDevice(&dev) != hipSuccess || hipDeviceGetAttribute(&cus, hipDeviceAttributeMultiprocessorCount, dev) != hipSuccess) { grid = -1; return; }
        if (hipFuncSetAttribute((const void*)fwd, hipFuncAttributeMaxDynamicSharedMemorySize, LDS_BYTES) != hipSuccess) { grid = -1; return; }
        int per_cu = 0;
        (void)hipOccupancyMaxActiveBlocksPerMultiprocessor(&per_cu, (const void*)fwd, 512, LDS_BYTES);
        (void)hipGetLastError();
        grid = cus;
    }
    if (grid < 0) return;
    (void)hipMemsetAsync((char*)d_ws + WS_CTL, 0, CTL_ZERO_BYTES, stream);
    Args a{};
    for (int i = 0; i < 28; ++i) a.in[i] = (const float*)d_in[i];
    a.out = (float*)d_out; a.ws = (unsigned char*)d_ws; a.pad = REP_N;
    if (MK_N_LAUNCHES == 1) { a.ph_lo = 0; a.ph_hi = NPHASE; a.li = 0; hipLaunchKernelGGL(fwd, dim3(grid), dim3(512), LDS_BYTES, stream, a);
#if EXTRA_PHASE >= 0
        for (int r = 0; r < EXTRA_N; ++r) { a.ph_lo = EXTRA_PHASE; a.ph_hi = EXTRA_PHASE + 1; a.li = 1 + r;
#if EXTRA_REQUEUE
            { static const unsigned hv = SEG_B; (void)hipMemsetAsync((char*)d_ws + WS_CTL + (CW_ARRIVE + 64 * EXTRA_PHASE) * 4, 0, 4, stream);
              (void)hipMemsetD32Async((hipDeviceptr_t)((char*)d_ws + WS_CTL + CW_QHEAD * 4), (int)hv, 1, stream); }
#endif
            hipLaunchKernelGGL(fwd, dim3(grid), dim3(512), LDS_BYTES, stream, a); }
#endif
    }
    else { for (int p = 0; p < NPHASE; ++p) { a.ph_lo = p; a.ph_hi = p + 1; a.li = p; hipLaunchKernelGGL(fwd, dim3(grid), dim3(512), LDS_BYTES, stream, a); } }
}
```
